# Optimizing an MI355X kernel written in HIP

```python
import math
import jax
import jax.numpy as jnp
from jax import lax
import numpy as np

D_MODEL = 1024
BATCH = 2
SEQ = 16384
DEPTH = 2

MEM_LEN = 256
GROUP_WIDTH = 384
MIX_WIDTH = 4 * GROUP_WIDTH
SSD_HEAD_DIM = 64
SSD_HEADS = GROUP_WIDTH // SSD_HEAD_DIM
SSD_GROUPS = 2
SSD_STATE = 128
SSD_CONV = 4
SSD_CHUNK = 128
SSD_CONV_CH = GROUP_WIDTH + 2 * SSD_GROUPS * SSD_STATE
DT_MIN = 0.001
DT_MAX = 0.1
SC_WIDTH = 3
ATT_HEAD_DIM = 64
ATT_HEADS = 6
ATT_WIDTH = ATT_HEADS * ATT_HEAD_DIM
DILATED_PATTERNS = ((128, 1), (512, 4), (2048, 16))
CF_KERNEL = 31
IN_SIZES = (GROUP_WIDTH, SSD_CONV_CH, SSD_HEADS,
            GROUP_WIDTH, GROUP_WIDTH, GROUP_WIDTH,
            ATT_WIDTH, ATT_WIDTH, ATT_WIDTH,
            GROUP_WIDTH, GROUP_WIDTH)
N_IN = 6 * GROUP_WIDTH + SSD_CONV_CH + SSD_HEADS + 3 * ATT_WIDTH
CA_HEADS = 4
CA_HEAD_DIM = D_MODEL // CA_HEADS
N_EXPERT_GROUPS = 4
EXPERTS_PER_GROUP = 8
N_EXPERTS = N_EXPERT_GROUPS * EXPERTS_PER_GROUP
TOP_K = 2
EXPERT_HIDDEN = D_MODEL // 2
MOE_BLOCK = 256

RMS_EPS = 1e-6
LN_EPS = 1e-5

kernel_name = 'hymba_style_ssd_conv_dilated_attn_hmoe'


def rms_norm(x, g):
    xf = x.astype(jnp.float32)
    y = xf * lax.rsqrt(jnp.mean(xf * xf, axis=-1, keepdims=True) + RMS_EPS)
    return (y * g.astype(jnp.float32)).astype(x.dtype)


def layer_norm(x, g, b):
    xf = x.astype(jnp.float32)
    mu = jnp.mean(xf, axis=-1, keepdims=True)
    xc = xf - mu
    y = xc * lax.rsqrt(jnp.mean(xc * xc, axis=-1, keepdims=True) + LN_EPS)
    return (y * g.astype(jnp.float32) + b.astype(jnp.float32)).astype(x.dtype)


def split_last(t, sizes):
    out, o = [], 0
    for s in sizes:
        out.append(t[..., o:o + s])
        o += s
    return out


def causal_dwconv(x, w, b=None):
    k, c = w.shape
    y = lax.conv_general_dilated(x, w[:, None, :].astype(x.dtype), window_strides=(1,),
                                 padding=((k - 1, 0),), dimension_numbers=('NWC', 'WIO', 'NWC'),
                                 feature_group_count=c)
    if b is not None:
        y = y + b.astype(x.dtype)
    return y


def ssd_chunked(x, da, b, c):
    bsz, s, nh, p = x.shape
    g, n = b.shape[2], b.shape[3]
    j = nh // g
    q = SSD_CHUNK
    nc = s // q
    x = x.reshape(bsz, nc, q, g, j, p)
    b = b.reshape(bsz, nc, q, g, n)
    c = c.reshape(bsz, nc, q, g, n)
    a_cs = jnp.cumsum(da.reshape(bsz, nc, q, g, j).transpose(0, 3, 4, 1, 2), axis=-1)
    tril = jnp.tril(jnp.ones((q, q), dtype=bool))
    seg = jnp.exp(jnp.where(tril, a_cs[..., :, None] - a_cs[..., None, :], -jnp.inf))
    cb = jnp.einsum('bclgn,bcsgn->bcgls', c, b)
    y_diag = jnp.einsum('bcgls,bgjcls,bcsgjp->bclgjp', cb, seg, x)
    decay = jnp.exp(a_cs[..., -1:] - a_cs)
    states = jnp.einsum('bclgn,bgjcl,bclgjp->bcgjpn', b, decay, x)
    chunk_decay = jnp.exp(a_cs[..., -1])

    def step(h, inp):
        st, dec = inp
        return h * dec[..., None, None] + st, h

    _, prev = lax.scan(step, jnp.zeros_like(states[:, 0]),
                       (jnp.moveaxis(states, 1, 0), jnp.moveaxis(chunk_decay, -1, 0)))
    prev = jnp.moveaxis(prev, 0, 1)
    y_off = jnp.einsum('bclgn,bcgjpn,bgjcl->bclgjp', c, prev, jnp.exp(a_cs))
    return (y_diag + y_off).reshape(bsz, s, nh, p)


def dilated_branch(q, k, v, window, dilation):
    bsz, s, nh, dh = q.shape
    n = window // dilation
    blk = n
    span = dilation * blk
    sp = -(-s // span) * span
    nb = sp // span

    def to_blocks(t):
        t = jnp.pad(t.astype(jnp.float32), ((0, 0), (0, sp - s), (0, 0), (0, 0)))
        return t.reshape(bsz, nb, blk, dilation, nh, dh).transpose(0, 3, 4, 1, 2, 5)

    def band(t):
        prev = jnp.pad(t, ((0, 0), (0, 0), (0, 0), (1, 0), (0, 0), (0, 0)))[:, :, :, :-1]
        return jnp.concatenate([prev, t], axis=4)

    qb = to_blocks(q)
    kb = band(to_blocks(k))
    vb = band(to_blocks(v))
    sc = jnp.einsum('brhnqe,brhnke->brhnqk', qb, kb) * (ATT_HEAD_DIM ** -0.5)
    bi = jnp.arange(nb)[:, None, None]
    qq = jnp.arange(blk)[None, :, None]
    kk = jnp.arange(2 * blk)[None, None, :]
    rel = qq + blk - kk
    valid = (rel >= 0) & (rel <= n) & ((bi > 0) | (kk >= blk))
    sc = jnp.where(valid, sc, -jnp.inf)
    m = jnp.max(sc, axis=-1, keepdims=True)
    pr = jnp.exp(sc - m)
    den = jnp.sum(pr, axis=-1)
    o = jnp.einsum('brhnqk,brhnke->brhnqe', pr, vb) / den[..., None]
    lse = m[..., 0] + jnp.log(den)
    o = o.transpose(0, 3, 4, 1, 2, 5).reshape(bsz, sp, nh, dh)[:, :s]
    lse = lse.transpose(0, 3, 4, 1, 2).reshape(bsz, sp, nh)[:, :s]
    return o, lse


def dilated_attention(q, k, v, q_norm, k_norm):
    bsz, s, _ = q.shape
    q = rms_norm(q.reshape(bsz, s, ATT_HEADS, ATT_HEAD_DIM), q_norm)
    k = rms_norm(k.reshape(bsz, s, ATT_HEADS, ATT_HEAD_DIM), k_norm)
    v = v.reshape(bsz, s, ATT_HEADS, ATT_HEAD_DIM)
    outs, lses = [], []
    for window, dilation in DILATED_PATTERNS:
        o, l = dilated_branch(q, k, v, window, dilation)
        outs.append(o)
        lses.append(l)
    wts = jax.nn.softmax(jnp.stack(lses, axis=0), axis=0)
    o = jnp.sum(wts[..., None] * jnp.stack(outs, axis=0), axis=0)
    return o.reshape(bsz, s, ATT_WIDTH).astype(v.dtype)


def hybrid_mixer(h, w_in, ssd_conv_w, ssd_conv_b, ssd_dt_bias, ssd_a_log, ssd_d, ssd_norm,
                 sc_conv_w, attn_q_norm, attn_k_norm, cf_conv_w, cf_conv_b, cf_ln_g, cf_ln_b, w_out):
    bsz, s, _ = h.shape
    proj = h @ w_in
    (z, xbc, dt_raw, sc_b, sc_c, sc_h, q, k, v, cf_a, cf_g) = split_last(proj, IN_SIZES)

    xbc = jax.nn.silu(causal_dwconv(xbc, ssd_conv_w, ssd_conv_b))
    xs, bm, cm = split_last(xbc, (GROUP_WIDTH, SSD_GROUPS * SSD_STATE, SSD_GROUPS * SSD_STATE))
    xs = xs.reshape(bsz, s, SSD_HEADS, SSD_HEAD_DIM).astype(jnp.float32)
    bm = bm.reshape(bsz, s, SSD_GROUPS, SSD_STATE).astype(jnp.float32)
    cm = cm.reshape(bsz, s, SSD_GROUPS, SSD_STATE).astype(jnp.float32)
    dt = jax.nn.softplus(dt_raw.astype(jnp.float32) + ssd_dt_bias.astype(jnp.float32))
    a = -jnp.exp(ssd_a_log.astype(jnp.float32))
    y = ssd_chunked(xs * dt[..., None], dt * a, bm, cm) + xs * ssd_d.astype(jnp.float32)[:, None]
    y = y.reshape(bsz, s, GROUP_WIDTH)
    y_ssd = rms_norm(y * jax.nn.silu(z.astype(jnp.float32)), ssd_norm).astype(h.dtype)

    y_sc = sc_b * causal_dwconv(sc_c * sc_h, sc_conv_w)

    y_att = dilated_attention(q, k, v, attn_q_norm, attn_k_norm)

    u = causal_dwconv(cf_a * jax.nn.sigmoid(cf_g), cf_conv_w, cf_conv_b)
    y_cf = jax.nn.silu(layer_norm(u, cf_ln_g, cf_ln_b))

    return jnp.concatenate([y_ssd, y_sc, y_att, y_cf], axis=-1) @ w_out


def memory_cross_attention(h, mem_n, wq, wkv, q_norm, k_norm, wo):
    bsz, s, _ = h.shape
    m = mem_n.shape[1]
    q = rms_norm((h @ wq).reshape(bsz, s, CA_HEADS, CA_HEAD_DIM), q_norm)
    k, v = split_last(mem_n @ wkv, (D_MODEL, D_MODEL))
    k = rms_norm(k.reshape(bsz, m, CA_HEADS, CA_HEAD_DIM), k_norm)
    v = v.reshape(bsz, m, CA_HEADS, CA_HEAD_DIM)
    sc = jnp.einsum('bshe,bmhe->bhsm', q.astype(jnp.float32), k.astype(jnp.float32)) * (CA_HEAD_DIM ** -0.5)
    pr = jax.nn.softmax(sc, axis=-1)
    o = jnp.einsum('bhsm,bmhe->bshe', pr, v.astype(jnp.float32)).astype(h.dtype)
    return o.reshape(bsz, s, D_MODEL) @ wo


def hierarchical_moe(h, wg, bg, we, be, w_gate, w_up, w_down):
    bsz, s, d = h.shape
    t = bsz * s
    ht = h.reshape(t, d)
    g_prob = jax.nn.softmax((ht @ wg + bg).astype(jnp.float32), axis=-1)
    g_p, g_idx = lax.top_k(g_prob, 1)
    e_logits = (ht @ we + be).astype(jnp.float32).reshape(t, N_EXPERT_GROUPS, EXPERTS_PER_GROUP)
    e_in = e_logits[jnp.arange(t), g_idx[:, 0]]
    e_p, e_loc = lax.top_k(jax.nn.softmax(e_in, axis=-1), TOP_K)
    gates = g_p * e_p / jnp.sum(e_p, axis=-1, keepdims=True)
    expert = g_idx * EXPERTS_PER_GROUP + e_loc

    a = t * TOP_K
    flat_e = expert.reshape(a)
    flat_tok = jnp.repeat(jnp.arange(t), TOP_K)
    flat_g = gates.reshape(a)
    order = jnp.argsort(flat_e)
    e_s, tok_s, g_s = flat_e[order], flat_tok[order], flat_g[order]
    counts = jnp.zeros((N_EXPERTS,), jnp.int32).at[flat_e].add(1)
    padded = ((counts + MOE_BLOCK - 1) // MOE_BLOCK) * MOE_BLOCK
    ends_pad = jnp.cumsum(padded)
    starts_pad = ends_pad - padded
    starts = jnp.cumsum(counts) - counts
    dest = starts_pad[e_s] + jnp.arange(a) - starts[e_s]
    p_rows = (-(-a // MOE_BLOCK)) * MOE_BLOCK + N_EXPERTS * MOE_BLOCK
    n_blocks = p_rows // MOE_BLOCK
    buf = jnp.zeros((p_rows, d), h.dtype).at[dest].set(ht[tok_s])
    blk_e = jnp.minimum(jnp.searchsorted(ends_pad, jnp.arange(n_blocks) * MOE_BLOCK, side='right'),
                        N_EXPERTS - 1)

    def expert_block(args):
        xb, e = args
        hid = jax.nn.silu(xb @ w_gate[e]) * (xb @ w_up[e])
        return hid @ w_down[e]

    yb = lax.map(expert_block, (buf.reshape(n_blocks, MOE_BLOCK, d), blk_e)).reshape(p_rows, d)
    y = jnp.zeros((t, d), h.dtype).at[tok_s].add(yb[dest] * g_s[:, None].astype(h.dtype))
    return y.reshape(bsz, s, d)


def setup_inputs(seed: int = 0) -> dict:
    key = jax.random.key(seed)
    keys = iter(jax.random.split(key, 48))
    f32 = jnp.float32
    L = DEPTH

    def normal(shape, scale):
        return jax.random.normal(next(keys), shape, f32) * scale

    def gain(shape):
        return 1.0 + normal(shape, 0.02)

    x = normal((BATCH, SEQ, D_MODEL), 1.0)
    mem = normal((BATCH, MEM_LEN, D_MODEL), 1.0)
    dt_init = jnp.exp(jax.random.uniform(next(keys), (L, SSD_HEADS), f32,
                                         math.log(DT_MIN), math.log(DT_MAX)))
    ssd_dt_bias = dt_init + jnp.log(-jnp.expm1(-dt_init))
    ssd_a_log = jnp.log(jax.random.uniform(next(keys), (L, SSD_HEADS), f32, 1.0, 16.0))
    return {
        'x': x,
        'mem': mem,
        'norm_mix': gain((L, D_MODEL)),
        'w_in': normal((L, D_MODEL, N_IN), D_MODEL ** -0.5),
        'ssd_conv_w': normal((L, SSD_CONV, SSD_CONV_CH), SSD_CONV ** -0.5),
        'ssd_conv_b': normal((L, SSD_CONV_CH), 0.02),
        'ssd_dt_bias': ssd_dt_bias,
        'ssd_a_log': ssd_a_log,
        'ssd_d': 1.0 + normal((L, SSD_HEADS), 0.1),
        'ssd_norm': gain((L, GROUP_WIDTH)),
        'sc_conv_w': normal((L, SC_WIDTH, GROUP_WIDTH), SC_WIDTH ** -0.5),
        'attn_q_norm': gain((L, ATT_HEAD_DIM)),
        'attn_k_norm': gain((L, ATT_HEAD_DIM)),
        'cf_conv_w': normal((L, CF_KERNEL, GROUP_WIDTH), CF_KERNEL ** -0.5),
        'cf_conv_b': normal((L, GROUP_WIDTH), 0.02),
        'cf_ln_g': gain((L, GROUP_WIDTH)),
        'cf_ln_b': normal((L, GROUP_WIDTH), 0.02),
        'w_out': normal((L, MIX_WIDTH, D_MODEL), MIX_WIDTH ** -0.5),
        'norm_ca': gain((L, D_MODEL)),
        'norm_mem': gain((L, D_MODEL)),
        'ca_wq': normal((L, D_MODEL, D_MODEL), D_MODEL ** -0.5),
        'ca_wkv': normal((L, D_MODEL, 2 * D_MODEL), D_MODEL ** -0.5),
        'ca_q_norm': gain((L, CA_HEAD_DIM)),
        'ca_k_norm': gain((L, CA_HEAD_DIM)),
        'ca_wo': normal((L, D_MODEL, D_MODEL), D_MODEL ** -0.5),
        'norm_ffn': gain((L, D_MODEL)),
        'router_group_w': normal((L, D_MODEL, N_EXPERT_GROUPS), D_MODEL ** -0.5),
        'router_group_b': normal((L, N_EXPERT_GROUPS), 0.01),
        'router_expert_w': normal((L, D_MODEL, N_EXPERTS), D_MODEL ** -0.5),
        'router_expert_b': normal((L, N_EXPERTS), 0.01),
        'exp_w_gate': normal((L, N_EXPERTS, D_MODEL, EXPERT_HIDDEN), D_MODEL ** -0.5),
        'exp_w_up': normal((L, N_EXPERTS, D_MODEL, EXPERT_HIDDEN), D_MODEL ** -0.5),
        'exp_w_down': normal((L, N_EXPERTS, EXPERT_HIDDEN, D_MODEL), EXPERT_HIDDEN ** -0.5),
    }


def reference(x, mem, norm_mix, w_in, ssd_conv_w, ssd_conv_b, ssd_dt_bias, ssd_a_log, ssd_d, ssd_norm,
              sc_conv_w, attn_q_norm, attn_k_norm, cf_conv_w, cf_conv_b, cf_ln_g, cf_ln_b, w_out,
              norm_ca, norm_mem, ca_wq, ca_wkv, ca_q_norm, ca_k_norm, ca_wo,
              norm_ffn, router_group_w, router_group_b, router_expert_w, router_expert_b,
              exp_w_gate, exp_w_up, exp_w_down):
    for l in range(DEPTH):
        h = rms_norm(x, norm_mix[l])
        x = x + hybrid_mixer(h, w_in[l], ssd_conv_w[l], ssd_conv_b[l], ssd_dt_bias[l], ssd_a_log[l],
                             ssd_d[l], ssd_norm[l], sc_conv_w[l], attn_q_norm[l], attn_k_norm[l],
                             cf_conv_w[l], cf_conv_b[l], cf_ln_g[l], cf_ln_b[l], w_out[l])
        h = rms_norm(x, norm_ca[l])
        x = x + memory_cross_attention(h, rms_norm(mem, norm_mem[l]), ca_wq[l], ca_wkv[l],
                                       ca_q_norm[l], ca_k_norm[l], ca_wo[l])
        h = rms_norm(x, norm_ffn[l])
        x = x + hierarchical_moe(h, router_group_w[l], router_group_b[l], router_expert_w[l],
                                 router_expert_b[l], exp_w_gate[l], exp_w_up[l], exp_w_down[l])
    return x
```

```cpp
#include <hip/hip_runtime.h>
#include <stdint.h>
#include <stdio.h>

typedef unsigned short bf16_t;
typedef short bf16x8 __attribute__((ext_vector_type(8)));
typedef float f32x4 __attribute__((ext_vector_type(4)));

constexpr int DM = 1024, BATCH = 2, SEQ = 16384, T = BATCH * SEQ, MEML = 256;
constexpr int NIN = 4358, NP = 4352;
constexpr int PC_Z = 0, PC_XBC = 384, PC_SCB = 1280, PC_SCC = 1664, PC_SCH = 2048, PC_Q = 2432, PC_K = 2816, PC_V = 3200, PC_CFA = 3584, PC_CFG = 3968;
constexpr int NEXP = 32, LISTCAP = 65536, PROWS = 65536 + 32 * 256;
constexpr size_t MiB = 1u << 20;
constexpr size_t WS_CTL = 0, WS_WIN = 1 * MiB, WS_WOUT = 10 * MiB, WS_WQ = 13 * MiB, WS_WO = 15 * MiB, WS_WKV = 17 * MiB, WS_MEMN = 25 * MiB, WS_KV = 26 * MiB;
constexpr size_t WS_PROJ = 33 * MiB, WS_Q = 33 * MiB, WS_O = 97 * MiB, WS_BUF = 33 * MiB, WS_YB = 33 * MiB, WS_HID = 177 * MiB;
constexpr size_t WS_CAT = 305 * MiB, WS_XN = 305 * MiB;
constexpr size_t WS_OBR = 401 * MiB, WS_LSE = 473 * MiB, WS_YS = 476 * MiB, WS_DT = 525 * MiB;
constexpr size_t WS_WGU = 401 * MiB, WS_WD = 465 * MiB;
constexpr size_t WS_LIST = 527 * MiB, WS_GATEL = 535 * MiB, WS_TOKDEST = 543 * MiB, WS_GATEBUF = 544 * MiB, WS_END = 545 * MiB;
constexpr int CW_CNT = 0, CW_NT = 64, CW_TILEE = 128;

__device__ __forceinline__ float bf2f(bf16_t v) { return __uint_as_float(((unsigned)v) << 16); }
__device__ __forceinline__ bf16_t f2bf(float f) { unsigned u = __float_as_uint(f); return (bf16_t)((u + 0x7fffu + ((u >> 16) & 1u)) >> 16); }
__device__ __forceinline__ float silu_f(float x) { return x / (1.f + expf(-x)); }
__device__ __forceinline__ float sigm_f(float x) { return 1.f / (1.f + expf(-x)); }
__device__ __forceinline__ float softplus_f(float x) { return fmaxf(x, 0.f) + log1pf(expf(-fabsf(x))); }

__device__ __forceinline__ float block_sum(float v, float* sh) {
    for (int o = 32; o > 0; o >>= 1) v += __shfl_xor(v, o);
    const int w = threadIdx.x >> 6, nw = (blockDim.x + 63) >> 6;
    __syncthreads();
    if ((threadIdx.x & 63) == 0) sh[w] = v;
    __syncthreads();
    float r = 0.f;
    for (int i = 0; i < nw; ++i) r += sh[i];
    return r;
}
__device__ __forceinline__ float block_max(float v, float* sh) {
    for (int o = 32; o > 0; o >>= 1) v = fmaxf(v, __shfl_xor(v, o));
    const int w = threadIdx.x >> 6, nw = (blockDim.x + 63) >> 6;
    __syncthreads();
    if ((threadIdx.x & 63) == 0) sh[w] = v;
    __syncthreads();
    float r = sh[0];
    for (int i = 1; i < nw; ++i) r = fmaxf(r, sh[i]);
    return r;
}

struct CvtJob { const float* src; const float* src2; const float* scale; bf16_t* dst; int K, N, ld, mode; size_t src_es, dst_es; };
__global__ void k_convert(CvtJob j) {
    __shared__ float tile[32][33];
    const int k0 = blockIdx.x * 32, n0 = blockIdx.y * 32, tx = threadIdx.x, ty = threadIdx.y;
    const float* s1 = j.src + (size_t)blockIdx.z * j.src_es;
    const float* s2 = j.src2 ? j.src2 + (size_t)blockIdx.z * j.src_es : nullptr;
    bf16_t* d = j.dst + (size_t)blockIdx.z * j.dst_es;
    for (int i = 0; i < 4; ++i) {
        const int k = k0 + ty + 8 * i, n = n0 + tx;
        float v;
        if (j.mode == 0) v = s1[(size_t)k * j.ld + n];
        else if (j.mode == 1) v = s1[(size_t)k * j.ld + n + (n >= 1280 ? 6 : 0)];
        else { const int c = (n >> 3) * 4 + (n & 3); v = (n & 4) ? s2[(size_t)k * j.ld + c] : s1[(size_t)k * j.ld + c]; }
        if (j.scale) v *= j.scale[k];
        tile[ty + 8 * i][tx] = v;
    }
    __syncthreads();
    for (int i = 0; i < 4; ++i) {
        const int n = n0 + ty + 8 * i, k = k0 + tx;
        d[(size_t)n * j.K + k] = f2bf(tile[tx][ty + 8 * i]);
    }
}

__global__ void k_memn(const float* mem, bf16_t* MEMN) {
    __shared__ float sh[32];
    const int m = blockIdx.x, tid = threadIdx.x;
    float v[4], ss = 0.f;
    for (int i = 0; i < 4; ++i) { v[i] = mem[(size_t)m * DM + tid + 256 * i]; ss += v[i] * v[i]; }
    ss = block_sum(ss, sh);
    const float rs = rsqrtf(ss / DM + 1e-6f);
    for (int i = 0; i < 4; ++i) MEMN[(size_t)m * DM + tid + 256 * i] = f2bf(v[i] * rs);
}
__global__ void k_knorm(bf16_t* KV, const float* kn  ) {
    __shared__ float sh[32];
    const int bid = blockIdx.x, h = bid & 3, l = (bid >> 2) & 1, m = bid >> 3, tid = threadIdx.x;
    bf16_t* p = KV + (size_t)m * 4096 + l * 2048 + h * 256 + tid;
    const float v = bf2f(*p);
    const float ss = block_sum(v * v, sh);
    *p = f2bf(v * rsqrtf(ss / 256.f + 1e-6f) * kn[l * 256 + tid]);
}

__global__ void k_norm1(const float* xin, float* X, bf16_t* XN, const bf16_t* YB, const int* TOKDEST,
                        const float* g, const float* w_in, float* DT, int first) {
    __shared__ float sh[32];
    const int t = blockIdx.x, tid = threadIdx.x;
    float v[4], ss = 0.f;
    int d0 = 0, d1 = 0;
    if (!first) { d0 = TOKDEST[2 * t]; d1 = TOKDEST[2 * t + 1]; }
#pragma unroll
    for (int i = 0; i < 4; ++i) {
        const int k = tid + 256 * i;
        if (first) v[i] = xin[(size_t)t * DM + k];
        else v[i] = X[(size_t)t * DM + k] + bf2f(YB[(size_t)d0 * DM + k]) + bf2f(YB[(size_t)d1 * DM + k]);
        X[(size_t)t * DM + k] = v[i];
        ss += v[i] * v[i];
    }
    ss = block_sum(ss, sh);
    const float rs = rsqrtf(ss / DM + 1e-6f);
    float part[6] = {0.f, 0.f, 0.f, 0.f, 0.f, 0.f};
#pragma unroll
    for (int i = 0; i < 4; ++i) {
        const int k = tid + 256 * i;
        XN[(size_t)t * DM + k] = f2bf(v[i] * rs);
        const float hv = v[i] * rs * g[k];
        for (int jj = 0; jj < 6; ++jj) part[jj] += hv * w_in[(size_t)k * NIN + 1280 + jj];
    }
    for (int jj = 0; jj < 6; ++jj) { const float s = block_sum(part[jj], sh); if (tid == 0) DT[(size_t)t * 8 + jj] = s; }
}
__global__ void k_norm2(const float* X, bf16_t* XN) {
    __shared__ float sh[32];
    const int t = blockIdx.x, tid = threadIdx.x;
    float v[4], ss = 0.f;
    for (int i = 0; i < 4; ++i) { v[i] = X[(size_t)t * DM + tid + 256 * i]; ss += v[i] * v[i]; }
    ss = block_sum(ss, sh);
    const float rs = rsqrtf(ss / DM + 1e-6f);
    for (int i = 0; i < 4; ++i) XN[(size_t)t * DM + tid + 256 * i] = f2bf(v[i] * rs);
}
__global__ void k_router(const float* X, bf16_t* XN, const float* g, const float* wg, const float* bg, const float* we, const float* be,
                         int* CNT, int* LIST, float* GATEL) {
    __shared__ float sh[32];
    __shared__ float lg[36];
    const int t = blockIdx.x, tid = threadIdx.x;
    float v[4], ss = 0.f;
    for (int i = 0; i < 4; ++i) { v[i] = X[(size_t)t * DM + tid + 256 * i]; ss += v[i] * v[i]; }
    ss = block_sum(ss, sh);
    const float rs = rsqrtf(ss / DM + 1e-6f);
    float hv[4];
    for (int i = 0; i < 4; ++i) { const int k = tid + 256 * i; XN[(size_t)t * DM + k] = f2bf(v[i] * rs); hv[i] = v[i] * rs * g[k]; }
    for (int c = 0; c < 36; ++c) {
        float p = 0.f;
        for (int i = 0; i < 4; ++i) { const int k = tid + 256 * i; p += hv[i] * (c < 4 ? wg[(size_t)k * 4 + c] : we[(size_t)k * 32 + (c - 4)]); }
        p = block_sum(p, sh);
        if (tid == 0) lg[c] = p + (c < 4 ? bg[c] : be[c - 4]);
    }
    __syncthreads();
    if (tid == 0) {
        int gi = 0;
        for (int i = 1; i < 4; ++i) if (lg[i] > lg[gi]) gi = i;
        float den = 0.f;
        for (int i = 0; i < 4; ++i) den += expf(lg[i] - lg[gi]);
        const float gp = 1.f / den;
        const float* le = lg + 4 + gi * 8;
        int i1 = 0;
        for (int i = 1; i < 8; ++i) if (le[i] > le[i1]) i1 = i;
        int i2 = (i1 == 0) ? 1 : 0;
        for (int i = 0; i < 8; ++i) if (i != i1 && le[i] > le[i2]) i2 = i;
        const float r = expf(le[i2] - le[i1]);
        const float g1 = gp / (1.f + r), g2 = gp * r / (1.f + r);
        const int e1 = gi * 8 + i1, e2 = gi * 8 + i2;
        const int p1 = atomicAdd(&CNT[e1], 1);
        LIST[(size_t)e1 * LISTCAP + p1] = t * 2; GATEL[(size_t)e1 * LISTCAP + p1] = g1;
        const int p2 = atomicAdd(&CNT[e2], 1);
        LIST[(size_t)e2 * LISTCAP + p2] = t * 2 + 1; GATEL[(size_t)e2 * LISTCAP + p2] = g2;
    }
}
__global__ void k_gather(const int* CNT, const int* LIST, const float* GATEL, const bf16_t* XN, bf16_t* BUF, float* GATEBUF, int* TOKDEST, int* NT, int* TILEE) {
    __shared__ int s_cnt[32], s_sp[33];
    const int tid = threadIdx.x, wave = tid >> 6, lane = tid & 63;
    if (tid < 32) s_cnt[tid] = CNT[tid];
    __syncthreads();
    if (tid == 0) { s_sp[0] = 0; for (int e = 0; e < 32; ++e) s_sp[e + 1] = s_sp[e] + ((s_cnt[e] + 255) / 256) * 256; }
    __syncthreads();
    if (blockIdx.x == 0 && tid == 0) *NT = s_sp[32] / 256;
    const int r = blockIdx.x * 4 + wave;
    if (r >= s_sp[32]) return;
    int e = 0;
    while (r >= s_sp[e + 1]) ++e;
    const int pos = r - s_sp[e];
    if ((r & 255) == 0 && lane == 0) TILEE[r >> 8] = e;
    uint4* dst = (uint4*)(BUF + (size_t)r * DM);
    if (pos < s_cnt[e]) {
        const int entry = LIST[(size_t)e * LISTCAP + pos];
        const uint4* src = (const uint4*)(XN + (size_t)(entry >> 1) * DM);
        dst[lane] = src[lane]; dst[lane + 64] = src[lane + 64];
        if (lane == 0) { GATEBUF[r] = GATEL[(size_t)e * LISTCAP + pos]; TOKDEST[entry] = r; }
    } else {
        const uint4 z = make_uint4(0, 0, 0, 0);
        dst[lane] = z; dst[lane + 64] = z;
        if (lane == 0) GATEBUF[r] = 0.f;
    }
}
__global__ void k_final(float* X, const bf16_t* YB, const int* TOKDEST) {
    const int t = blockIdx.x, tid = threadIdx.x;
    const int d0 = TOKDEST[2 * t], d1 = TOKDEST[2 * t + 1];
#pragma unroll
    for (int i = 0; i < 4; ++i) {
        const int k = tid + 256 * i;
        X[(size_t)t * DM + k] = X[(size_t)t * DM + k] + bf2f(YB[(size_t)d0 * DM + k]) + bf2f(YB[(size_t)d1 * DM + k]);
    }
}

struct EpiStoreBf16 { bf16_t* out; int ld; int pad; __device__ void operator()(int r, int c, float v) const { out[(size_t)r * ld + c] = f2bf(v); } };
struct EpiResAdd { float* X; __device__ void operator()(int r, int c, float v) const { X[(size_t)r * DM + c] += v; } };
struct EpiDown { bf16_t* YB; const float* GATEBUF; __device__ void operator()(int r, int c, float v) const { YB[(size_t)r * DM + c] = f2bf(v * GATEBUF[r]); } };

template <class Epi>
__global__ __launch_bounds__(256) void k_gemm(const bf16_t* A, const bf16_t* Bt, Epi epi, const int* tile_e, size_t bt_es, const int* nt_ptr, int K) {
    const int wave = threadIdx.x >> 6, lane = threadIdx.x & 63;
    if (nt_ptr && (int)(blockIdx.y * 128) >= *nt_ptr * 256) return;
    const int m0 = blockIdx.y * 128 + (wave >> 1) * 64, n0 = blockIdx.x * 128 + (wave & 1) * 64;
    const bf16_t* B = Bt;
    if (tile_e) B += (size_t)tile_e[blockIdx.y >> 1] * bt_es;
    const int r = lane & 15, q = lane >> 4;
    f32x4 acc[4][4];
    for (int i = 0; i < 4; ++i) for (int j = 0; j < 4; ++j) acc[i][j] = (f32x4){0.f, 0.f, 0.f, 0.f};
    for (int k0 = 0; k0 < K; k0 += 32) {
        bf16x8 a[4], b[4];
        for (int i = 0; i < 4; ++i) a[i] = *(const bf16x8*)(A + (size_t)(m0 + i * 16 + r) * K + k0 + q * 8);
        for (int j = 0; j < 4; ++j) b[j] = *(const bf16x8*)(B + (size_t)(n0 + j * 16 + r) * K + k0 + q * 8);
        for (int i = 0; i < 4; ++i) for (int j = 0; j < 4; ++j) acc[i][j] = __builtin_amdgcn_mfma_f32_16x16x32_bf16(a[i], b[j], acc[i][j], 0, 0, 0);
    }
    for (int i = 0; i < 4; ++i) for (int j = 0; j < 4; ++j) for (int e = 0; e < 4; ++e) epi(m0 + i * 16 + q * 4 + e, n0 + j * 16 + r, acc[i][j][e]);
}
__global__ __launch_bounds__(256) void k_gemm_gu(const bf16_t* A, const bf16_t* Bt, bf16_t* HID, const int* tile_e, size_t bt_es, const int* nt_ptr) {
    const int K = DM;
    const int wave = threadIdx.x >> 6, lane = threadIdx.x & 63;
    if ((int)(blockIdx.y * 128) >= *nt_ptr * 256) return;
    const int m0 = blockIdx.y * 128 + (wave >> 1) * 64, h0 = blockIdx.x * 128 + (wave & 1) * 64;
    const bf16_t* B = Bt + (size_t)tile_e[blockIdx.y >> 1] * bt_es;
    const int r = lane & 15, q = lane >> 4;
    f32x4 ag[4][4], au[4][4];
    for (int i = 0; i < 4; ++i) for (int j = 0; j < 4; ++j) { ag[i][j] = (f32x4){0.f, 0.f, 0.f, 0.f}; au[i][j] = (f32x4){0.f, 0.f, 0.f, 0.f}; }
    for (int k0 = 0; k0 < K; k0 += 32) {
        bf16x8 a[4], bg[4], bu[4];
        for (int i = 0; i < 4; ++i) a[i] = *(const bf16x8*)(A + (size_t)(m0 + i * 16 + r) * K + k0 + q * 8);
        for (int j = 0; j < 4; ++j) {
            const int hc = h0 + j * 16 + r, ng = 8 * (hc >> 2) + (hc & 3);
            bg[j] = *(const bf16x8*)(B + (size_t)ng * K + k0 + q * 8);
            bu[j] = *(const bf16x8*)(B + (size_t)(ng + 4) * K + k0 + q * 8);
        }
        for (int i = 0; i < 4; ++i) for (int j = 0; j < 4; ++j) {
            ag[i][j] = __builtin_amdgcn_mfma_f32_16x16x32_bf16(a[i], bg[j], ag[i][j], 0, 0, 0);
            au[i][j] = __builtin_amdgcn_mfma_f32_16x16x32_bf16(a[i], bu[j], au[i][j], 0, 0, 0);
        }
    }
    for (int i = 0; i < 4; ++i) for (int j = 0; j < 4; ++j) for (int e = 0; e < 4; ++e) {
        const int row = m0 + i * 16 + q * 4 + e, hc = h0 + j * 16 + r;
        HID[(size_t)row * 512 + hc] = f2bf(silu_f(ag[i][j][e]) * au[i][j][e]);
    }
}

__global__ __launch_bounds__(256) void k_qknorm(bf16_t* PROJ, const float* qn, const float* kn) {
    const int idx = blockIdx.x * 256 + threadIdx.x;
    const int t = idx / 12, hh = idx % 12, isk = hh >= 6, h = hh % 6;
    bf16_t* p = PROJ + (size_t)t * NP + (isk ? PC_K : PC_Q) + h * 64;
    float v[64], ss = 0.f;
    for (int i = 0; i < 64; ++i) { v[i] = bf2f(p[i]); ss += v[i] * v[i]; }
    const float rs = rsqrtf(ss / 64.f + 1e-6f) * (isk ? 1.f : 0.125f);
    const float* gn = isk ? kn : qn;
    for (int i = 0; i < 64; ++i) p[i] = f2bf(v[i] * rs * gn[i]);
}

__global__ __launch_bounds__(64) void k_ssd_naive(const bf16_t* PROJ, const float* DT, const float* conv_w, const float* conv_b, const float* dt_bias,
                                                  const float* a_log, const float* dvec, float* YS) {
    __shared__ float xc[32][64], Bc[32][128], Cc[32][128], dtv[32], av[32];
    const int b = blockIdx.x / 6, h = blockIdx.x % 6, g = h / 3, p = threadIdx.x;
    float hst[128];
#pragma unroll
    for (int n = 0; n < 128; ++n) hst[n] = 0.f;
    const float a_h = -expf(a_log[h]), Dh = dvec[h], dtb = dt_bias[h];
    for (int tb = 0; tb < SEQ; tb += 32) {
        __syncthreads();
        for (int idx = p; idx < 32 * 320; idx += 64) {
            const int tt = idx / 320, ch = idx % 320, t = tb + tt;
            const int ci = ch < 64 ? h * 64 + ch : (ch < 192 ? 384 + g * 128 + (ch - 64) : 640 + g * 128 + (ch - 192));
            float acc = conv_b[ci];
            for (int k = 0; k < 4; ++k) { const int tp = t - 3 + k; if (tp >= 0) acc += conv_w[k * 896 + ci] * bf2f(PROJ[(size_t)(b * SEQ + tp) * NP + PC_XBC + ci]); }
            const float v = silu_f(acc);
            if (ch < 64) xc[tt][ch] = v; else if (ch < 192) Bc[tt][ch - 64] = v; else Cc[tt][ch - 192] = v;
        }
        if (p < 32) { const float dt = softplus_f(DT[(size_t)(b * SEQ + tb + p) * 8 + h] + dtb); dtv[p] = dt; av[p] = expf(dt * a_h); }
        __syncthreads();
        for (int tt = 0; tt < 32; ++tt) {
            const float a = av[tt], xv = xc[tt][p], xd = xv * dtv[tt];
            float y = 0.f;
#pragma unroll
            for (int n = 0; n < 128; ++n) { hst[n] = hst[n] * a + Bc[tt][n] * xd; y += Cc[tt][n] * hst[n]; }
            YS[(size_t)(b * SEQ + tb + tt) * 384 + h * 64 + p] = y + xv * Dh;
        }
    }
}
__global__ void k_ssd_fin(const float* YS, const bf16_t* PROJ, const float* gn, bf16_t* CAT) {
    __shared__ float sh[32];
    const int t = blockIdx.x, c = threadIdx.x;
    const float v = YS[(size_t)t * 384 + c] * silu_f(bf2f(PROJ[(size_t)t * NP + PC_Z + c]));
    const float ss = block_sum(v * v, sh);
    CAT[(size_t)t * 1536 + c] = f2bf(v * rsqrtf(ss / 384.f + 1e-6f) * gn[c]);
}

__global__ __launch_bounds__(256) void k_attn_naive(const bf16_t* PROJ, bf16_t* OBR, float* LSE) {
    const int idx = blockIdx.x * 256 + threadIdx.x;
    const int h = idx % 6, t = (idx / 6) % T, br = idx / (6 * T);
    const int d = br == 0 ? 1 : (br == 1 ? 4 : 16);
    const int b = t / SEQ, tp = t % SEQ;
    float q[64], o[64];
    const bf16_t* qp = PROJ + (size_t)t * NP + PC_Q + h * 64;
    for (int i = 0; i < 64; ++i) { q[i] = bf2f(qp[i]); o[i] = 0.f; }
    float m = -INFINITY, l = 0.f;
    for (int j = 0; j <= 128; ++j) {
        const int kp = tp - j * d;
        if (kp < 0) break;
        const bf16_t* kr = PROJ + (size_t)(b * SEQ + kp) * NP + PC_K + h * 64;
        const bf16_t* vr = PROJ + (size_t)(b * SEQ + kp) * NP + PC_V + h * 64;
        float s = 0.f;
        for (int i = 0; i < 64; ++i) s += q[i] * bf2f(kr[i]);
        const float mn = fmaxf(m, s), corr = expf(m - mn), pw = expf(s - mn);
        l = l * corr + pw;
        for (int i = 0; i < 64; ++i) o[i] = o[i] * corr + pw * bf2f(vr[i]);
        m = mn;
    }
    const float il = 1.f / l;
    bf16_t* op = OBR + ((size_t)br * T + t) * 384 + h * 64;
    for (int i = 0; i < 64; ++i) op[i] = f2bf(o[i] * il);
    LSE[((size_t)br * T + t) * 6 + h] = m + logf(l);
}
__global__ void k_attn_comb(const bf16_t* OBR, const float* LSE, bf16_t* CAT) {
    const int idx = blockIdx.x * 256 + threadIdx.x;
    const int dd = idx & 63, h = (idx >> 6) % 6, t = idx / 384;
    const float l0 = LSE[((size_t)0 * T + t) * 6 + h], l1 = LSE[((size_t)1 * T + t) * 6 + h], l2 = LSE[((size_t)2 * T + t) * 6 + h];
    const float mx = fmaxf(l0, fmaxf(l1, l2));
    const float w0 = expf(l0 - mx), w1 = expf(l1 - mx), w2 = expf(l2 - mx), inv = 1.f / (w0 + w1 + w2);
    const size_t off = (size_t)t * 384 + h * 64 + dd;
    const float v = (w0 * bf2f(OBR[off]) + w1 * bf2f(OBR[(size_t)T * 384 + off]) + w2 * bf2f(OBR[(size_t)2 * T * 384 + off])) * inv;
    CAT[(size_t)t * 1536 + 768 + h * 64 + dd] = f2bf(v);
}
__global__ void k_cf_naive(const bf16_t* PROJ, const float* cw, const float* cb, const float* lng, const float* lnb, const float* scw, bf16_t* CAT) {
    __shared__ float sh[32];
    const int t = blockIdx.x, c = threadIdx.x, b = t / SEQ, tp = t % SEQ;
    float u = cb[c];
    for (int k = 0; k < 31; ++k) {
        const int tq = tp - 30 + k;
        if (tq >= 0) { const bf16_t* pr = PROJ + (size_t)(b * SEQ + tq) * NP; u += cw[k * 384 + c] * bf2f(pr[PC_CFA + c]) * sigm_f(bf2f(pr[PC_CFG + c])); }
    }
    const float mean = block_sum(u, sh) / 384.f, dl = u - mean;
    const float var = block_sum(dl * dl, sh) / 384.f;
    const float y = dl * rsqrtf(var + 1e-5f) * lng[c] + lnb[c];
    CAT[(size_t)t * 1536 + 1152 + c] = f2bf(silu_f(y));
    float s = 0.f;
    for (int k = 0; k < 3; ++k) {
        const int tq = tp - 2 + k;
        if (tq >= 0) { const bf16_t* pr = PROJ + (size_t)(b * SEQ + tq) * NP; s += scw[k * 384 + c] * bf2f(pr[PC_SCC + c]) * bf2f(pr[PC_SCH + c]); }
    }
    CAT[(size_t)t * 1536 + 384 + c] = f2bf(bf2f(PROJ[(size_t)t * NP + PC_SCB + c]) * s);
}
__global__ void k_ca_naive(const bf16_t* Q, const bf16_t* KV, const float* qn, bf16_t* O, int l) {
    __shared__ float sh[32];
    __shared__ float qs[256], ps[256];
    const int t = blockIdx.x >> 2, h = blockIdx.x & 3, b = t / SEQ, tid = threadIdx.x;
    const float qv = bf2f(Q[(size_t)t * DM + h * 256 + tid]);
    const float ss = block_sum(qv * qv, sh);
    qs[tid] = qv * rsqrtf(ss / 256.f + 1e-6f) * qn[tid] * 0.0625f;
    __syncthreads();
    const bf16_t* kr = KV + (size_t)(b * MEML + tid) * 4096 + l * 2048 + h * 256;
    float s = 0.f;
    for (int d = 0; d < 256; ++d) s += qs[d] * bf2f(kr[d]);
    const float mx = block_max(s, sh);
    const float p = expf(s - mx);
    const float sum = block_sum(p, sh);
    ps[tid] = p / sum;
    __syncthreads();
    float o = 0.f;
    for (int j = 0; j < 256; ++j) o += ps[j] * bf2f(KV[(size_t)(b * MEML + j) * 4096 + l * 2048 + 1024 + h * 256 + tid]);
    O[(size_t)t * DM + h * 256 + tid] = f2bf(o);
}

static void convert(hipStream_t s, const float* src, const float* src2, const float* scale, bf16_t* dst, int K, int N, int ld, int mode, int nz, size_t ses, size_t des) {
    CvtJob j{src, src2, scale, dst, K, N, ld, mode, ses, des};
    hipLaunchKernelGGL(k_convert, dim3(K / 32, N / 32, nz), dim3(32, 8), 0, s, j);
}

extern "C" void kernel_launch(void* const* d_in, const int* in_sizes, int n_in, void* d_out, int out_size, void* d_ws, size_t ws_size, hipStream_t stream) {
    if (n_in != 33 || ws_size < WS_END) { fprintf(stderr, "kernel_launch: bad n_in %d or ws %zu < %zu\n", n_in, ws_size, (size_t)WS_END); return; }
    const float* const* in = (const float* const*)d_in;
    char* ws = (char*)d_ws;
    float* X = (float*)d_out;
    int* CTL = (int*)(ws + WS_CTL);
    bf16_t *WIN = (bf16_t*)(ws + WS_WIN), *WOUT = (bf16_t*)(ws + WS_WOUT), *WQ = (bf16_t*)(ws + WS_WQ), *WO = (bf16_t*)(ws + WS_WO), *WKV = (bf16_t*)(ws + WS_WKV);
    bf16_t *MEMN = (bf16_t*)(ws + WS_MEMN), *KV = (bf16_t*)(ws + WS_KV), *PROJ = (bf16_t*)(ws + WS_PROJ), *Qb = (bf16_t*)(ws + WS_Q), *Ob = (bf16_t*)(ws + WS_O);
    bf16_t *BUF = (bf16_t*)(ws + WS_BUF), *YB = (bf16_t*)(ws + WS_YB), *HID = (bf16_t*)(ws + WS_HID), *CAT = (bf16_t*)(ws + WS_CAT), *XN = (bf16_t*)(ws + WS_XN);
    bf16_t *OBR = (bf16_t*)(ws + WS_OBR), *WGU = (bf16_t*)(ws + WS_WGU), *WD = (bf16_t*)(ws + WS_WD);
    float *LSE = (float*)(ws + WS_LSE), *YS = (float*)(ws + WS_YS), *DT = (float*)(ws + WS_DT), *GATEL = (float*)(ws + WS_GATEL), *GATEBUF = (float*)(ws + WS_GATEBUF);
    int *LIST = (int*)(ws + WS_LIST), *TOKDEST = (int*)(ws + WS_TOKDEST);

    hipLaunchKernelGGL(k_memn, dim3(BATCH * MEML), dim3(256), 0, stream, in[1], MEMN);
    for (int l = 0; l < 2; ++l)
        convert(stream, in[21] + (size_t)l * DM * 2048, nullptr, in[19] + l * DM, WKV + (size_t)l * 2048 * DM, DM, 2048, 2048, 0, 1, 0, 0);
    hipLaunchKernelGGL(k_gemm<EpiStoreBf16>, dim3(4096 / 128, 512 / 128), dim3(256), 0, stream, MEMN, WKV, EpiStoreBf16{KV, 4096, 0}, (const int*)nullptr, (size_t)0, (const int*)nullptr, DM);
    hipLaunchKernelGGL(k_knorm, dim3(512 * 8), dim3(256), 0, stream, KV, in[23]);

    for (int l = 0; l < 2; ++l) {
        convert(stream, in[3] + (size_t)l * DM * NIN, nullptr, in[2] + l * DM, WIN, DM, NP, NIN, 1, 1, 0, 0);
        convert(stream, in[17] + (size_t)l * 1536 * DM, nullptr, nullptr, WOUT, 1536, DM, DM, 0, 1, 0, 0);
        convert(stream, in[20] + (size_t)l * DM * DM, nullptr, in[18] + l * DM, WQ, DM, DM, DM, 0, 1, 0, 0);
        convert(stream, in[24] + (size_t)l * DM * DM, nullptr, nullptr, WO, DM, DM, DM, 0, 1, 0, 0);
        hipLaunchKernelGGL(k_norm1, dim3(T), dim3(256), 0, stream, in[0], X, XN, YB, TOKDEST, in[2] + l * DM, in[3] + (size_t)l * DM * NIN, DT, l == 0 ? 1 : 0);
        hipLaunchKernelGGL(k_gemm<EpiStoreBf16>, dim3(NP / 128, T / 128), dim3(256), 0, stream, XN, WIN, EpiStoreBf16{PROJ, NP, 0}, (const int*)nullptr, (size_t)0, (const int*)nullptr, DM);
        hipLaunchKernelGGL(k_qknorm, dim3(T * 12 / 256), dim3(256), 0, stream, PROJ, in[11] + l * 64, in[12] + l * 64);
        hipLaunchKernelGGL(k_ssd_naive, dim3(12), dim3(64), 0, stream, PROJ, DT, in[4] + l * 4 * 896, in[5] + l * 896, in[6] + l * 6, in[7] + l * 6, in[8] + l * 6, YS);
        hipLaunchKernelGGL(k_ssd_fin, dim3(T), dim3(384), 0, stream, YS, PROJ, in[9] + l * 384, CAT);
        hipLaunchKernelGGL(k_attn_naive, dim3(T * 18 / 256), dim3(256), 0, stream, PROJ, OBR, LSE);
        hipLaunchKernelGGL(k_attn_comb, dim3(T * 384 / 256), dim3(256), 0, stream, OBR, LSE, CAT);
        hipLaunchKernelGGL(k_cf_naive, dim3(T), dim3(384), 0, stream, PROJ, in[13] + l * 31 * 384, in[14] + l * 384, in[15] + l * 384, in[16] + l * 384, in[10] + l * 3 * 384, CAT);
        hipLaunchKernelGGL(k_gemm<EpiResAdd>, dim3(DM / 128, T / 128), dim3(256), 0, stream, CAT, WOUT, EpiResAdd{X}, (const int*)nullptr, (size_t)0, (const int*)nullptr, 1536);
        convert(stream, in[30] + (size_t)l * 32 * DM * 512, in[31] + (size_t)l * 32 * DM * 512, in[25] + l * DM, WGU, DM, 1024, 512, 2, 32, (size_t)DM * 512, (size_t)1024 * DM);
        convert(stream, in[32] + (size_t)l * 32 * 512 * DM, nullptr, nullptr, WD, 512, DM, DM, 0, 32, (size_t)512 * DM, (size_t)DM * 512);
        hipLaunchKernelGGL(k_norm2, dim3(T), dim3(256), 0, stream, X, XN);
        hipLaunchKernelGGL(k_gemm<EpiStoreBf16>, dim3(DM / 128, T / 128), dim3(256), 0, stream, XN, WQ, EpiStoreBf16{Qb, DM, 0}, (const int*)nullptr, (size_t)0, (const int*)nullptr, DM);
        hipLaunchKernelGGL(k_ca_naive, dim3(T * 4), dim3(256), 0, stream, Qb, KV, in[22] + l * 256, Ob, l);
        hipLaunchKernelGGL(k_gemm<EpiResAdd>, dim3(DM / 128, T / 128), dim3(256), 0, stream, Ob, WO, EpiResAdd{X}, (const int*)nullptr, (size_t)0, (const int*)nullptr, DM);
        (void)hipMemsetAsync(CTL, 0, 4096 * 4, stream);
        hipLaunchKernelGGL(k_router, dim3(T), dim3(256), 0, stream, X, XN, in[25] + l * DM, in[26] + (size_t)l * DM * 4, in[27] + l * 4, in[28] + (size_t)l * DM * 32, in[29] + l * 32,
                           CTL + CW_CNT, LIST, GATEL);
        hipLaunchKernelGGL(k_gather, dim3(PROWS / 4), dim3(256), 0, stream, CTL + CW_CNT, LIST, GATEL, XN, BUF, GATEBUF, TOKDEST, CTL + CW_NT, CTL + CW_TILEE);
        hipLaunchKernelGGL(k_gemm_gu, dim3(512 / 128, PROWS / 128), dim3(256), 0, stream, BUF, WGU, HID, CTL + CW_TILEE, (size_t)1024 * DM, CTL + CW_NT);
        hipLaunchKernelGGL(k_gemm<EpiDown>, dim3(DM / 128, PROWS / 128), dim3(256), 0, stream, HID, WD, EpiDown{YB, GATEBUF}, CTL + CW_TILEE, (size_t)DM * 512, CTL + CW_NT, 512);
    }
    hipLaunchKernelGGL(k_final, dim3(T), dim3(256), 0, stream, X, YB, TOKDEST);
}
```

```cpp
#include <hip/hip_runtime.h>
#include <stdint.h>
#include <stdio.h>

typedef unsigned short bf16_t;
typedef short bf16x8 __attribute__((ext_vector_type(8)));
typedef float f32x4 __attribute__((ext_vector_type(4)));

constexpr int DM = 1024, BATCH = 2, SEQ = 16384, T = BATCH * SEQ, MEML = 256;
constexpr int NIN = 4358, NP = 4352;
constexpr int PC_Z = 0, PC_XBC = 384, PC_SCB = 1280, PC_SCC = 1664, PC_SCH = 2048, PC_Q = 2432, PC_K = 2816, PC_V = 3200, PC_CFA = 3584, PC_CFG = 3968;
constexpr int NEXP = 32, LISTCAP = 65536, PROWS = 65536 + 32 * 256;
constexpr size_t MiB = 1u << 20;
constexpr size_t WS_CTL = 0, WS_WIN = 1 * MiB, WS_WOUT = 10 * MiB, WS_WQ = 13 * MiB, WS_WO = 15 * MiB, WS_WKV = 17 * MiB, WS_MEMN = 25 * MiB, WS_KV = 26 * MiB;
constexpr size_t WS_PROJ = 33 * MiB, WS_Q = 33 * MiB, WS_O = 97 * MiB, WS_BUF = 33 * MiB, WS_YB = 33 * MiB, WS_HID = 177 * MiB;
constexpr size_t WS_CAT = 305 * MiB, WS_XN = 305 * MiB;
constexpr size_t WS_OBR = 401 * MiB, WS_LSE = 473 * MiB, WS_YS = 476 * MiB, WS_DT = 525 * MiB;
constexpr size_t WS_WGU = 401 * MiB, WS_WD = 465 * MiB;
constexpr size_t WS_LIST = 527 * MiB, WS_GATEL = 535 * MiB, WS_TOKDEST = 543 * MiB, WS_GATEBUF = 544 * MiB, WS_END = 545 * MiB;
constexpr int CW_CNT = 0, CW_NT = 64, CW_TILEE = 128;

__device__ __forceinline__ float bf2f(bf16_t v) { return __uint_as_float(((unsigned)v) << 16); }
__device__ __forceinline__ bf16_t f2bf(float f) { unsigned u = __float_as_uint(f); return (bf16_t)((u + 0x7fffu + ((u >> 16) & 1u)) >> 16); }
__device__ __forceinline__ float silu_f(float x) { return x / (1.f + expf(-x)); }
__device__ __forceinline__ float sigm_f(float x) { return 1.f / (1.f + expf(-x)); }
__device__ __forceinline__ float softplus_f(float x) { return fmaxf(x, 0.f) + log1pf(expf(-fabsf(x))); }

__device__ __forceinline__ float block_sum(float v, float* sh) {
    for (int o = 32; o > 0; o >>= 1) v += __shfl_xor(v, o);
    const int w = threadIdx.x >> 6, nw = (blockDim.x + 63) >> 6;
    __syncthreads();
    if ((threadIdx.x & 63) == 0) sh[w] = v;
    __syncthreads();
    float r = 0.f;
    for (int i = 0; i < nw; ++i) r += sh[i];
    return r;
}
__device__ __forceinline__ float block_max(float v, float* sh) {
    for (int o = 32; o > 0; o >>= 1) v = fmaxf(v, __shfl_xor(v, o));
    const int w = threadIdx.x >> 6, nw = (blockDim.x + 63) >> 6;
    __syncthreads();
    if ((threadIdx.x & 63) == 0) sh[w] = v;
    __syncthreads();
    float r = sh[0];
    for (int i = 1; i < nw; ++i) r = fmaxf(r, sh[i]);
    return r;
}

struct CvtJob { const float* src; const float* src2; const float* scale; bf16_t* dst; int K, N, ld, mode; size_t src_es, dst_es; };
__global__ void k_convert(CvtJob j) {
    __shared__ float tile[32][33];
    const int k0 = blockIdx.x * 32, n0 = blockIdx.y * 32, tx = threadIdx.x, ty = threadIdx.y;
    const float* s1 = j.src + (size_t)blockIdx.z * j.src_es;
    const float* s2 = j.src2 ? j.src2 + (size_t)blockIdx.z * j.src_es : nullptr;
    bf16_t* d = j.dst + (size_t)blockIdx.z * j.dst_es;
    for (int i = 0; i < 4; ++i) {
        const int k = k0 + ty + 8 * i, n = n0 + tx;
        float v;
        if (j.mode == 0) v = s1[(size_t)k * j.ld + n];
        else if (j.mode == 1) v = s1[(size_t)k * j.ld + n + (n >= 1280 ? 6 : 0)];
        else { const int c = (n >> 3) * 4 + (n & 3); v = (n & 4) ? s2[(size_t)k * j.ld + c] : s1[(size_t)k * j.ld + c]; }
        if (j.scale) v *= j.scale[k];
        tile[ty + 8 * i][tx] = v;
    }
    __syncthreads();
    for (int i = 0; i < 4; ++i) {
        const int n = n0 + ty + 8 * i, k = k0 + tx;
        d[(size_t)n * j.K + k] = f2bf(tile[tx][ty + 8 * i]);
    }
}

__global__ void k_memn(const float* mem, bf16_t* MEMN) {
    __shared__ float sh[32];
    const int m = blockIdx.x, tid = threadIdx.x;
    float v[4], ss = 0.f;
    for (int i = 0; i < 4; ++i) { v[i] = mem[(size_t)m * DM + tid + 256 * i]; ss += v[i] * v[i]; }
    ss = block_sum(ss, sh);
    const float rs = rsqrtf(ss / DM + 1e-6f);
    for (int i = 0; i < 4; ++i) MEMN[(size_t)m * DM + tid + 256 * i] = f2bf(v[i] * rs);
}
__global__ void k_knorm(bf16_t* KV, const float* kn  ) {
    __shared__ float sh[32];
    const int bid = blockIdx.x, h = bid & 3, l = (bid >> 2) & 1, m = bid >> 3, tid = threadIdx.x;
    bf16_t* p = KV + (size_t)m * 4096 + l * 2048 + h * 256 + tid;
    const float v = bf2f(*p);
    const float ss = block_sum(v * v, sh);
    *p = f2bf(v * rsqrtf(ss / 256.f + 1e-6f) * kn[l * 256 + tid]);
}

__global__ void k_norm1(const float* xin, float* X, bf16_t* XN, const bf16_t* YB, const int* TOKDEST,
                        const float* g, const float* w_in, float* DT, int first) {
    __shared__ float sh[32];
    const int t = blockIdx.x, tid = threadIdx.x;
    float v[4], ss = 0.f;
    int d0 = 0, d1 = 0;
    if (!first) { d0 = TOKDEST[2 * t]; d1 = TOKDEST[2 * t + 1]; }
#pragma unroll
    for (int i = 0; i < 4; ++i) {
        const int k = tid + 256 * i;
        if (first) v[i] = xin[(size_t)t * DM + k];
        else v[i] = X[(size_t)t * DM + k] + bf2f(YB[(size_t)d0 * DM + k]) + bf2f(YB[(size_t)d1 * DM + k]);
        X[(size_t)t * DM + k] = v[i];
        ss += v[i] * v[i];
    }
    ss = block_sum(ss, sh);
    const float rs = rsqrtf(ss / DM + 1e-6f);
    float part[6] = {0.f, 0.f, 0.f, 0.f, 0.f, 0.f};
#pragma unroll
    for (int i = 0; i < 4; ++i) {
        const int k = tid + 256 * i;
        XN[(size_t)t * DM + k] = f2bf(v[i] * rs);
        const float hv = v[i] * rs * g[k];
        for (int jj = 0; jj < 6; ++jj) part[jj] += hv * w_in[(size_t)k * NIN + 1280 + jj];
    }
    for (int jj = 0; jj < 6; ++jj) { const float s = block_sum(part[jj], sh); if (tid == 0) DT[(size_t)t * 8 + jj] = s; }
}
__global__ void k_norm2(const float* X, bf16_t* XN) {
    __shared__ float sh[32];
    const int t = blockIdx.x, tid = threadIdx.x;
    float v[4], ss = 0.f;
    for (int i = 0; i < 4; ++i) { v[i] = X[(size_t)t * DM + tid + 256 * i]; ss += v[i] * v[i]; }
    ss = block_sum(ss, sh);
    const float rs = rsqrtf(ss / DM + 1e-6f);
    for (int i = 0; i < 4; ++i) XN[(size_t)t * DM + tid + 256 * i] = f2bf(v[i] * rs);
}
__global__ void k_router(const float* X, bf16_t* XN, const float* g, const float* wg, const float* bg, const float* we, const float* be,
                         int* CNT, int* LIST, float* GATEL) {
    __shared__ float sh[32];
    __shared__ float lg[36];
    const int t = blockIdx.x, tid = threadIdx.x;
    float v[4], ss = 0.f;
    for (int i = 0; i < 4; ++i) { v[i] = X[(size_t)t * DM + tid + 256 * i]; ss += v[i] * v[i]; }
    ss = block_sum(ss, sh);
    const float rs = rsqrtf(ss / DM + 1e-6f);
    float hv[4];
    for (int i = 0; i < 4; ++i) { const int k = tid + 256 * i; XN[(size_t)t * DM + k] = f2bf(v[i] * rs); hv[i] = v[i] * rs * g[k]; }
    for (int c = 0; c < 36; ++c) {
        float p = 0.f;
        for (int i = 0; i < 4; ++i) { const int k = tid + 256 * i; p += hv[i] * (c < 4 ? wg[(size_t)k * 4 + c] : we[(size_t)k * 32 + (c - 4)]); }
        p = block_sum(p, sh);
        if (tid == 0) lg[c] = p + (c < 4 ? bg[c] : be[c - 4]);
    }
    __syncthreads();
    if (tid == 0) {
        int gi = 0;
        for (int i = 1; i < 4; ++i) if (lg[i] > lg[gi]) gi = i;
        float den = 0.f;
        for (int i = 0; i < 4; ++i) den += expf(lg[i] - lg[gi]);
        const float gp = 1.f / den;
        const float* le = lg + 4 + gi * 8;
        int i1 = 0;
        for (int i = 1; i < 8; ++i) if (le[i] > le[i1]) i1 = i;
        int i2 = (i1 == 0) ? 1 : 0;
        for (int i = 0; i < 8; ++i) if (i != i1 && le[i] > le[i2]) i2 = i;
        const float r = expf(le[i2] - le[i1]);
        const float g1 = gp / (1.f + r), g2 = gp * r / (1.f + r);
        const int e1 = gi * 8 + i1, e2 = gi * 8 + i2;
        const int p1 = atomicAdd(&CNT[e1], 1);
        LIST[(size_t)e1 * LISTCAP + p1] = t * 2; GATEL[(size_t)e1 * LISTCAP + p1] = g1;
        const int p2 = atomicAdd(&CNT[e2], 1);
        LIST[(size_t)e2 * LISTCAP + p2] = t * 2 + 1; GATEL[(size_t)e2 * LISTCAP + p2] = g2;
    }
}
__global__ void k_gather(const int* CNT, const int* LIST, const float* GATEL, const bf16_t* XN, bf16_t* BUF, float* GATEBUF, int* TOKDEST, int* NT, int* TILEE) {
    __shared__ int s_cnt[32], s_sp[33];
    const int tid = threadIdx.x, wave = tid >> 6, lane = tid & 63;
    if (tid < 32) s_cnt[tid] = CNT[tid];
    __syncthreads();
    if (tid == 0) { s_sp[0] = 0; for (int e = 0; e < 32; ++e) s_sp[e + 1] = s_sp[e] + ((s_cnt[e] + 255) / 256) * 256; }
    __syncthreads();
    if (blockIdx.x == 0 && tid == 0) *NT = s_sp[32] / 256;
    const int r = blockIdx.x * 4 + wave;
    if (r >= s_sp[32]) return;
    int e = 0;
    while (r >= s_sp[e + 1]) ++e;
    const int pos = r - s_sp[e];
    if ((r & 255) == 0 && lane == 0) TILEE[r >> 8] = e;
    uint4* dst = (uint4*)(BUF + (size_t)r * DM);
    if (pos < s_cnt[e]) {
        const int entry = LIST[(size_t)e * LISTCAP + pos];
        const uint4* src = (const uint4*)(XN + (size_t)(entry >> 1) * DM);
        dst[lane] = src[lane]; dst[lane + 64] = src[lane + 64];
        if (lane == 0) { GATEBUF[r] = GATEL[(size_t)e * LISTCAP + pos]; TOKDEST[entry] = r; }
    } else {
        const uint4 z = make_uint4(0, 0, 0, 0);
        dst[lane] = z; dst[lane + 64] = z;
        if (lane == 0) GATEBUF[r] = 0.f;
    }
}
__global__ void k_final(float* X, const bf16_t* YB, const int* TOKDEST) {
    const int t = blockIdx.x, tid = threadIdx.x;
    const int d0 = TOKDEST[2 * t], d1 = TOKDEST[2 * t + 1];
#pragma unroll
    for (int i = 0; i < 4; ++i) {
        const int k = tid + 256 * i;
        X[(size_t)t * DM + k] = X[(size_t)t * DM + k] + bf2f(YB[(size_t)d0 * DM + k]) + bf2f(YB[(size_t)d1 * DM + k]);
    }
}

struct EpiStoreBf16 { bf16_t* out; int ld; int pad; __device__ void operator()(int r, int c, float v) const { out[(size_t)r * ld + c] = f2bf(v); } };
struct EpiResAdd { float* X; __device__ void operator()(int r, int c, float v) const { X[(size_t)r * DM + c] += v; } };
struct EpiDown { bf16_t* YB; const float* GATEBUF; __device__ void operator()(int r, int c, float v) const { YB[(size_t)r * DM + c] = f2bf(v * GATEBUF[r]); } };

template <class Epi>
__global__ __launch_bounds__(256) void k_gemm(const bf16_t* A, const bf16_t* Bt, Epi epi, const int* tile_e, size_t bt_es, const int* nt_ptr, int K) {
    const int wave = threadIdx.x >> 6, lane = threadIdx.x & 63;
    if (nt_ptr && (int)(blockIdx.y * 128) >= *nt_ptr * 256) return;
    const int m0 = blockIdx.y * 128 + (wave >> 1) * 64, n0 = blockIdx.x * 128 + (wave & 1) * 64;
    const bf16_t* B = Bt;
    if (tile_e) B += (size_t)tile_e[blockIdx.y >> 1] * bt_es;
    const int r = lane & 15, q = lane >> 4;
    f32x4 acc[4][4];
    for (int i = 0; i < 4; ++i) for (int j = 0; j < 4; ++j) acc[i][j] = (f32x4){0.f, 0.f, 0.f, 0.f};
    for (int k0 = 0; k0 < K; k0 += 32) {
        bf16x8 a[4], b[4];
        for (int i = 0; i < 4; ++i) a[i] = *(const bf16x8*)(A + (size_t)(m0 + i * 16 + r) * K + k0 + q * 8);
        for (int j = 0; j < 4; ++j) b[j] = *(const bf16x8*)(B + (size_t)(n0 + j * 16 + r) * K + k0 + q * 8);
        for (int i = 0; i < 4; ++i) for (int j = 0; j < 4; ++j) acc[i][j] = __builtin_amdgcn_mfma_f32_16x16x32_bf16(a[i], b[j], acc[i][j], 0, 0, 0);
    }
    for (int i = 0; i < 4; ++i) for (int j = 0; j < 4; ++j) for (int e = 0; e < 4; ++e) epi(m0 + i * 16 + q * 4 + e, n0 + j * 16 + r, acc[i][j][e]);
}
__global__ __launch_bounds__(256) void k_gemm_gu(const bf16_t* A, const bf16_t* Bt, bf16_t* HID, const int* tile_e, size_t bt_es, const int* nt_ptr) {
    const int K = DM;
    const int wave = threadIdx.x >> 6, lane = threadIdx.x & 63;
    if ((int)(blockIdx.y * 128) >= *nt_ptr * 256) return;
    const int m0 = blockIdx.y * 128 + (wave >> 1) * 64, h0 = blockIdx.x * 128 + (wave & 1) * 64;
    const bf16_t* B = Bt + (size_t)tile_e[blockIdx.y >> 1] * bt_es;
    const int r = lane & 15, q = lane >> 4;
    f32x4 ag[4][4], au[4][4];
    for (int i = 0; i < 4; ++i) for (int j = 0; j < 4; ++j) { ag[i][j] = (f32x4){0.f, 0.f, 0.f, 0.f}; au[i][j] = (f32x4){0.f, 0.f, 0.f, 0.f}; }
    for (int k0 = 0; k0 < K; k0 += 32) {
        bf16x8 a[4], bg[4], bu[4];
        for (int i = 0; i < 4; ++i) a[i] = *(const bf16x8*)(A + (size_t)(m0 + i * 16 + r) * K + k0 + q * 8);
        for (int j = 0; j < 4; ++j) {
            const int hc = h0 + j * 16 + r, ng = 8 * (hc >> 2) + (hc & 3);
            bg[j] = *(const bf16x8*)(B + (size_t)ng * K + k0 + q * 8);
            bu[j] = *(const bf16x8*)(B + (size_t)(ng + 4) * K + k0 + q * 8);
        }
        for (int i = 0; i < 4; ++i) for (int j = 0; j < 4; ++j) {
            ag[i][j] = __builtin_amdgcn_mfma_f32_16x16x32_bf16(a[i], bg[j], ag[i][j], 0, 0, 0);
            au[i][j] = __builtin_amdgcn_mfma_f32_16x16x32_bf16(a[i], bu[j], au[i][j], 0, 0, 0);
        }
    }
    for (int i = 0; i < 4; ++i) for (int j = 0; j < 4; ++j) for (int e = 0; e < 4; ++e) {
        const int row = m0 + i * 16 + q * 4 + e, hc = h0 + j * 16 + r;
        HID[(size_t)row * 512 + hc] = f2bf(silu_f(ag[i][j][e]) * au[i][j][e]);
    }
}

__global__ __launch_bounds__(256) void k_qknorm(bf16_t* PROJ, const float* qn, const float* kn) {
    const int idx = blockIdx.x * 256 + threadIdx.x;
    const int t = idx / 12, hh = idx % 12, isk = hh >= 6, h = hh % 6;
    bf16_t* p = PROJ + (size_t)t * NP + (isk ? PC_K : PC_Q) + h * 64;
    float v[64], ss = 0.f;
    for (int i = 0; i < 64; ++i) { v[i] = bf2f(p[i]); ss += v[i] * v[i]; }
    const float rs = rsqrtf(ss / 64.f + 1e-6f) * (isk ? 1.f : 0.125f);
    const float* gn = isk ? kn : qn;
    for (int i = 0; i < 64; ++i) p[i] = f2bf(v[i] * rs * gn[i]);
}

__global__ __launch_bounds__(64) void k_ssd_naive(const bf16_t* PROJ, const float* DT, const float* conv_w, const float* conv_b, const float* dt_bias,
                                                  const float* a_log, const float* dvec, float* YS) {
    __shared__ float xc[32][64], Bc[32][128], Cc[32][128], dtv[32], av[32];
    const int b = blockIdx.x / 6, h = blockIdx.x % 6, g = h / 3, p = threadIdx.x;
    float hst[128];
#pragma unroll
    for (int n = 0; n < 128; ++n) hst[n] = 0.f;
    const float a_h = -expf(a_log[h]), Dh = dvec[h], dtb = dt_bias[h];
    for (int tb = 0; tb < SEQ; tb += 32) {
        __syncthreads();
        for (int idx = p; idx < 32 * 320; idx += 64) {
            const int tt = idx / 320, ch = idx % 320, t = tb + tt;
            const int ci = ch < 64 ? h * 64 + ch : (ch < 192 ? 384 + g * 128 + (ch - 64) : 640 + g * 128 + (ch - 192));
            float acc = conv_b[ci];
            for (int k = 0; k < 4; ++k) { const int tp = t - 3 + k; if (tp >= 0) acc += conv_w[k * 896 + ci] * bf2f(PROJ[(size_t)(b * SEQ + tp) * NP + PC_XBC + ci]); }
            const float v = silu_f(acc);
            if (ch < 64) xc[tt][ch] = v; else if (ch < 192) Bc[tt][ch - 64] = v; else Cc[tt][ch - 192] = v;
        }
        if (p < 32) { const float dt = softplus_f(DT[(size_t)(b * SEQ + tb + p) * 8 + h] + dtb); dtv[p] = dt; av[p] = expf(dt * a_h); }
        __syncthreads();
        for (int tt = 0; tt < 32; ++tt) {
            const float a = av[tt], xv = xc[tt][p], xd = xv * dtv[tt];
            float y = 0.f;
#pragma unroll
            for (int n = 0; n < 128; ++n) { hst[n] = hst[n] * a + Bc[tt][n] * xd; y += Cc[tt][n] * hst[n]; }
            YS[(size_t)(b * SEQ + tb + tt) * 384 + h * 64 + p] = y + xv * Dh;
        }
    }
}
__global__ void k_ssd_fin(const float* YS, const bf16_t* PROJ, const float* gn, bf16_t* CAT) {
    __shared__ float sh[32];
    const int t = blockIdx.x, c = threadIdx.x;
    const float v = YS[(size_t)t * 384 + c] * silu_f(bf2f(PROJ[(size_t)t * NP + PC_Z + c]));
    const float ss = block_sum(v * v, sh);
    CAT[(size_t)t * 1536 + c] = f2bf(v * rsqrtf(ss / 384.f + 1e-6f) * gn[c]);
}

__global__ __launch_bounds__(256) void k_attn_naive(const bf16_t* PROJ, bf16_t* OBR, float* LSE) {
    const int idx = blockIdx.x * 256 + threadIdx.x;
    const int h = idx % 6, t = (idx / 6) % T, br = idx / (6 * T);
    const int d = br == 0 ? 1 : (br == 1 ? 4 : 16);
    const int b = t / SEQ, tp = t % SEQ;
    float q[64], o[64];
    const bf16_t* qp = PROJ + (size_t)t * NP + PC_Q + h * 64;
    for (int i = 0; i < 64; ++i) { q[i] = bf2f(qp[i]); o[i] = 0.f; }
    float m = -INFINITY, l = 0.f;
    for (int j = 0; j <= 128; ++j) {
        const int kp = tp - j * d;
        if (kp < 0) break;
        const bf16_t* kr = PROJ + (size_t)(b * SEQ + kp) * NP + PC_K + h * 64;
        const bf16_t* vr = PROJ + (size_t)(b * SEQ + kp) * NP + PC_V + h * 64;
        float s = 0.f;
        for (int i = 0; i < 64; ++i) s += q[i] * bf2f(kr[i]);
        const float mn = fmaxf(m, s), corr = expf(m - mn), pw = expf(s - mn);
        l = l * corr + pw;
        for (int i = 0; i < 64; ++i) o[i] = o[i] * corr + pw * bf2f(vr[i]);
        m = mn;
    }
    const float il = 1.f / l;
    bf16_t* op = OBR + ((size_t)br * T + t) * 384 + h * 64;
    for (int i = 0; i < 64; ++i) op[i] = f2bf(o[i] * il);
    LSE[((size_t)br * T + t) * 6 + h] = m + logf(l);
}
__global__ void k_attn_comb(const bf16_t* OBR, const float* LSE, bf16_t* CAT) {
    const int idx = blockIdx.x * 256 + threadIdx.x;
    const int dd = idx & 63, h = (idx >> 6) % 6, t = idx / 384;
    const float l0 = LSE[((size_t)0 * T + t) * 6 + h], l1 = LSE[((size_t)1 * T + t) * 6 + h], l2 = LSE[((size_t)2 * T + t) * 6 + h];
    const float mx = fmaxf(l0, fmaxf(l1, l2));
    const float w0 = expf(l0 - mx), w1 = expf(l1 - mx), w2 = expf(l2 - mx), inv = 1.f / (w0 + w1 + w2);
    const size_t off = (size_t)t * 384 + h * 64 + dd;
    const float v = (w0 * bf2f(OBR[off]) + w1 * bf2f(OBR[(size_t)T * 384 + off]) + w2 * bf2f(OBR[(size_t)2 * T * 384 + off])) * inv;
    CAT[(size_t)t * 1536 + 768 + h * 64 + dd] = f2bf(v);
}
__global__ void k_cf_naive(const bf16_t* PROJ, const float* cw, const float* cb, const float* lng, const float* lnb, const float* scw, bf16_t* CAT) {
    __shared__ float sh[32];
    const int t = blockIdx.x, c = threadIdx.x, b = t / SEQ, tp = t % SEQ;
    float u = cb[c];
    for (int k = 0; k < 31; ++k) {
        const int tq = tp - 30 + k;
        if (tq >= 0) { const bf16_t* pr = PROJ + (size_t)(b * SEQ + tq) * NP; u += cw[k * 384 + c] * bf2f(pr[PC_CFA + c]) * sigm_f(bf2f(pr[PC_CFG + c])); }
    }
    const float mean = block_sum(u, sh) / 384.f, dl = u - mean;
    const float var = block_sum(dl * dl, sh) / 384.f;
    const float y = dl * rsqrtf(var + 1e-5f) * lng[c] + lnb[c];
    CAT[(size_t)t * 1536 + 1152 + c] = f2bf(silu_f(y));
    float s = 0.f;
    for (int k = 0; k < 3; ++k) {
        const int tq = tp - 2 + k;
        if (tq >= 0) { const bf16_t* pr = PROJ + (size_t)(b * SEQ + tq) * NP; s += scw[k * 384 + c] * bf2f(pr[PC_SCC + c]) * bf2f(pr[PC_SCH + c]); }
    }
    CAT[(size_t)t * 1536 + 384 + c] = f2bf(bf2f(PROJ[(size_t)t * NP + PC_SCB + c]) * s);
}
__global__ void k_ca_naive(const bf16_t* Q, const bf16_t* KV, const float* qn, bf16_t* O, int l) {
    __shared__ float sh[32];
    __shared__ float qs[256], ps[256];
    const int t = blockIdx.x >> 2, h = blockIdx.x & 3, b = t / SEQ, tid = threadIdx.x;
    const float qv = bf2f(Q[(size_t)t * DM + h * 256 + tid]);
    const float ss = block_sum(qv * qv, sh);
    qs[tid] = qv * rsqrtf(ss / 256.f + 1e-6f) * qn[tid] * 0.0625f;
    __syncthreads();
    const bf16_t* kr = KV + (size_t)(b * MEML + tid) * 4096 + l * 2048 + h * 256;
    float s = 0.f;
    for (int d = 0; d < 256; ++d) s += qs[d] * bf2f(kr[d]);
    const float mx = block_max(s, sh);
    const float p = expf(s - mx);
    const float sum = block_sum(p, sh);
    ps[tid] = p / sum;
    __syncthreads();
    float o = 0.f;
    for (int j = 0; j < 256; ++j) o += ps[j] * bf2f(KV[(size_t)(b * MEML + j) * 4096 + l * 2048 + 1024 + h * 256 + tid]);
    O[(size_t)t * DM + h * 256 + tid] = f2bf(o);
}

namespace pg8 {
#define PG8_LAS __attribute__((address_space(3)))
typedef unsigned short bf16_t;
typedef short bf16x8 __attribute__((ext_vector_type(8)));
typedef float f32x4 __attribute__((ext_vector_type(4)));
typedef unsigned u32x4 __attribute__((ext_vector_type(4)));
constexpr int BM = 256, BK = 64, HALF = 128, HTB = HALF * BK * 2  , STAGE_BYTES = 8 * HTB, NXCD = 8, WGM = 8;

__host__ __device__ __forceinline__ int lds_byte(int r, int c) { const int st = (r >> 4) * 2 + (c >> 5), rr = r & 15, cc = c & 31, ob = rr * 64 + cc * 2; return st * 1024 + (ob ^ (((ob >> 9) & 1) << 5)); }
__host__ __device__ __forceinline__ void stage_rc(int b, int& R, int& C) { const int st = b / 1024, sb = b % 1024, swz = sb ^ (((sb >> 9) & 1) << 5); R = (st >> 1) * 16 + swz / 64; C = (st & 1) * 32 + (swz % 64) / 2; }
__host__ __device__ __forceinline__ int perm32(int rho) { const int n = rho >> 4, i = rho & 15; return 8 * (i >> 2) + 4 * n + (i & 3); }

struct Unit { int pm, pn; };
struct Gemm { const bf16_t* A; const bf16_t* Bt; int M, N, K; };

struct StaticOrder {
    int nM, nN, nwg, G, c;
    __host__ __device__ void init(int M, int N, int G_, int c_) { nM = M / BM; nN = N / BM; nwg = nM * nN; G = G_; c = c_; }
    __host__ __device__ bool next(int i, Unit& u) const {
        const long L = (long)i * G + c; if (L >= nwg) return false;
        int wgid = (int)L; { const int q = nwg / NXCD, r = nwg % NXCD, xcd = wgid % NXCD, off = wgid / NXCD; wgid = (xcd < r ? xcd * (q + 1) : r * (q + 1) + (xcd - r) * q) + off; }
        const int nig = WGM * nN, gid = wgid / nig, fm = gid * WGM, gsz = (nM - fm) < WGM ? (nM - fm) : WGM;
        u.pm = fm + ((wgid % nig) % gsz); u.pn = (wgid % nig) / gsz; return true;
    }
    __device__ __forceinline__ void a_ready(const Unit&) const {}
    __device__ __forceinline__ const char* b_base(const Gemm& g, const Unit&) const { return (const char*)g.Bt; }
    __device__ __forceinline__ void done(const Unit&) const {}
};

__device__ __forceinline__ unsigned cvt_pk_bf16(float lo, float hi) { unsigned r; asm volatile("v_cvt_pk_bf16_f32 %0, %1, %2" : "=v"(r) : "v"(lo), "v"(hi)); return r; }
typedef float f32x2 __attribute__((ext_vector_type(2)));
__device__ __forceinline__ f32x2 gelu_pk(f32x2 v) {
    const f32x2 av = __builtin_elementwise_abs(v), d = av * 0.2316418882f + 1.0f;
    f32x2 t; t.x = __builtin_amdgcn_rcpf(d.x); t.y = __builtin_amdgcn_rcpf(d.y);
    f32x2 q = t * 0.5307027145f + (-0.7265760135f); q = q * t + 0.7107068705f; q = q * t + (-0.142248368f); q = q * t + 0.127414796f; q = q * t;
    const f32x2 s = (v * v) * (-0.72134752044f);
    f32x2 e; e.x = __builtin_amdgcn_exp2f(s.x); e.y = __builtin_amdgcn_exp2f(s.y);
    const f32x2 m = v * (q * e), r = v - m;
    f32x2 o; o.x = v.x < 0.f ? m.x : r.x; o.y = v.y < 0.f ? m.y : r.y; return o;
}

template <int ACT  > struct EpiBf16 {
    static constexpr bool PERM = true, AFTER_DRAIN = false; static_assert(ACT == 0 || ACT == 1, "EpiBf16: ACT is 0 (none) or 1 (gelu_pk)");
    bf16_t* O; int ldc; const float* bias; int split_cols; size_t split_stride; float scale0;
    __device__ __forceinline__ void operator()(const f32x4 (&acc)[2][2][4][2], const Unit& u, int wr, int wc, int fr, int fq) const {
        const int row0 = u.pm * BM + wr * 64 + fr; int colt = u.pn * BM; bf16_t* base = O;
        float sc = 1.f; if (split_cols) { const int t = colt / split_cols; base += (size_t)t * split_stride; colt -= t * split_cols; if (t == 0) sc = scale0; }
        const int col0 = colt + wc * 32 + 8 * fq, bcol0 = u.pn * BM + wc * 32 + 8 * fq;
        f32x4 bv[2][2];
#pragma unroll
        for (int bj = 0; bj < 2; ++bj)
#pragma unroll
            for (int n = 0; n < 2; ++n) bv[bj][n] = bias ? *(const f32x4*)(bias + bcol0 + bj * HALF + 4 * n) : (f32x4){0.f, 0.f, 0.f, 0.f};
#pragma unroll
        for (int ai = 0; ai < 2; ++ai)
#pragma unroll
            for (int m = 0; m < 4; ++m) { bf16_t* rowp = base + (size_t)(row0 + ai * HALF + m * 16) * ldc + col0;
#pragma unroll
                for (int bj = 0; bj < 2; ++bj) { f32x4 v0 = acc[ai][bj][m][0] + bv[bj][0], v1 = acc[ai][bj][m][1] + bv[bj][1];
                    if (ACT == 1) { f32x2 a = gelu_pk((f32x2){v0[0], v0[1]}), b = gelu_pk((f32x2){v0[2], v0[3]}), c = gelu_pk((f32x2){v1[0], v1[1]}), d = gelu_pk((f32x2){v1[2], v1[3]});
                        v0 = (f32x4){a.x, a.y, b.x, b.y}; v1 = (f32x4){c.x, c.y, d.x, d.y}; }
                    v0 = v0 * sc; v1 = v1 * sc; u32x4 w; w.x = cvt_pk_bf16(v0[0], v0[1]); w.y = cvt_pk_bf16(v0[2], v0[3]); w.z = cvt_pk_bf16(v1[0], v1[1]); w.w = cvt_pk_bf16(v1[2], v1[3]);
                    *(u32x4*)(rowp + bj * HALF) = w; } }
    }
};
template <class Epi, class Sched, bool ALIGN_EPI = false, bool SP2 = false>
__device__ __forceinline__ void gemm_phase(PG8_LAS unsigned char* lds, const Gemm g, const Sched& S, const Epi& E) {
    const int tid = threadIdx.x, wid = __builtin_amdgcn_readfirstlane(tid >> 6), lane = tid & 63, wr = wid >> 2, wc = wid & 3, fr = lane & 15, fq = lane >> 4;
    const int K = g.K, nt = K / BK;
    unsigned voffA[2], voffB[2];
#pragma unroll
    for (int i = 0; i < 2; ++i) { int R, C; stage_rc(tid * 16 + i * 8192, R, C); const int Rb = Epi::PERM ? ((R & ~31) + perm32(R & 31)) : R;
        voffA[i] = (unsigned)(R * K + C) * 2u; voffB[i] = (unsigned)(Rb * K + C) * 2u; }
    const size_t kstep = (size_t)(BK * 2);
    const size_t hstep = (size_t)HALF * K * 2;
    const size_t tstep = 2 * hstep;
    const unsigned ldsw = (unsigned)wid * 1024u;
    const int aoff = lds_byte(wr * 64 + fr, fq * 8), boff = lds_byte(wc * 32 + fr, fq * 8);
#define PG8_SA(b, h) (((b) * 2 + (h)) * HTB)
#define PG8_SB(b, h) ((4 + (b) * 2 + (h)) * HTB)
#define PG8_STAGE(bufoff, gbase, voff) do { _Pragma("unroll") for (int _i = 0; _i < 2; ++_i) \
        __builtin_amdgcn_global_load_lds((const unsigned*)((const char*)(gbase) + (voff)[_i]), (PG8_LAS unsigned*)(lds + (bufoff) + ldsw + _i * 8192), 16, 0, 0); } while (0)
#define PG8_LDA(dst, b, h) do { _Pragma("unroll") for (int m = 0; m < 4; ++m) _Pragma("unroll") for (int k = 0; k < 2; ++k) dst[m][k] = *(const PG8_LAS bf16x8*)(lds + PG8_SA(b, h) + aoff + m * 2048 + k * 1024); } while (0)
#define PG8_LDB(dst, b, h) do { _Pragma("unroll") for (int n = 0; n < 2; ++n) _Pragma("unroll") for (int k = 0; k < 2; ++k) dst[n][k] = *(const PG8_LAS bf16x8*)(lds + PG8_SB(b, h) + boff + n * 2048 + k * 1024); } while (0)
#define PG8_MMA(ai, bj, At, Bt) do { __builtin_amdgcn_s_setprio(1); _Pragma("unroll") for (int m = 0; m < 4; ++m) _Pragma("unroll") for (int n = 0; n < 2; ++n) _Pragma("unroll") for (int k = 0; k < 2; ++k) \
        acc[ai][bj][m][n] = __builtin_amdgcn_mfma_f32_16x16x32_bf16(Bt[n][k], At[m][k], acc[ai][bj][m][n], 0, 0, 0); __builtin_amdgcn_s_setprio(0); } while (0)
#define PG8_WAIT_V(n) asm volatile("s_waitcnt vmcnt(" #n ")" ::: "memory")
#define PG8_WAIT_L(n) asm volatile("s_waitcnt lgkmcnt(" #n ")" ::: "memory")
#define PG8_BAR __builtin_amdgcn_s_barrier()
#define PG8_SCHED __builtin_amdgcn_sched_barrier(0)
    Unit cur, nxt; int ui = 0;
    if (!S.next(0, cur)) return;
    f32x4 acc[2][2][4][2];
#pragma unroll
    for (int a = 0; a < 2; ++a)
#pragma unroll
        for (int b = 0; b < 2; ++b)
#pragma unroll
            for (int m = 0; m < 4; ++m)
#pragma unroll
                for (int n = 0; n < 2; ++n) acc[a][b][m][n] = (f32x4){0.f, 0.f, 0.f, 0.f};
    bf16x8 At[4][2], B0[2][2], B1[2][2];
    const char* cA = (const char*)g.A + (size_t)cur.pm * tstep; const char* cB = S.b_base(g, cur) + (size_t)cur.pn * tstep;
    S.a_ready(cur);
    if constexpr (SP2) {
        PG8_STAGE(PG8_SB(0, 0), cB, voffB); PG8_STAGE(PG8_SB(0, 1), cB + hstep, voffB); PG8_STAGE(PG8_SA(0, 0), cA, voffA); PG8_STAGE(PG8_SA(0, 1), cA + hstep, voffA);
        if (wr == 1) PG8_BAR;
        PG8_WAIT_V(2); PG8_BAR;
        PG8_STAGE(PG8_SB(1, 0), cB + kstep, voffB); PG8_STAGE(PG8_SA(1, 0), cA + kstep, voffA); PG8_STAGE(PG8_SB(1, 1), cB + hstep + kstep, voffB);
        PG8_WAIT_V(6); PG8_BAR;
    } else {
        PG8_STAGE(PG8_SB(0, 0), cB, voffB); PG8_STAGE(PG8_SA(0, 0), cA, voffA); PG8_STAGE(PG8_SB(0, 1), cB + hstep, voffB); PG8_STAGE(PG8_SA(0, 1), cA + hstep, voffA);
        if (wr == 1) PG8_BAR;
        PG8_WAIT_V(4); PG8_BAR;
        PG8_STAGE(PG8_SB(1, 0), cB + kstep, voffB); PG8_STAGE(PG8_SA(1, 0), cA + kstep, voffA); PG8_STAGE(PG8_SB(1, 1), cB + hstep + kstep, voffB);
        PG8_WAIT_V(6); PG8_BAR;
    }
    for (;;) {
        const bool has_next = S.next(ui + 1, nxt);
        const char* nA = has_next ? (const char*)g.A + (size_t)nxt.pm * tstep : cA; const char* nB = has_next ? S.b_base(g, nxt) + (size_t)nxt.pn * tstep : cB;
        for (int t = 0; t < nt; t += 2) {
            const bool last = (t == nt - 2);
            const char* a1 = cA + (size_t)(t + 1) * kstep;
            const char* a2 = last ? nA : cA + (size_t)(t + 2) * kstep; const char* b2 = last ? nB : cB + (size_t)(t + 2) * kstep;
            const char* a3 = a2 + kstep; const char* b3 = b2 + kstep;
            if (last && has_next) S.a_ready(nxt);
            if constexpr (SP2) {
            PG8_LDB(B0, 0, 0); PG8_LDB(B1, 0, 1); PG8_SCHED; PG8_LDA(At, 0, 0); PG8_STAGE(PG8_SA(1, 1), a1 + hstep, voffA);
            PG8_WAIT_V(8); PG8_WAIT_L(0); PG8_BAR; PG8_MMA(0, 0, At, B0); PG8_MMA(0, 1, At, B1); PG8_BAR; PG8_SCHED;
            PG8_LDA(At, 0, 1); PG8_STAGE(PG8_SB(0, 0), b2, voffB); PG8_STAGE(PG8_SB(0, 1), b2 + hstep, voffB); PG8_STAGE(PG8_SA(0, 0), a2, voffA);
            PG8_WAIT_V(8); PG8_WAIT_L(0); PG8_BAR; PG8_MMA(1, 0, At, B0); PG8_MMA(1, 1, At, B1); PG8_BAR; PG8_SCHED;
            PG8_LDB(B0, 1, 0); PG8_LDB(B1, 1, 1); PG8_SCHED; PG8_LDA(At, 1, 0); PG8_STAGE(PG8_SA(0, 1), a2 + hstep, voffA);
            PG8_WAIT_V(8); PG8_WAIT_L(0); PG8_BAR; PG8_MMA(0, 0, At, B0); PG8_MMA(0, 1, At, B1); PG8_BAR; PG8_SCHED;
            PG8_LDA(At, 1, 1); PG8_STAGE(PG8_SB(1, 0), b3, voffB); PG8_STAGE(PG8_SB(1, 1), b3 + hstep, voffB); PG8_STAGE(PG8_SA(1, 0), a3, voffA);
            PG8_WAIT_V(8); PG8_WAIT_L(0); PG8_BAR; PG8_MMA(1, 0, At, B0); PG8_MMA(1, 1, At, B1); PG8_BAR; PG8_SCHED;
            } else {
            PG8_LDB(B0, 0, 0); PG8_SCHED; PG8_LDA(At, 0, 0); PG8_STAGE(PG8_SA(1, 1), a1 + hstep, voffA);
            PG8_WAIT_L(8); PG8_BAR; PG8_WAIT_L(0); PG8_MMA(0, 0, At, B0); PG8_BAR; PG8_SCHED;
            PG8_LDB(B1, 0, 1); PG8_STAGE(PG8_SB(0, 0), b2, voffB);
            PG8_BAR; PG8_WAIT_L(0); PG8_MMA(0, 1, At, B1); PG8_BAR;
            PG8_LDA(At, 0, 1); PG8_STAGE(PG8_SA(0, 0), a2, voffA);
            PG8_BAR; PG8_WAIT_L(0); PG8_MMA(1, 0, At, B0); PG8_BAR; PG8_SCHED;
            PG8_STAGE(PG8_SB(0, 1), b2 + hstep, voffB);
            PG8_WAIT_V(6); PG8_BAR; PG8_MMA(1, 1, At, B1); PG8_BAR;
            PG8_LDB(B0, 1, 0); PG8_SCHED; PG8_LDA(At, 1, 0); PG8_STAGE(PG8_SA(0, 1), a2 + hstep, voffA);
            PG8_WAIT_L(8); PG8_BAR; PG8_WAIT_L(0); PG8_MMA(0, 0, At, B0); PG8_BAR; PG8_SCHED;
            PG8_LDB(B1, 1, 1); PG8_STAGE(PG8_SB(1, 0), b3, voffB);
            PG8_BAR; PG8_WAIT_L(0); PG8_MMA(0, 1, At, B1); PG8_BAR;
            PG8_LDA(At, 1, 1); PG8_STAGE(PG8_SA(1, 0), a3, voffA);
            PG8_BAR; PG8_WAIT_L(0); PG8_MMA(1, 0, At, B0); PG8_BAR; PG8_SCHED;
            PG8_STAGE(PG8_SB(1, 1), b3 + hstep, voffB);
            PG8_WAIT_V(6); PG8_BAR; PG8_MMA(1, 1, At, B1); PG8_BAR;
            }
        }
        if constexpr (ALIGN_EPI) { if (wr == 0) PG8_BAR; }
        if constexpr (!Epi::AFTER_DRAIN) { E(acc, cur, wr, wc, fr, fq); S.done(cur); }
        if (!has_next) break;
#pragma unroll
        for (int a = 0; a < 2; ++a)
#pragma unroll
            for (int b = 0; b < 2; ++b)
#pragma unroll
                for (int m = 0; m < 4; ++m)
#pragma unroll
                    for (int n = 0; n < 2; ++n) acc[a][b][m][n] = (f32x4){0.f, 0.f, 0.f, 0.f};
        cur = nxt; cA = nA; cB = nB; ++ui;
        if constexpr (ALIGN_EPI) { if (wr == 1) PG8_BAR; }
    }
    PG8_WAIT_V(0);
    if constexpr (!ALIGN_EPI) { if (wr == 0) PG8_BAR; }
    PG8_BAR;
    if constexpr (Epi::AFTER_DRAIN) { E.fused(acc, cur, wr, wc, fr, fq, lds, wid, lane); S.done(cur); }
#undef PG8_SA
#undef PG8_SB
#undef PG8_STAGE
#undef PG8_LDA
#undef PG8_LDB
#undef PG8_MMA
#undef PG8_WAIT_V
#undef PG8_WAIT_L
#undef PG8_BAR
#undef PG8_SCHED
}
}

namespace pg8 {
struct MoeOrder {
    int nM, nN, nwg, G, c; const int* tile_e; size_t es_bytes;
    __device__ void init(int nM_, int nN_, int G_, int c_, const int* te, size_t es) { nM = nM_; nN = nN_; nwg = nM * nN; G = G_; c = c_; tile_e = te; es_bytes = es; }
    __device__ bool next(int i, Unit& u) const {
        const long L = (long)i * G + c; if (L >= nwg) return false;
        int wgid = (int)L; { const int q = nwg / NXCD, r = nwg % NXCD, xcd = wgid % NXCD, off = wgid / NXCD; wgid = (xcd < r ? xcd * (q + 1) : r * (q + 1) + (xcd - r) * q) + off; }
        const int nig = WGM * nN, gid = wgid / nig, fm = gid * WGM, gsz = (nM - fm) < WGM ? (nM - fm) : WGM;
        u.pm = fm + ((wgid % nig) % gsz); u.pn = (wgid % nig) / gsz; return true;
    }
    __device__ __forceinline__ void a_ready(const Unit&) const {}
    __device__ __forceinline__ void done(const Unit&) const {}
    __device__ __forceinline__ const char* b_base(const Gemm& g, const Unit& u) const { return (const char*)g.Bt + (size_t)tile_e[u.pm] * es_bytes; }
};
struct EpiResAdd {
    static constexpr bool PERM = false, AFTER_DRAIN = false;
    float* X; int ldc; int pad;
    __device__ __forceinline__ void operator()(const f32x4 (&acc)[2][2][4][2], const Unit& u, int wr, int wc, int fr, int fq) const {
        const int row0 = u.pm * BM + wr * 64 + fr, col0 = u.pn * BM + wc * 32 + 4 * fq;
#pragma unroll
        for (int ai = 0; ai < 2; ++ai)
#pragma unroll
            for (int m = 0; m < 4; ++m) { float* rowp = X + (size_t)(row0 + ai * HALF + m * 16) * ldc + col0;
#pragma unroll
                for (int bj = 0; bj < 2; ++bj)
#pragma unroll
                    for (int n = 0; n < 2; ++n) { f32x4* p = (f32x4*)(rowp + bj * HALF + n * 16); *p = *p + acc[ai][bj][m][n]; } }
    }
};
struct EpiGateUp {
    static constexpr bool PERM = true, AFTER_DRAIN = false;
    bf16_t* HID;
    __device__ __forceinline__ void operator()(const f32x4 (&acc)[2][2][4][2], const Unit& u, int wr, int wc, int fr, int fq) const {
        const int row0 = u.pm * BM + wr * 64 + fr, hc0 = u.pn * 128 + wc * 16 + 4 * fq;
#pragma unroll
        for (int ai = 0; ai < 2; ++ai)
#pragma unroll
            for (int m = 0; m < 4; ++m) { bf16_t* rowp = HID + (size_t)(row0 + ai * HALF + m * 16) * 512 + hc0;
#pragma unroll
                for (int bj = 0; bj < 2; ++bj) { const f32x4 g = acc[ai][bj][m][0], up = acc[ai][bj][m][1]; float h[4];
#pragma unroll
                    for (int i = 0; i < 4; ++i) h[i] = g[i] / (1.f + __expf(-g[i])) * up[i];
                    typedef unsigned u32x2 __attribute__((ext_vector_type(2)));
                    u32x2 w; w.x = cvt_pk_bf16(h[0], h[1]); w.y = cvt_pk_bf16(h[2], h[3]);
                    *(u32x2*)(rowp + bj * 64) = w; } }
    }
};
struct EpiDown {
    static constexpr bool PERM = true, AFTER_DRAIN = false;
    bf16_t* YB; const float* gate;
    __device__ __forceinline__ void operator()(const f32x4 (&acc)[2][2][4][2], const Unit& u, int wr, int wc, int fr, int fq) const {
        const int row0 = u.pm * BM + wr * 64 + fr, col0 = u.pn * BM + wc * 32 + 8 * fq;
#pragma unroll
        for (int ai = 0; ai < 2; ++ai)
#pragma unroll
            for (int m = 0; m < 4; ++m) { const int row = row0 + ai * HALF + m * 16; const float gt = gate[row]; bf16_t* rowp = YB + (size_t)row * 1024 + col0;
#pragma unroll
                for (int bj = 0; bj < 2; ++bj) { const f32x4 v0 = acc[ai][bj][m][0] * gt, v1 = acc[ai][bj][m][1] * gt;
                    u32x4 w; w.x = cvt_pk_bf16(v0[0], v0[1]); w.y = cvt_pk_bf16(v0[2], v0[3]); w.z = cvt_pk_bf16(v1[0], v1[1]); w.w = cvt_pk_bf16(v1[2], v1[3]);
                    *(u32x4*)(rowp + bj * HALF) = w; } }
    }
};
}

#define GAS __attribute__((address_space(1)))
#define LAS __attribute__((address_space(3)))
constexpr int NWAVES = 8, LDS_BYTES = 147456, RING_BYTES = 131072, MISC_OFF = RING_BYTES + 320;
constexpr int CW_BAR = 4096;
constexpr size_t CTL_ZERO_BYTES = 1u << 20;

#define XB_TMO      128
#define XB_XCNT(j)  (256  + 64 * (j))
#define XB_XSUB(j)  (1280 + 64 * (j))
#define XB_XGEN(j)  (2304 + 64 * (j))
#define XB_TOP      3328
#define XB_TOPGEN   3392
#define XCD_BAR_WORDS 3456
#define XB_SPIN_CAP (1u << 20)
__device__ __forceinline__ unsigned xb_ld(unsigned* p)              { return __hip_atomic_load(p, __ATOMIC_RELAXED, __HIP_MEMORY_SCOPE_AGENT); }
__device__ __forceinline__ unsigned xb_add(unsigned* p, unsigned v) { return __hip_atomic_fetch_add(p, v, __ATOMIC_RELAXED, __HIP_MEMORY_SCOPE_AGENT); }
__device__ __forceinline__ unsigned xb_xcc_id() { return (unsigned)__builtin_amdgcn_s_getreg((3 << 11) | 20) & 0xFu; }
#define XB_SPIN(cond, bar) do { unsigned _sp = 0; while (cond) { __builtin_amdgcn_s_sleep(1); \
    if ((++_sp & 255u) == 0u) { if (xb_ld(&(bar)[XB_TMO])) break; if (_sp > XB_SPIN_CAP) { atomicAdd(&(bar)[XB_TMO], 1u); break; } } } } while (0)
struct XcdBarrier { unsigned* bar; unsigned x; volatile LAS unsigned* st; };
__device__ __forceinline__ XcdBarrier xcd_barrier_post(unsigned* bar, volatile LAS unsigned* st) {
    XcdBarrier b; b.bar = bar; b.x = xb_xcc_id(); b.st = st;
    if (threadIdx.x == 0) (void)xb_add(&bar[XB_XCNT(b.x)], 1u);
    return b;
}
__device__ __forceinline__ void xcd_barrier_complete(unsigned* bar, unsigned x, unsigned& nloc, unsigned& nx) {
    const unsigned G = gridDim.x * gridDim.y * gridDim.z;
    unsigned sum, cnt, mine, sp = 0u;
    for (;;) {
        sum = 0u; cnt = 0u; mine = 0u;
#pragma unroll
        for (unsigned j = 0; j < 16; ++j) { const unsigned c = xb_ld(&bar[XB_XCNT(j)]); sum += c; cnt += (c > 0u) ? 1u : 0u; mine = (j == x) ? c : mine; }
        if (sum == G) break;
        __builtin_amdgcn_s_sleep(1);
        if ((++sp & 255u) == 0u) { if (xb_ld(&bar[XB_TMO])) break; if (sp > XB_SPIN_CAP) { atomicAdd(&bar[XB_TMO], 1u); break; } }
    }
    nloc = mine > 0u ? mine : 1u; nx = cnt > 0u ? cnt : 1u;
}
__device__ __forceinline__ void xcd_barrier(const XcdBarrier& b) {
    asm volatile("s_waitcnt vmcnt(0)" ::: "memory");
    __syncthreads();
    if (threadIdx.x == 0) {
        unsigned* bar = b.bar;
        __builtin_amdgcn_s_waitcnt(0);
        unsigned nloc = b.st[0], nx = b.st[1];
        if (nloc == 0u) { xcd_barrier_complete(bar, b.x, nloc, nx); b.st[0] = nloc; b.st[1] = nx; }
        const unsigned old = xb_add(&bar[XB_XSUB(b.x)], 1u);
        const unsigned gen = old / nloc;
        if (old + 1u == (gen + 1u) * nloc) {
            __builtin_amdgcn_fence(__ATOMIC_RELEASE, "agent");
            asm volatile("s_waitcnt vmcnt(0)" ::: "memory");
            const unsigned og = xb_add(&bar[XB_TOP], 1u);
            const unsigned tg = og / nx;
            if (og + 1u == (tg + 1u) * nx) xb_add(&bar[XB_TOPGEN], 1u);
            else XB_SPIN(xb_ld(&bar[XB_TOPGEN]) == tg, bar);
            __builtin_amdgcn_fence(__ATOMIC_ACQUIRE, "agent");
            xb_add(&bar[XB_XGEN(b.x)], 1u);
            asm volatile("s_waitcnt vmcnt(0)" ::: "memory");
        } else {
            XB_SPIN(xb_ld(&bar[XB_XGEN(b.x)]) == gen, bar);
            __builtin_amdgcn_fence(__ATOMIC_ACQUIRE, "agent");
            asm volatile("s_waitcnt vmcnt(0)" ::: "memory");
        }
    }
    __syncthreads();
}

enum { PH_KVGEMM = 1, PH_L0 = 2, PH_PER_LAYER = 15, PH_FINAL = 32, PH_COUNT = 33 };
enum { LP_NORM1 = 0, LP_GIN = 1, LP_QKN = 2, LP_MIX1 = 3, LP_SCAN = 4, LP_MIX2 = 5, LP_GOUT = 6, LP_NORM2 = 7, LP_GQ = 8, LP_CA = 9, LP_GO = 10, LP_ROUTER = 11, LP_GATHER = 12, LP_GGU = 13, LP_GDOWN = 14 };

struct MkArgs { const float* in[33]; float* out; unsigned char* ws; int ph_lo, ph_hi, bar_region, pad; };

#define WSP(type, off) ((type*)(args.ws + (off)))
#define IN(k) (lo <= (k) && (k) < hi)
#define SEAM(k) do { if (IN(k) && IN((k) + 1)) xcd_barrier(bar); } while (0)
template <int l> __device__ __forceinline__ void layer_phases(const MkArgs& args, LAS unsigned char* lds, const XcdBarrier& bar, const int lo, const int hi) {
        const int P0 = PH_L0 + l * PH_PER_LAYER;
        SEAM(P0 + LP_NORM1);
        if (IN(P0 + LP_GIN)) {
            pg8::Gemm g{WSP(bf16_t, WS_XN), WSP(bf16_t, WS_WIN), T, NP, DM}; pg8::StaticOrder S; S.init(T, NP, gridDim.x, (int)blockIdx.x);
            pg8::EpiBf16<0> E{WSP(bf16_t, WS_PROJ), NP, nullptr, 0, 0, 1.f};
            pg8::gemm_phase<pg8::EpiBf16<0>, pg8::StaticOrder, true, true>(lds, g, S, E);
        }
        SEAM(P0 + LP_GIN); SEAM(P0 + LP_QKN); SEAM(P0 + LP_MIX1); SEAM(P0 + LP_SCAN); SEAM(P0 + LP_MIX2);
        if (IN(P0 + LP_GOUT)) {
            pg8::Gemm g{WSP(bf16_t, WS_CAT), WSP(bf16_t, WS_WOUT), T, DM, 1536}; pg8::StaticOrder S; S.init(T, DM, gridDim.x, (int)blockIdx.x);
            pg8::EpiResAdd E{args.out, DM, 0};
            pg8::gemm_phase<pg8::EpiResAdd, pg8::StaticOrder, true, true>(lds, g, S, E);
        }
        SEAM(P0 + LP_GOUT); SEAM(P0 + LP_NORM2);
        if (IN(P0 + LP_GQ)) {
            pg8::Gemm g{WSP(bf16_t, WS_XN), WSP(bf16_t, WS_WQ), T, DM, DM}; pg8::StaticOrder S; S.init(T, DM, gridDim.x, (int)blockIdx.x);
            pg8::EpiBf16<0> E{WSP(bf16_t, WS_Q), DM, nullptr, 0, 0, 1.f};
            pg8::gemm_phase<pg8::EpiBf16<0>, pg8::StaticOrder, true, true>(lds, g, S, E);
        }
        SEAM(P0 + LP_GQ); SEAM(P0 + LP_CA);
        if (IN(P0 + LP_GO)) {
            pg8::Gemm g{WSP(bf16_t, WS_O), WSP(bf16_t, WS_WO), T, DM, DM}; pg8::StaticOrder S; S.init(T, DM, gridDim.x, (int)blockIdx.x);
            pg8::EpiResAdd E{args.out, DM, 0};
            pg8::gemm_phase<pg8::EpiResAdd, pg8::StaticOrder, true, true>(lds, g, S, E);
        }
        SEAM(P0 + LP_GO); SEAM(P0 + LP_ROUTER); SEAM(P0 + LP_GATHER);
        if (IN(P0 + LP_GGU)) {
            const int* CTLl = WSP(const int, WS_CTL) + l * 1024; const int nt = CTLl[CW_NT];
            pg8::Gemm g{WSP(bf16_t, WS_BUF), WSP(bf16_t, WS_WGU), nt * 256, 1024, DM}; pg8::MoeOrder S; S.init(nt, 4, gridDim.x, (int)blockIdx.x, CTLl + CW_TILEE, (size_t)1024 * DM * 2);
            pg8::EpiGateUp E{WSP(bf16_t, WS_HID)};
            pg8::gemm_phase<pg8::EpiGateUp, pg8::MoeOrder, true, true>(lds, g, S, E);
        }
        SEAM(P0 + LP_GGU);
        if (IN(P0 + LP_GDOWN)) {
            const int* CTLl = WSP(const int, WS_CTL) + l * 1024; const int nt = CTLl[CW_NT];
            pg8::Gemm g{WSP(bf16_t, WS_HID), WSP(bf16_t, WS_WD), nt * 256, 1024, 512}; pg8::MoeOrder S; S.init(nt, 4, gridDim.x, (int)blockIdx.x, CTLl + CW_TILEE, (size_t)DM * 512 * 2);
            pg8::EpiDown E{WSP(bf16_t, WS_YB), WSP(const float, WS_GATEBUF)};
            pg8::gemm_phase<pg8::EpiDown, pg8::MoeOrder, true, true>(lds, g, S, E);
        }
        SEAM(P0 + LP_GDOWN);
    }
__global__ void __launch_bounds__(NWAVES * 64, 2) mk_fwd(MkArgs args) {
    extern __shared__ __attribute__((aligned(16))) unsigned char lds_raw[];
    LAS unsigned char* lds = (LAS unsigned char*)lds_raw;
    for (int u = threadIdx.x; u < (LDS_BYTES - RING_BYTES) / 4; u += NWAVES * 64) ((LAS unsigned*)(lds + RING_BYTES))[u] = 0u;
    __syncthreads();
    XcdBarrier bar = xcd_barrier_post(WSP(unsigned, WS_CTL) + CW_BAR + args.bar_region * XCD_BAR_WORDS, (volatile LAS unsigned*)(lds + MISC_OFF) + 8);
    const int lo = args.ph_lo, hi = args.ph_hi;

    if (IN(PH_KVGEMM)) {
        pg8::Gemm g{WSP(bf16_t, WS_MEMN), WSP(bf16_t, WS_WKV), 512, 4096, DM}; pg8::StaticOrder S; S.init(512, 4096, gridDim.x, (int)blockIdx.x);
        pg8::EpiBf16<0> E{WSP(bf16_t, WS_KV), 4096, nullptr, 0, 0, 1.f};
        pg8::gemm_phase<pg8::EpiBf16<0>, pg8::StaticOrder, true, true>(lds, g, S, E);
    }
    SEAM(PH_KVGEMM);
    layer_phases<0>(args, lds, bar, lo, hi);
    layer_phases<1>(args, lds, bar, lo, hi);
#undef IN
#undef SEAM
}

static void convert(hipStream_t s, const float* src, const float* src2, const float* scale, bf16_t* dst, int K, int N, int ld, int mode, int nz, size_t ses, size_t des) {
    CvtJob j{src, src2, scale, dst, K, N, ld, mode, ses, des};
    hipLaunchKernelGGL(k_convert, dim3(K / 32, N / 32, nz), dim3(32, 8), 0, s, j);
}
static int g_grid = 0, g_region = 0;
static void mk(hipStream_t stream, void* const* d_in, void* d_out, void* d_ws, int lo, int hi) {
    MkArgs a{};
    for (int i = 0; i < 33; ++i) a.in[i] = (const float*)d_in[i];
    a.out = (float*)d_out; a.ws = (unsigned char*)d_ws; a.ph_lo = lo; a.ph_hi = hi; a.bar_region = g_region++; a.pad = 0;
    hipLaunchKernelGGL(mk_fwd, dim3(g_grid), dim3(NWAVES * 64), LDS_BYTES, stream, a);
}
#define USE_MK_GEMM 1

extern "C" void kernel_launch(void* const* d_in, const int* in_sizes, int n_in, void* d_out, int out_size, void* d_ws, size_t ws_size, hipStream_t stream) {
    if (n_in != 33 || ws_size < WS_END) { fprintf(stderr, "kernel_launch: bad n_in %d or ws %zu < %zu\n", n_in, ws_size, (size_t)WS_END); return; }
    if (g_grid == 0) {
        int dev = 0, cus = 0;
        (void)hipGetDevice(&dev); (void)hipDeviceGetAttribute(&cus, hipDeviceAttributeMultiprocessorCount, dev);
        if (hipFuncSetAttribute((const void*)mk_fwd, hipFuncAttributeMaxDynamicSharedMemorySize, LDS_BYTES) != hipSuccess) fprintf(stderr, "hipFuncSetAttribute failed\n");
        g_grid = cus > 0 ? cus : 256;
    }
    const float* const* in = (const float* const*)d_in;
    char* ws = (char*)d_ws;
    float* X = (float*)d_out;
    int* CTL = (int*)(ws + WS_CTL);
    bf16_t *WIN = (bf16_t*)(ws + WS_WIN), *WOUT = (bf16_t*)(ws + WS_WOUT), *WQ = (bf16_t*)(ws + WS_WQ), *WO = (bf16_t*)(ws + WS_WO), *WKV = (bf16_t*)(ws + WS_WKV);
    bf16_t *MEMN = (bf16_t*)(ws + WS_MEMN), *KV = (bf16_t*)(ws + WS_KV), *PROJ = (bf16_t*)(ws + WS_PROJ), *Qb = (bf16_t*)(ws + WS_Q), *Ob = (bf16_t*)(ws + WS_O);
    bf16_t *BUF = (bf16_t*)(ws + WS_BUF), *YB = (bf16_t*)(ws + WS_YB), *HID = (bf16_t*)(ws + WS_HID), *CAT = (bf16_t*)(ws + WS_CAT), *XN = (bf16_t*)(ws + WS_XN);
    bf16_t *OBR = (bf16_t*)(ws + WS_OBR), *WGU = (bf16_t*)(ws + WS_WGU), *WD = (bf16_t*)(ws + WS_WD);
    float *LSE = (float*)(ws + WS_LSE), *YS = (float*)(ws + WS_YS), *DT = (float*)(ws + WS_DT), *GATEL = (float*)(ws + WS_GATEL), *GATEBUF = (float*)(ws + WS_GATEBUF);
    int *LIST = (int*)(ws + WS_LIST), *TOKDEST = (int*)(ws + WS_TOKDEST);
    const int* NOI = nullptr;

    (void)hipMemsetAsync(CTL, 0, CTL_ZERO_BYTES, stream);
    g_region = 0;
    hipLaunchKernelGGL(k_memn, dim3(BATCH * MEML), dim3(256), 0, stream, in[1], MEMN);
    for (int l = 0; l < 2; ++l)
        convert(stream, in[21] + (size_t)l * DM * 2048, nullptr, in[19] + l * DM, WKV + (size_t)l * 2048 * DM, DM, 2048, 2048, 0, 1, 0, 0);
#if USE_MK_GEMM
    mk(stream, d_in, d_out, d_ws, PH_KVGEMM, PH_KVGEMM + 1);
#else
    hipLaunchKernelGGL(k_gemm<EpiStoreBf16>, dim3(4096 / 128, 512 / 128), dim3(256), 0, stream, MEMN, WKV, EpiStoreBf16{KV, 4096, 0}, NOI, (size_t)0, NOI, DM);
#endif
    hipLaunchKernelGGL(k_knorm, dim3(512 * 8), dim3(256), 0, stream, KV, in[23]);

    for (int l = 0; l < 2; ++l) {
        int* CTLl = CTL + l * 1024;
        const int P0 = PH_L0 + l * PH_PER_LAYER;
        convert(stream, in[3] + (size_t)l * DM * NIN, nullptr, in[2] + l * DM, WIN, DM, NP, NIN, 1, 1, 0, 0);
        convert(stream, in[17] + (size_t)l * 1536 * DM, nullptr, nullptr, WOUT, 1536, DM, DM, 0, 1, 0, 0);
        convert(stream, in[20] + (size_t)l * DM * DM, nullptr, in[18] + l * DM, WQ, DM, DM, DM, 0, 1, 0, 0);
        convert(stream, in[24] + (size_t)l * DM * DM, nullptr, nullptr, WO, DM, DM, DM, 0, 1, 0, 0);
        hipLaunchKernelGGL(k_norm1, dim3(T), dim3(256), 0, stream, in[0], X, XN, YB, TOKDEST, in[2] + l * DM, in[3] + (size_t)l * DM * NIN, DT, l == 0 ? 1 : 0);
#if USE_MK_GEMM
        mk(stream, d_in, d_out, d_ws, P0 + LP_GIN, P0 + LP_GIN + 1);
#else
        hipLaunchKernelGGL(k_gemm<EpiStoreBf16>, dim3(NP / 128, T / 128), dim3(256), 0, stream, XN, WIN, EpiStoreBf16{PROJ, NP, 0}, NOI, (size_t)0, NOI, DM);
#endif
        hipLaunchKernelGGL(k_qknorm, dim3(T * 12 / 256), dim3(256), 0, stream, PROJ, in[11] + l * 64, in[12] + l * 64);
        hipLaunchKernelGGL(k_ssd_naive, dim3(12), dim3(64), 0, stream, PROJ, DT, in[4] + l * 4 * 896, in[5] + l * 896, in[6] + l * 6, in[7] + l * 6, in[8] + l * 6, YS);
        hipLaunchKernelGGL(k_ssd_fin, dim3(T), dim3(384), 0, stream, YS, PROJ, in[9] + l * 384, CAT);
        hipLaunchKernelGGL(k_attn_naive, dim3(T * 18 / 256), dim3(256), 0, stream, PROJ, OBR, LSE);
        hipLaunchKernelGGL(k_attn_comb, dim3(T * 384 / 256), dim3(256), 0, stream, OBR, LSE, CAT);
        hipLaunchKernelGGL(k_cf_naive, dim3(T), dim3(384), 0, stream, PROJ, in[13] + l * 31 * 384, in[14] + l * 384, in[15] + l * 384, in[16] + l * 384, in[10] + l * 3 * 384, CAT);
#if USE_MK_GEMM
        mk(stream, d_in, d_out, d_ws, P0 + LP_GOUT, P0 + LP_GOUT + 1);
#else
        hipLaunchKernelGGL(k_gemm<EpiResAdd>, dim3(DM / 128, T / 128), dim3(256), 0, stream, CAT, WOUT, EpiResAdd{X}, NOI, (size_t)0, NOI, 1536);
#endif
        convert(stream, in[30] + (size_t)l * 32 * DM * 512, in[31] + (size_t)l * 32 * DM * 512, in[25] + l * DM, WGU, DM, 1024, 512, 2, 32, (size_t)DM * 512, (size_t)1024 * DM);
        convert(stream, in[32] + (size_t)l * 32 * 512 * DM, nullptr, nullptr, WD, 512, DM, DM, 0, 32, (size_t)512 * DM, (size_t)DM * 512);
        hipLaunchKernelGGL(k_norm2, dim3(T), dim3(256), 0, stream, X, XN);
#if USE_MK_GEMM
        mk(stream, d_in, d_out, d_ws, P0 + LP_GQ, P0 + LP_GQ + 1);
#else
        hipLaunchKernelGGL(k_gemm<EpiStoreBf16>, dim3(DM / 128, T / 128), dim3(256), 0, stream, XN, WQ, EpiStoreBf16{Qb, DM, 0}, NOI, (size_t)0, NOI, DM);
#endif
        hipLaunchKernelGGL(k_ca_naive, dim3(T * 4), dim3(256), 0, stream, Qb, KV, in[22] + l * 256, Ob, l);
#if USE_MK_GEMM
        mk(stream, d_in, d_out, d_ws, P0 + LP_GO, P0 + LP_GO + 1);
#else
        hipLaunchKernelGGL(k_gemm<EpiResAdd>, dim3(DM / 128, T / 128), dim3(256), 0, stream, Ob, WO, EpiResAdd{X}, NOI, (size_t)0, NOI, DM);
#endif
        hipLaunchKernelGGL(k_router, dim3(T), dim3(256), 0, stream, X, XN, in[25] + l * DM, in[26] + (size_t)l * DM * 4, in[27] + l * 4, in[28] + (size_t)l * DM * 32, in[29] + l * 32,
                           CTLl + CW_CNT, LIST, GATEL);
        hipLaunchKernelGGL(k_gather, dim3(PROWS / 4), dim3(256), 0, stream, CTLl + CW_CNT, LIST, GATEL, XN, BUF, GATEBUF, TOKDEST, CTLl + CW_NT, CTLl + CW_TILEE);
#if USE_MK_GEMM
        mk(stream, d_in, d_out, d_ws, P0 + LP_GGU, P0 + LP_GDOWN + 1);
#else
        hipLaunchKernelGGL(k_gemm_gu, dim3(512 / 128, PROWS / 128), dim3(256), 0, stream, BUF, WGU, HID, CTLl + CW_TILEE, (size_t)1024 * DM, CTLl + CW_NT);
        hipLaunchKernelGGL(k_gemm<EpiDown>, dim3(DM / 128, PROWS / 128), dim3(256), 0, stream, HID, WD, EpiDown{YB, GATEBUF}, CTLl + CW_TILEE, (size_t)DM * 512, CTLl + CW_NT, 512);
#endif
    }
    hipLaunchKernelGGL(k_final, dim3(T), dim3(256), 0, stream, X, YB, TOKDEST);
}
```

```cpp
#include <hip/hip_runtime.h>
#include <stdint.h>
#include <stdio.h>

typedef unsigned short bf16_t;
typedef short bf16x8 __attribute__((ext_vector_type(8)));
typedef float f32x4 __attribute__((ext_vector_type(4)));

constexpr int DM = 1024, BATCH = 2, SEQ = 16384, T = BATCH * SEQ, MEML = 256;
constexpr int NIN = 4358, NP = 4352;
constexpr int PC_Z = 0, PC_XBC = 384, PC_SCB = 1280, PC_SCC = 1664, PC_SCH = 2048, PC_Q = 2432, PC_K = 2816, PC_V = 3200, PC_CFA = 3584, PC_CFG = 3968;
constexpr int NEXP = 32, LISTCAP = 65536, PROWS = 65536 + 32 * 256;
constexpr size_t MiB = 1u << 20;
constexpr size_t WS_CTL = 0, WS_WIN = 1 * MiB, WS_WOUT = 10 * MiB, WS_WQ = 13 * MiB, WS_WO = 15 * MiB, WS_WKV = 17 * MiB, WS_MEMN = 25 * MiB, WS_KV = 26 * MiB;
constexpr size_t WS_PROJ = 33 * MiB, WS_Q = 33 * MiB, WS_O = 97 * MiB, WS_BUF = 33 * MiB, WS_YB = 33 * MiB, WS_HID = 177 * MiB;
constexpr size_t WS_CAT = 305 * MiB, WS_XN = 305 * MiB;
constexpr size_t WS_OBR = 401 * MiB, WS_LSE = 473 * MiB, WS_YS = 476 * MiB, WS_DT = 525 * MiB;
constexpr size_t WS_WGU = 401 * MiB, WS_WD = 465 * MiB;
constexpr size_t WS_LIST = 527 * MiB, WS_GATEL = 535 * MiB, WS_TOKDEST = 543 * MiB, WS_GATEBUF = 544 * MiB, WS_END = 545 * MiB;
constexpr int CW_CNT = 0, CW_NT = 64, CW_TILEE = 128;

__device__ __forceinline__ float bf2f(bf16_t v) { return __uint_as_float(((unsigned)v) << 16); }
__device__ __forceinline__ bf16_t f2bf(float f) { unsigned u = __float_as_uint(f); return (bf16_t)((u + 0x7fffu + ((u >> 16) & 1u)) >> 16); }
__device__ __forceinline__ float silu_f(float x) { return x / (1.f + expf(-x)); }
__device__ __forceinline__ float sigm_f(float x) { return 1.f / (1.f + expf(-x)); }
__device__ __forceinline__ float softplus_f(float x) { return fmaxf(x, 0.f) + log1pf(expf(-fabsf(x))); }

__device__ __forceinline__ float block_sum(float v, float* sh) {
    for (int o = 32; o > 0; o >>= 1) v += __shfl_xor(v, o);
    const int w = threadIdx.x >> 6, nw = (blockDim.x + 63) >> 6;
    __syncthreads();
    if ((threadIdx.x & 63) == 0) sh[w] = v;
    __syncthreads();
    float r = 0.f;
    for (int i = 0; i < nw; ++i) r += sh[i];
    return r;
}
__device__ __forceinline__ float block_max(float v, float* sh) {
    for (int o = 32; o > 0; o >>= 1) v = fmaxf(v, __shfl_xor(v, o));
    const int w = threadIdx.x >> 6, nw = (blockDim.x + 63) >> 6;
    __syncthreads();
    if ((threadIdx.x & 63) == 0) sh[w] = v;
    __syncthreads();
    float r = sh[0];
    for (int i = 1; i < nw; ++i) r = fmaxf(r, sh[i]);
    return r;
}

struct CvtJob { const float* src; const float* src2; const float* scale; bf16_t* dst; int K, N, ld, mode; size_t src_es, dst_es; };
__global__ void k_convert(CvtJob j) {
    __shared__ float tile[32][33];
    const int k0 = blockIdx.x * 32, n0 = blockIdx.y * 32, tx = threadIdx.x, ty = threadIdx.y;
    const float* s1 = j.src + (size_t)blockIdx.z * j.src_es;
    const float* s2 = j.src2 ? j.src2 + (size_t)blockIdx.z * j.src_es : nullptr;
    bf16_t* d = j.dst + (size_t)blockIdx.z * j.dst_es;
    for (int i = 0; i < 4; ++i) {
        const int k = k0 + ty + 8 * i, n = n0 + tx;
        float v;
        if (j.mode == 0) v = s1[(size_t)k * j.ld + n];
        else if (j.mode == 1) v = s1[(size_t)k * j.ld + n + (n >= 1280 ? 6 : 0)];
        else { const int c = (n >> 3) * 4 + (n & 3); v = (n & 4) ? s2[(size_t)k * j.ld + c] : s1[(size_t)k * j.ld + c]; }
        if (j.scale) v *= j.scale[k];
        tile[ty + 8 * i][tx] = v;
    }
    __syncthreads();
    for (int i = 0; i < 4; ++i) {
        const int n = n0 + ty + 8 * i, k = k0 + tx;
        d[(size_t)n * j.K + k] = f2bf(tile[tx][ty + 8 * i]);
    }
}

__global__ void k_memn(const float* mem, bf16_t* MEMN) {
    __shared__ float sh[32];
    const int m = blockIdx.x, tid = threadIdx.x;
    float v[4], ss = 0.f;
    for (int i = 0; i < 4; ++i) { v[i] = mem[(size_t)m * DM + tid + 256 * i]; ss += v[i] * v[i]; }
    ss = block_sum(ss, sh);
    const float rs = rsqrtf(ss / DM + 1e-6f);
    for (int i = 0; i < 4; ++i) MEMN[(size_t)m * DM + tid + 256 * i] = f2bf(v[i] * rs);
}
__global__ void k_knorm(bf16_t* KV, const float* kn  ) {
    __shared__ float sh[32];
    const int bid = blockIdx.x, h = bid & 3, l = (bid >> 2) & 1, m = bid >> 3, tid = threadIdx.x;
    bf16_t* p = KV + (size_t)m * 4096 + l * 2048 + h * 256 + tid;
    const float v = bf2f(*p);
    const float ss = block_sum(v * v, sh);
    *p = f2bf(v * rsqrtf(ss / 256.f + 1e-6f) * kn[l * 256 + tid]);
}

__global__ void k_norm1(const float* xin, float* X, bf16_t* XN, const bf16_t* YB, const int* TOKDEST,
                        const float* g, const float* w_in, float* DT, int first) {
    __shared__ float sh[32];
    const int t = blockIdx.x, tid = threadIdx.x;
    float v[4], ss = 0.f;
    int d0 = 0, d1 = 0;
    if (!first) { d0 = TOKDEST[2 * t]; d1 = TOKDEST[2 * t + 1]; }
#pragma unroll
    for (int i = 0; i < 4; ++i) {
        const int k = tid + 256 * i;
        if (first) v[i] = xin[(size_t)t * DM + k];
        else v[i] = X[(size_t)t * DM + k] + bf2f(YB[(size_t)d0 * DM + k]) + bf2f(YB[(size_t)d1 * DM + k]);
        X[(size_t)t * DM + k] = v[i];
        ss += v[i] * v[i];
    }
    ss = block_sum(ss, sh);
    const float rs = rsqrtf(ss / DM + 1e-6f);
    float part[6] = {0.f, 0.f, 0.f, 0.f, 0.f, 0.f};
#pragma unroll
    for (int i = 0; i < 4; ++i) {
        const int k = tid + 256 * i;
        XN[(size_t)t * DM + k] = f2bf(v[i] * rs);
        const float hv = v[i] * rs * g[k];
        for (int jj = 0; jj < 6; ++jj) part[jj] += hv * w_in[(size_t)k * NIN + 1280 + jj];
    }
    for (int jj = 0; jj < 6; ++jj) { const float s = block_sum(part[jj], sh); if (tid == 0) DT[(size_t)t * 8 + jj] = s; }
}
__global__ void k_norm2(const float* X, bf16_t* XN) {
    __shared__ float sh[32];
    const int t = blockIdx.x, tid = threadIdx.x;
    float v[4], ss = 0.f;
    for (int i = 0; i < 4; ++i) { v[i] = X[(size_t)t * DM + tid + 256 * i]; ss += v[i] * v[i]; }
    ss = block_sum(ss, sh);
    const float rs = rsqrtf(ss / DM + 1e-6f);
    for (int i = 0; i < 4; ++i) XN[(size_t)t * DM + tid + 256 * i] = f2bf(v[i] * rs);
}
__global__ void k_router(const float* X, bf16_t* XN, const float* g, const float* wg, const float* bg, const float* we, const float* be,
                         int* CNT, int* LIST, float* GATEL) {
    __shared__ float sh[32];
    __shared__ float lg[36];
    const int t = blockIdx.x, tid = threadIdx.x;
    float v[4], ss = 0.f;
    for (int i = 0; i < 4; ++i) { v[i] = X[(size_t)t * DM + tid + 256 * i]; ss += v[i] * v[i]; }
    ss = block_sum(ss, sh);
    const float rs = rsqrtf(ss / DM + 1e-6f);
    float hv[4];
    for (int i = 0; i < 4; ++i) { const int k = tid + 256 * i; XN[(size_t)t * DM + k] = f2bf(v[i] * rs); hv[i] = v[i] * rs * g[k]; }
    for (int c = 0; c < 36; ++c) {
        float p = 0.f;
        for (int i = 0; i < 4; ++i) { const int k = tid + 256 * i; p += hv[i] * (c < 4 ? wg[(size_t)k * 4 + c] : we[(size_t)k * 32 + (c - 4)]); }
        p = block_sum(p, sh);
        if (tid == 0) lg[c] = p + (c < 4 ? bg[c] : be[c - 4]);
    }
    __syncthreads();
    if (tid == 0) {
        int gi = 0;
        for (int i = 1; i < 4; ++i) if (lg[i] > lg[gi]) gi = i;
        float den = 0.f;
        for (int i = 0; i < 4; ++i) den += expf(lg[i] - lg[gi]);
        const float gp = 1.f / den;
        const float* le = lg + 4 + gi * 8;
        int i1 = 0;
        for (int i = 1; i < 8; ++i) if (le[i] > le[i1]) i1 = i;
        int i2 = (i1 == 0) ? 1 : 0;
        for (int i = 0; i < 8; ++i) if (i != i1 && le[i] > le[i2]) i2 = i;
        const float r = expf(le[i2] - le[i1]);
        const float g1 = gp / (1.f + r), g2 = gp * r / (1.f + r);
        const int e1 = gi * 8 + i1, e2 = gi * 8 + i2;
        const int p1 = atomicAdd(&CNT[e1], 1);
        LIST[(size_t)e1 * LISTCAP + p1] = t * 2; GATEL[(size_t)e1 * LISTCAP + p1] = g1;
        const int p2 = atomicAdd(&CNT[e2], 1);
        LIST[(size_t)e2 * LISTCAP + p2] = t * 2 + 1; GATEL[(size_t)e2 * LISTCAP + p2] = g2;
    }
}
__global__ void k_gather(const int* CNT, const int* LIST, const float* GATEL, const bf16_t* XN, bf16_t* BUF, float* GATEBUF, int* TOKDEST, int* NT, int* TILEE) {
    __shared__ int s_cnt[32], s_sp[33];
    const int tid = threadIdx.x, wave = tid >> 6, lane = tid & 63;
    if (tid < 32) s_cnt[tid] = CNT[tid];
    __syncthreads();
    if (tid == 0) { s_sp[0] = 0; for (int e = 0; e < 32; ++e) s_sp[e + 1] = s_sp[e] + ((s_cnt[e] + 255) / 256) * 256; }
    __syncthreads();
    if (blockIdx.x == 0 && tid == 0) *NT = s_sp[32] / 256;
    const int r = blockIdx.x * 4 + wave;
    if (r >= s_sp[32]) return;
    int e = 0;
    while (r >= s_sp[e + 1]) ++e;
    const int pos = r - s_sp[e];
    if ((r & 255) == 0 && lane == 0) TILEE[r >> 8] = e;
    uint4* dst = (uint4*)(BUF + (size_t)r * DM);
    if (pos < s_cnt[e]) {
        const int entry = LIST[(size_t)e * LISTCAP + pos];
        const uint4* src = (const uint4*)(XN + (size_t)(entry >> 1) * DM);
        dst[lane] = src[lane]; dst[lane + 64] = src[lane + 64];
        if (lane == 0) { GATEBUF[r] = GATEL[(size_t)e * LISTCAP + pos]; TOKDEST[entry] = r; }
    } else {
        const uint4 z = make_uint4(0, 0, 0, 0);
        dst[lane] = z; dst[lane + 64] = z;
        if (lane == 0) GATEBUF[r] = 0.f;
    }
}
__global__ void k_final(float* X, const bf16_t* YB, const int* TOKDEST) {
    const int t = blockIdx.x, tid = threadIdx.x;
    const int d0 = TOKDEST[2 * t], d1 = TOKDEST[2 * t + 1];
#pragma unroll
    for (int i = 0; i < 4; ++i) {
        const int k = tid + 256 * i;
        X[(size_t)t * DM + k] = X[(size_t)t * DM + k] + bf2f(YB[(size_t)d0 * DM + k]) + bf2f(YB[(size_t)d1 * DM + k]);
    }
}

struct EpiStoreBf16 { bf16_t* out; int ld; int pad; __device__ void operator()(int r, int c, float v) const { out[(size_t)r * ld + c] = f2bf(v); } };
struct EpiResAdd { float* X; __device__ void operator()(int r, int c, float v) const { X[(size_t)r * DM + c] += v; } };
struct EpiDown { bf16_t* YB; const float* GATEBUF; __device__ void operator()(int r, int c, float v) const { YB[(size_t)r * DM + c] = f2bf(v * GATEBUF[r]); } };

template <class Epi>
__global__ __launch_bounds__(256) void k_gemm(const bf16_t* A, const bf16_t* Bt, Epi epi, const int* tile_e, size_t bt_es, const int* nt_ptr, int K) {
    const int wave = threadIdx.x >> 6, lane = threadIdx.x & 63;
    if (nt_ptr && (int)(blockIdx.y * 128) >= *nt_ptr * 256) return;
    const int m0 = blockIdx.y * 128 + (wave >> 1) * 64, n0 = blockIdx.x * 128 + (wave & 1) * 64;
    const bf16_t* B = Bt;
    if (tile_e) B += (size_t)tile_e[blockIdx.y >> 1] * bt_es;
    const int r = lane & 15, q = lane >> 4;
    f32x4 acc[4][4];
    for (int i = 0; i < 4; ++i) for (int j = 0; j < 4; ++j) acc[i][j] = (f32x4){0.f, 0.f, 0.f, 0.f};
    for (int k0 = 0; k0 < K; k0 += 32) {
        bf16x8 a[4], b[4];
        for (int i = 0; i < 4; ++i) a[i] = *(const bf16x8*)(A + (size_t)(m0 + i * 16 + r) * K + k0 + q * 8);
        for (int j = 0; j < 4; ++j) b[j] = *(const bf16x8*)(B + (size_t)(n0 + j * 16 + r) * K + k0 + q * 8);
        for (int i = 0; i < 4; ++i) for (int j = 0; j < 4; ++j) acc[i][j] = __builtin_amdgcn_mfma_f32_16x16x32_bf16(a[i], b[j], acc[i][j], 0, 0, 0);
    }
    for (int i = 0; i < 4; ++i) for (int j = 0; j < 4; ++j) for (int e = 0; e < 4; ++e) epi(m0 + i * 16 + q * 4 + e, n0 + j * 16 + r, acc[i][j][e]);
}
__global__ __launch_bounds__(256) void k_gemm_gu(const bf16_t* A, const bf16_t* Bt, bf16_t* HID, const int* tile_e, size_t bt_es, const int* nt_ptr) {
    const int K = DM;
    const int wave = threadIdx.x >> 6, lane = threadIdx.x & 63;
    if ((int)(blockIdx.y * 128) >= *nt_ptr * 256) return;
    const int m0 = blockIdx.y * 128 + (wave >> 1) * 64, h0 = blockIdx.x * 128 + (wave & 1) * 64;
    const bf16_t* B = Bt + (size_t)tile_e[blockIdx.y >> 1] * bt_es;
    const int r = lane & 15, q = lane >> 4;
    f32x4 ag[4][4], au[4][4];
    for (int i = 0; i < 4; ++i) for (int j = 0; j < 4; ++j) { ag[i][j] = (f32x4){0.f, 0.f, 0.f, 0.f}; au[i][j] = (f32x4){0.f, 0.f, 0.f, 0.f}; }
    for (int k0 = 0; k0 < K; k0 += 32) {
        bf16x8 a[4], bg[4], bu[4];
        for (int i = 0; i < 4; ++i) a[i] = *(const bf16x8*)(A + (size_t)(m0 + i * 16 + r) * K + k0 + q * 8);
        for (int j = 0; j < 4; ++j) {
            const int hc = h0 + j * 16 + r, ng = 8 * (hc >> 2) + (hc & 3);
            bg[j] = *(const bf16x8*)(B + (size_t)ng * K + k0 + q * 8);
            bu[j] = *(const bf16x8*)(B + (size_t)(ng + 4) * K + k0 + q * 8);
        }
        for (int i = 0; i < 4; ++i) for (int j = 0; j < 4; ++j) {
            ag[i][j] = __builtin_amdgcn_mfma_f32_16x16x32_bf16(a[i], bg[j], ag[i][j], 0, 0, 0);
            au[i][j] = __builtin_amdgcn_mfma_f32_16x16x32_bf16(a[i], bu[j], au[i][j], 0, 0, 0);
        }
    }
    for (int i = 0; i < 4; ++i) for (int j = 0; j < 4; ++j) for (int e = 0; e < 4; ++e) {
        const int row = m0 + i * 16 + q * 4 + e, hc = h0 + j * 16 + r;
        HID[(size_t)row * 512 + hc] = f2bf(silu_f(ag[i][j][e]) * au[i][j][e]);
    }
}

__global__ __launch_bounds__(256) void k_qknorm(bf16_t* PROJ, const float* qn, const float* kn) {
    const int idx = blockIdx.x * 256 + threadIdx.x;
    const int t = idx / 12, hh = idx % 12, isk = hh >= 6, h = hh % 6;
    bf16_t* p = PROJ + (size_t)t * NP + (isk ? PC_K : PC_Q) + h * 64;
    float v[64], ss = 0.f;
    for (int i = 0; i < 64; ++i) { v[i] = bf2f(p[i]); ss += v[i] * v[i]; }
    const float rs = rsqrtf(ss / 64.f + 1e-6f) * (isk ? 1.f : 0.125f);
    const float* gn = isk ? kn : qn;
    for (int i = 0; i < 64; ++i) p[i] = f2bf(v[i] * rs * gn[i]);
}

__global__ __launch_bounds__(64) void k_ssd_naive(const bf16_t* PROJ, const float* DT, const float* conv_w, const float* conv_b, const float* dt_bias,
                                                  const float* a_log, const float* dvec, float* YS) {
    __shared__ float xc[32][64], Bc[32][128], Cc[32][128], dtv[32], av[32];
    const int b = blockIdx.x / 6, h = blockIdx.x % 6, g = h / 3, p = threadIdx.x;
    float hst[128];
#pragma unroll
    for (int n = 0; n < 128; ++n) hst[n] = 0.f;
    const float a_h = -expf(a_log[h]), Dh = dvec[h], dtb = dt_bias[h];
    for (int tb = 0; tb < SEQ; tb += 32) {
        __syncthreads();
        for (int idx = p; idx < 32 * 320; idx += 64) {
            const int tt = idx / 320, ch = idx % 320, t = tb + tt;
            const int ci = ch < 64 ? h * 64 + ch : (ch < 192 ? 384 + g * 128 + (ch - 64) : 640 + g * 128 + (ch - 192));
            float acc = conv_b[ci];
            for (int k = 0; k < 4; ++k) { const int tp = t - 3 + k; if (tp >= 0) acc += conv_w[k * 896 + ci] * bf2f(PROJ[(size_t)(b * SEQ + tp) * NP + PC_XBC + ci]); }
            const float v = silu_f(acc);
            if (ch < 64) xc[tt][ch] = v; else if (ch < 192) Bc[tt][ch - 64] = v; else Cc[tt][ch - 192] = v;
        }
        if (p < 32) { const float dt = softplus_f(DT[(size_t)(b * SEQ + tb + p) * 8 + h] + dtb); dtv[p] = dt; av[p] = expf(dt * a_h); }
        __syncthreads();
        for (int tt = 0; tt < 32; ++tt) {
            const float a = av[tt], xv = xc[tt][p], xd = xv * dtv[tt];
            float y = 0.f;
#pragma unroll
            for (int n = 0; n < 128; ++n) { hst[n] = hst[n] * a + Bc[tt][n] * xd; y += Cc[tt][n] * hst[n]; }
            YS[(size_t)(b * SEQ + tb + tt) * 384 + h * 64 + p] = y + xv * Dh;
        }
    }
}
__global__ void k_ssd_fin(const float* YS, const bf16_t* PROJ, const float* gn, bf16_t* CAT) {
    __shared__ float sh[32];
    const int t = blockIdx.x, c = threadIdx.x;
    const float v = YS[(size_t)t * 384 + c] * silu_f(bf2f(PROJ[(size_t)t * NP + PC_Z + c]));
    const float ss = block_sum(v * v, sh);
    CAT[(size_t)t * 1536 + c] = f2bf(v * rsqrtf(ss / 384.f + 1e-6f) * gn[c]);
}

__global__ __launch_bounds__(256) void k_attn_naive(const bf16_t* PROJ, bf16_t* OBR, float* LSE) {
    const int idx = blockIdx.x * 256 + threadIdx.x;
    const int h = idx % 6, t = (idx / 6) % T, br = idx / (6 * T);
    const int d = br == 0 ? 1 : (br == 1 ? 4 : 16);
    const int b = t / SEQ, tp = t % SEQ;
    float q[64], o[64];
    const bf16_t* qp = PROJ + (size_t)t * NP + PC_Q + h * 64;
    for (int i = 0; i < 64; ++i) { q[i] = bf2f(qp[i]); o[i] = 0.f; }
    float m = -INFINITY, l = 0.f;
    for (int j = 0; j <= 128; ++j) {
        const int kp = tp - j * d;
        if (kp < 0) break;
        const bf16_t* kr = PROJ + (size_t)(b * SEQ + kp) * NP + PC_K + h * 64;
        const bf16_t* vr = PROJ + (size_t)(b * SEQ + kp) * NP + PC_V + h * 64;
        float s = 0.f;
        for (int i = 0; i < 64; ++i) s += q[i] * bf2f(kr[i]);
        const float mn = fmaxf(m, s), corr = expf(m - mn), pw = expf(s - mn);
        l = l * corr + pw;
        for (int i = 0; i < 64; ++i) o[i] = o[i] * corr + pw * bf2f(vr[i]);
        m = mn;
    }
    const float il = 1.f / l;
    bf16_t* op = OBR + ((size_t)br * T + t) * 384 + h * 64;
    for (int i = 0; i < 64; ++i) op[i] = f2bf(o[i] * il);
    LSE[((size_t)br * T + t) * 6 + h] = m + logf(l);
}
__global__ void k_attn_comb(const bf16_t* OBR, const float* LSE, bf16_t* CAT) {
    const int idx = blockIdx.x * 256 + threadIdx.x;
    const int dd = idx & 63, h = (idx >> 6) % 6, t = idx / 384;
    const float l0 = LSE[((size_t)0 * T + t) * 6 + h], l1 = LSE[((size_t)1 * T + t) * 6 + h], l2 = LSE[((size_t)2 * T + t) * 6 + h];
    const float mx = fmaxf(l0, fmaxf(l1, l2));
    const float w0 = expf(l0 - mx), w1 = expf(l1 - mx), w2 = expf(l2 - mx), inv = 1.f / (w0 + w1 + w2);
    const size_t off = (size_t)t * 384 + h * 64 + dd;
    const float v = (w0 * bf2f(OBR[off]) + w1 * bf2f(OBR[(size_t)T * 384 + off]) + w2 * bf2f(OBR[(size_t)2 * T * 384 + off])) * inv;
    CAT[(size_t)t * 1536 + 768 + h * 64 + dd] = f2bf(v);
}
__global__ void k_cf_naive(const bf16_t* PROJ, const float* cw, const float* cb, const float* lng, const float* lnb, const float* scw, bf16_t* CAT) {
    __shared__ float sh[32];
    const int t = blockIdx.x, c = threadIdx.x, b = t / SEQ, tp = t % SEQ;
    float u = cb[c];
    for (int k = 0; k < 31; ++k) {
        const int tq = tp - 30 + k;
        if (tq >= 0) { const bf16_t* pr = PROJ + (size_t)(b * SEQ + tq) * NP; u += cw[k * 384 + c] * bf2f(pr[PC_CFA + c]) * sigm_f(bf2f(pr[PC_CFG + c])); }
    }
    const float mean = block_sum(u, sh) / 384.f, dl = u - mean;
    const float var = block_sum(dl * dl, sh) / 384.f;
    const float y = dl * rsqrtf(var + 1e-5f) * lng[c] + lnb[c];
    CAT[(size_t)t * 1536 + 1152 + c] = f2bf(silu_f(y));
    float s = 0.f;
    for (int k = 0; k < 3; ++k) {
        const int tq = tp - 2 + k;
        if (tq >= 0) { const bf16_t* pr = PROJ + (size_t)(b * SEQ + tq) * NP; s += scw[k * 384 + c] * bf2f(pr[PC_SCC + c]) * bf2f(pr[PC_SCH + c]); }
    }
    CAT[(size_t)t * 1536 + 384 + c] = f2bf(bf2f(PROJ[(size_t)t * NP + PC_SCB + c]) * s);
}
__global__ void k_ca_naive(const bf16_t* Q, const bf16_t* KV, const float* qn, bf16_t* O, int l) {
    __shared__ float sh[32];
    __shared__ float qs[256], ps[256];
    const int t = blockIdx.x >> 2, h = blockIdx.x & 3, b = t / SEQ, tid = threadIdx.x;
    const float qv = bf2f(Q[(size_t)t * DM + h * 256 + tid]);
    const float ss = block_sum(qv * qv, sh);
    qs[tid] = qv * rsqrtf(ss / 256.f + 1e-6f) * qn[tid] * 0.0625f;
    __syncthreads();
    const bf16_t* kr = KV + (size_t)(b * MEML + tid) * 4096 + l * 2048 + h * 256;
    float s = 0.f;
    for (int d = 0; d < 256; ++d) s += qs[d] * bf2f(kr[d]);
    const float mx = block_max(s, sh);
    const float p = expf(s - mx);
    const float sum = block_sum(p, sh);
    ps[tid] = p / sum;
    __syncthreads();
    float o = 0.f;
    for (int j = 0; j < 256; ++j) o += ps[j] * bf2f(KV[(size_t)(b * MEML + j) * 4096 + l * 2048 + 1024 + h * 256 + tid]);
    O[(size_t)t * DM + h * 256 + tid] = f2bf(o);
}

namespace pg8 {
#define PG8_LAS __attribute__((address_space(3)))
typedef unsigned short bf16_t;
typedef short bf16x8 __attribute__((ext_vector_type(8)));
typedef float f32x4 __attribute__((ext_vector_type(4)));
typedef unsigned u32x4 __attribute__((ext_vector_type(4)));
constexpr int BM = 256, BK = 64, HALF = 128, HTB = HALF * BK * 2  , STAGE_BYTES = 8 * HTB, NXCD = 8, WGM = 8;

__host__ __device__ __forceinline__ int lds_byte(int r, int c) { const int st = (r >> 4) * 2 + (c >> 5), rr = r & 15, cc = c & 31, ob = rr * 64 + cc * 2; return st * 1024 + (ob ^ (((ob >> 9) & 1) << 5)); }
__host__ __device__ __forceinline__ void stage_rc(int b, int& R, int& C) { const int st = b / 1024, sb = b % 1024, swz = sb ^ (((sb >> 9) & 1) << 5); R = (st >> 1) * 16 + swz / 64; C = (st & 1) * 32 + (swz % 64) / 2; }
__host__ __device__ __forceinline__ int perm32(int rho) { const int n = rho >> 4, i = rho & 15; return 8 * (i >> 2) + 4 * n + (i & 3); }

struct Unit { int pm, pn; };
struct Gemm { const bf16_t* A; const bf16_t* Bt; int M, N, K; };

struct StaticOrder {
    int nM, nN, nwg, G, c;
    __host__ __device__ void init(int M, int N, int G_, int c_) { nM = M / BM; nN = N / BM; nwg = nM * nN; G = G_; c = c_; }
    __host__ __device__ bool next(int i, Unit& u) const {
        const long L = (long)i * G + c; if (L >= nwg) return false;
        int wgid = (int)L; { const int q = nwg / NXCD, r = nwg % NXCD, xcd = wgid % NXCD, off = wgid / NXCD; wgid = (xcd < r ? xcd * (q + 1) : r * (q + 1) + (xcd - r) * q) + off; }
        const int nig = WGM * nN, gid = wgid / nig, fm = gid * WGM, gsz = (nM - fm) < WGM ? (nM - fm) : WGM;
        u.pm = fm + ((wgid % nig) % gsz); u.pn = (wgid % nig) / gsz; return true;
    }
    __device__ __forceinline__ void a_ready(const Unit&) const {}
    __device__ __forceinline__ const char* b_base(const Gemm& g, const Unit&) const { return (const char*)g.Bt; }
    __device__ __forceinline__ void done(const Unit&) const {}
};

__device__ __forceinline__ unsigned cvt_pk_bf16(float lo, float hi) { unsigned r; asm volatile("v_cvt_pk_bf16_f32 %0, %1, %2" : "=v"(r) : "v"(lo), "v"(hi)); return r; }
typedef float f32x2 __attribute__((ext_vector_type(2)));
__device__ __forceinline__ f32x2 gelu_pk(f32x2 v) {
    const f32x2 av = __builtin_elementwise_abs(v), d = av * 0.2316418882f + 1.0f;
    f32x2 t; t.x = __builtin_amdgcn_rcpf(d.x); t.y = __builtin_amdgcn_rcpf(d.y);
    f32x2 q = t * 0.5307027145f + (-0.7265760135f); q = q * t + 0.7107068705f; q = q * t + (-0.142248368f); q = q * t + 0.127414796f; q = q * t;
    const f32x2 s = (v * v) * (-0.72134752044f);
    f32x2 e; e.x = __builtin_amdgcn_exp2f(s.x); e.y = __builtin_amdgcn_exp2f(s.y);
    const f32x2 m = v * (q * e), r = v - m;
    f32x2 o; o.x = v.x < 0.f ? m.x : r.x; o.y = v.y < 0.f ? m.y : r.y; return o;
}

template <int ACT  > struct EpiBf16 {
    static constexpr bool PERM = true, AFTER_DRAIN = false; static_assert(ACT == 0 || ACT == 1, "EpiBf16: ACT is 0 (none) or 1 (gelu_pk)");
    bf16_t* O; int ldc; const float* bias; int split_cols; size_t split_stride; float scale0;
    __device__ __forceinline__ void operator()(const f32x4 (&acc)[2][2][4][2], const Unit& u, int wr, int wc, int fr, int fq) const {
        const int row0 = u.pm * BM + wr * 64 + fr; int colt = u.pn * BM; bf16_t* base = O;
        float sc = 1.f; if (split_cols) { const int t = colt / split_cols; base += (size_t)t * split_stride; colt -= t * split_cols; if (t == 0) sc = scale0; }
        const int col0 = colt + wc * 32 + 8 * fq, bcol0 = u.pn * BM + wc * 32 + 8 * fq;
        f32x4 bv[2][2];
#pragma unroll
        for (int bj = 0; bj < 2; ++bj)
#pragma unroll
            for (int n = 0; n < 2; ++n) bv[bj][n] = bias ? *(const f32x4*)(bias + bcol0 + bj * HALF + 4 * n) : (f32x4){0.f, 0.f, 0.f, 0.f};
#pragma unroll
        for (int ai = 0; ai < 2; ++ai)
#pragma unroll
            for (int m = 0; m < 4; ++m) { bf16_t* rowp = base + (size_t)(row0 + ai * HALF + m * 16) * ldc + col0;
#pragma unroll
                for (int bj = 0; bj < 2; ++bj) { f32x4 v0 = acc[ai][bj][m][0] + bv[bj][0], v1 = acc[ai][bj][m][1] + bv[bj][1];
                    if (ACT == 1) { f32x2 a = gelu_pk((f32x2){v0[0], v0[1]}), b = gelu_pk((f32x2){v0[2], v0[3]}), c = gelu_pk((f32x2){v1[0], v1[1]}), d = gelu_pk((f32x2){v1[2], v1[3]});
                        v0 = (f32x4){a.x, a.y, b.x, b.y}; v1 = (f32x4){c.x, c.y, d.x, d.y}; }
                    v0 = v0 * sc; v1 = v1 * sc; u32x4 w; w.x = cvt_pk_bf16(v0[0], v0[1]); w.y = cvt_pk_bf16(v0[2], v0[3]); w.z = cvt_pk_bf16(v1[0], v1[1]); w.w = cvt_pk_bf16(v1[2], v1[3]);
                    *(u32x4*)(rowp + bj * HALF) = w; } }
    }
};
template <class Epi, class Sched, bool ALIGN_EPI = false, bool SP2 = false>
__device__ __forceinline__ void gemm_phase(PG8_LAS unsigned char* lds, const Gemm g, const Sched& S, const Epi& E) {
    const int tid = threadIdx.x, wid = __builtin_amdgcn_readfirstlane(tid >> 6), lane = tid & 63, wr = wid >> 2, wc = wid & 3, fr = lane & 15, fq = lane >> 4;
    const int K = g.K, nt = K / BK;
    unsigned voffA[2], voffB[2];
#pragma unroll
    for (int i = 0; i < 2; ++i) { int R, C; stage_rc(tid * 16 + i * 8192, R, C); const int Rb = Epi::PERM ? ((R & ~31) + perm32(R & 31)) : R;
        voffA[i] = (unsigned)(R * K + C) * 2u; voffB[i] = (unsigned)(Rb * K + C) * 2u; }
    const size_t kstep = (size_t)(BK * 2);
    const size_t hstep = (size_t)HALF * K * 2;
    const size_t tstep = 2 * hstep;
    const unsigned ldsw = (unsigned)wid * 1024u;
    const int aoff = lds_byte(wr * 64 + fr, fq * 8), boff = lds_byte(wc * 32 + fr, fq * 8);
#define PG8_SA(b, h) (((b) * 2 + (h)) * HTB)
#define PG8_SB(b, h) ((4 + (b) * 2 + (h)) * HTB)
#define PG8_STAGE(bufoff, gbase, voff) do { _Pragma("unroll") for (int _i = 0; _i < 2; ++_i) \
        __builtin_amdgcn_global_load_lds((const unsigned*)((const char*)(gbase) + (voff)[_i]), (PG8_LAS unsigned*)(lds + (bufoff) + ldsw + _i * 8192), 16, 0, 0); } while (0)
#define PG8_LDA(dst, b, h) do { _Pragma("unroll") for (int m = 0; m < 4; ++m) _Pragma("unroll") for (int k = 0; k < 2; ++k) dst[m][k] = *(const PG8_LAS bf16x8*)(lds + PG8_SA(b, h) + aoff + m * 2048 + k * 1024); } while (0)
#define PG8_LDB(dst, b, h) do { _Pragma("unroll") for (int n = 0; n < 2; ++n) _Pragma("unroll") for (int k = 0; k < 2; ++k) dst[n][k] = *(const PG8_LAS bf16x8*)(lds + PG8_SB(b, h) + boff + n * 2048 + k * 1024); } while (0)
#define PG8_MMA(ai, bj, At, Bt) do { __builtin_amdgcn_s_setprio(1); _Pragma("unroll") for (int m = 0; m < 4; ++m) _Pragma("unroll") for (int n = 0; n < 2; ++n) _Pragma("unroll") for (int k = 0; k < 2; ++k) \
        acc[ai][bj][m][n] = __builtin_amdgcn_mfma_f32_16x16x32_bf16(Bt[n][k], At[m][k], acc[ai][bj][m][n], 0, 0, 0); __builtin_amdgcn_s_setprio(0); } while (0)
#define PG8_WAIT_V(n) asm volatile("s_waitcnt vmcnt(" #n ")" ::: "memory")
#define PG8_WAIT_L(n) asm volatile("s_waitcnt lgkmcnt(" #n ")" ::: "memory")
#define PG8_BAR __builtin_amdgcn_s_barrier()
#define PG8_SCHED __builtin_amdgcn_sched_barrier(0)
    Unit cur, nxt; int ui = 0;
    if (!S.next(0, cur)) return;
    f32x4 acc[2][2][4][2];
#pragma unroll
    for (int a = 0; a < 2; ++a)
#pragma unroll
        for (int b = 0; b < 2; ++b)
#pragma unroll
            for (int m = 0; m < 4; ++m)
#pragma unroll
                for (int n = 0; n < 2; ++n) acc[a][b][m][n] = (f32x4){0.f, 0.f, 0.f, 0.f};
    bf16x8 At[4][2], B0[2][2], B1[2][2];
    const char* cA = (const char*)g.A + (size_t)cur.pm * tstep; const char* cB = S.b_base(g, cur) + (size_t)cur.pn * tstep;
    S.a_ready(cur);
    if constexpr (SP2) {
        PG8_STAGE(PG8_SB(0, 0), cB, voffB); PG8_STAGE(PG8_SB(0, 1), cB + hstep, voffB); PG8_STAGE(PG8_SA(0, 0), cA, voffA); PG8_STAGE(PG8_SA(0, 1), cA + hstep, voffA);
        if (wr == 1) PG8_BAR;
        PG8_WAIT_V(2); PG8_BAR;
        PG8_STAGE(PG8_SB(1, 0), cB + kstep, voffB); PG8_STAGE(PG8_SA(1, 0), cA + kstep, voffA); PG8_STAGE(PG8_SB(1, 1), cB + hstep + kstep, voffB);
        PG8_WAIT_V(6); PG8_BAR;
    } else {
        PG8_STAGE(PG8_SB(0, 0), cB, voffB); PG8_STAGE(PG8_SA(0, 0), cA, voffA); PG8_STAGE(PG8_SB(0, 1), cB + hstep, voffB); PG8_STAGE(PG8_SA(0, 1), cA + hstep, voffA);
        if (wr == 1) PG8_BAR;
        PG8_WAIT_V(4); PG8_BAR;
        PG8_STAGE(PG8_SB(1, 0), cB + kstep, voffB); PG8_STAGE(PG8_SA(1, 0), cA + kstep, voffA); PG8_STAGE(PG8_SB(1, 1), cB + hstep + kstep, voffB);
        PG8_WAIT_V(6); PG8_BAR;
    }
    for (;;) {
        const bool has_next = S.next(ui + 1, nxt);
        const char* nA = has_next ? (const char*)g.A + (size_t)nxt.pm * tstep : cA; const char* nB = has_next ? S.b_base(g, nxt) + (size_t)nxt.pn * tstep : cB;
        for (int t = 0; t < nt; t += 2) {
            const bool last = (t == nt - 2);
            const char* a1 = cA + (size_t)(t + 1) * kstep;
            const char* a2 = last ? nA : cA + (size_t)(t + 2) * kstep; const char* b2 = last ? nB : cB + (size_t)(t + 2) * kstep;
            const char* a3 = a2 + kstep; const char* b3 = b2 + kstep;
            if (last && has_next) S.a_ready(nxt);
            if constexpr (SP2) {
            PG8_LDB(B0, 0, 0); PG8_LDB(B1, 0, 1); PG8_SCHED; PG8_LDA(At, 0, 0); PG8_STAGE(PG8_SA(1, 1), a1 + hstep, voffA);
            PG8_WAIT_V(8); PG8_WAIT_L(0); PG8_BAR; PG8_MMA(0, 0, At, B0); PG8_MMA(0, 1, At, B1); PG8_BAR; PG8_SCHED;
            PG8_LDA(At, 0, 1); PG8_STAGE(PG8_SB(0, 0), b2, voffB); PG8_STAGE(PG8_SB(0, 1), b2 + hstep, voffB); PG8_STAGE(PG8_SA(0, 0), a2, voffA);
            PG8_WAIT_V(8); PG8_WAIT_L(0); PG8_BAR; PG8_MMA(1, 0, At, B0); PG8_MMA(1, 1, At, B1); PG8_BAR; PG8_SCHED;
            PG8_LDB(B0, 1, 0); PG8_LDB(B1, 1, 1); PG8_SCHED; PG8_LDA(At, 1, 0); PG8_STAGE(PG8_SA(0, 1), a2 + hstep, voffA);
            PG8_WAIT_V(8); PG8_WAIT_L(0); PG8_BAR; PG8_MMA(0, 0, At, B0); PG8_MMA(0, 1, At, B1); PG8_BAR; PG8_SCHED;
            PG8_LDA(At, 1, 1); PG8_STAGE(PG8_SB(1, 0), b3, voffB); PG8_STAGE(PG8_SB(1, 1), b3 + hstep, voffB); PG8_STAGE(PG8_SA(1, 0), a3, voffA);
            PG8_WAIT_V(8); PG8_WAIT_L(0); PG8_BAR; PG8_MMA(1, 0, At, B0); PG8_MMA(1, 1, At, B1); PG8_BAR; PG8_SCHED;
            } else {
            PG8_LDB(B0, 0, 0); PG8_SCHED; PG8_LDA(At, 0, 0); PG8_STAGE(PG8_SA(1, 1), a1 + hstep, voffA);
            PG8_WAIT_L(8); PG8_BAR; PG8_WAIT_L(0); PG8_MMA(0, 0, At, B0); PG8_BAR; PG8_SCHED;
            PG8_LDB(B1, 0, 1); PG8_STAGE(PG8_SB(0, 0), b2, voffB);
            PG8_BAR; PG8_WAIT_L(0); PG8_MMA(0, 1, At, B1); PG8_BAR;
            PG8_LDA(At, 0, 1); PG8_STAGE(PG8_SA(0, 0), a2, voffA);
            PG8_BAR; PG8_WAIT_L(0); PG8_MMA(1, 0, At, B0); PG8_BAR; PG8_SCHED;
            PG8_STAGE(PG8_SB(0, 1), b2 + hstep, voffB);
            PG8_WAIT_V(6); PG8_BAR; PG8_MMA(1, 1, At, B1); PG8_BAR;
            PG8_LDB(B0, 1, 0); PG8_SCHED; PG8_LDA(At, 1, 0); PG8_STAGE(PG8_SA(0, 1), a2 + hstep, voffA);
            PG8_WAIT_L(8); PG8_BAR; PG8_WAIT_L(0); PG8_MMA(0, 0, At, B0); PG8_BAR; PG8_SCHED;
            PG8_LDB(B1, 1, 1); PG8_STAGE(PG8_SB(1, 0), b3, voffB);
            PG8_BAR; PG8_WAIT_L(0); PG8_MMA(0, 1, At, B1); PG8_BAR;
            PG8_LDA(At, 1, 1); PG8_STAGE(PG8_SA(1, 0), a3, voffA);
            PG8_BAR; PG8_WAIT_L(0); PG8_MMA(1, 0, At, B0); PG8_BAR; PG8_SCHED;
            PG8_STAGE(PG8_SB(1, 1), b3 + hstep, voffB);
            PG8_WAIT_V(6); PG8_BAR; PG8_MMA(1, 1, At, B1); PG8_BAR;
            }
        }
        if constexpr (ALIGN_EPI) { if (wr == 0) PG8_BAR; }
        if constexpr (!Epi::AFTER_DRAIN) { E(acc, cur, wr, wc, fr, fq); S.done(cur); }
        if (!has_next) break;
#pragma unroll
        for (int a = 0; a < 2; ++a)
#pragma unroll
            for (int b = 0; b < 2; ++b)
#pragma unroll
                for (int m = 0; m < 4; ++m)
#pragma unroll
                    for (int n = 0; n < 2; ++n) acc[a][b][m][n] = (f32x4){0.f, 0.f, 0.f, 0.f};
        cur = nxt; cA = nA; cB = nB; ++ui;
        if constexpr (ALIGN_EPI) { if (wr == 1) PG8_BAR; }
    }
    PG8_WAIT_V(0);
    if constexpr (!ALIGN_EPI) { if (wr == 0) PG8_BAR; }
    PG8_BAR;
    if constexpr (Epi::AFTER_DRAIN) { E.fused(acc, cur, wr, wc, fr, fq, lds, wid, lane); S.done(cur); }
#undef PG8_SA
#undef PG8_SB
#undef PG8_STAGE
#undef PG8_LDA
#undef PG8_LDB
#undef PG8_MMA
#undef PG8_WAIT_V
#undef PG8_WAIT_L
#undef PG8_BAR
#undef PG8_SCHED
}
}

namespace pg8 {
struct MoeOrder {
    int nM, nN, nwg, G, c; const int* tile_e; size_t es_bytes;
    __device__ void init(int nM_, int nN_, int G_, int c_, const int* te, size_t es) { nM = nM_; nN = nN_; nwg = nM * nN; G = G_; c = c_; tile_e = te; es_bytes = es; }
    __device__ bool next(int i, Unit& u) const {
        const long L = (long)i * G + c; if (L >= nwg) return false;
        int wgid = (int)L; { const int q = nwg / NXCD, r = nwg % NXCD, xcd = wgid % NXCD, off = wgid / NXCD; wgid = (xcd < r ? xcd * (q + 1) : r * (q + 1) + (xcd - r) * q) + off; }
        const int nig = WGM * nN, gid = wgid / nig, fm = gid * WGM, gsz = (nM - fm) < WGM ? (nM - fm) : WGM;
        u.pm = fm + ((wgid % nig) % gsz); u.pn = (wgid % nig) / gsz; return true;
    }
    __device__ __forceinline__ void a_ready(const Unit&) const {}
    __device__ __forceinline__ void done(const Unit&) const {}
    __device__ __forceinline__ const char* b_base(const Gemm& g, const Unit& u) const { return (const char*)g.Bt + (size_t)tile_e[u.pm] * es_bytes; }
};
struct EpiResAdd {
    static constexpr bool PERM = false, AFTER_DRAIN = false;
    const float* base; float* X; int ldc; int pad;
    __device__ __forceinline__ void operator()(const f32x4 (&acc)[2][2][4][2], const Unit& u, int wr, int wc, int fr, int fq) const {
        const int row0 = u.pm * BM + wr * 64 + fr, col0 = u.pn * BM + wc * 32 + 4 * fq;
#pragma unroll
        for (int ai = 0; ai < 2; ++ai)
#pragma unroll
            for (int m = 0; m < 4; ++m) { const size_t off = (size_t)(row0 + ai * HALF + m * 16) * ldc + col0;
#pragma unroll
                for (int bj = 0; bj < 2; ++bj)
#pragma unroll
                    for (int n = 0; n < 2; ++n) { *(f32x4*)(X + off + bj * HALF + n * 16) = *(const f32x4*)(base + off + bj * HALF + n * 16) + acc[ai][bj][m][n]; } }
    }
};
struct EpiGateUp {
    static constexpr bool PERM = true, AFTER_DRAIN = false;
    bf16_t* HID;
    __device__ __forceinline__ void operator()(const f32x4 (&acc)[2][2][4][2], const Unit& u, int wr, int wc, int fr, int fq) const {
        const int row0 = u.pm * BM + wr * 64 + fr, hc0 = u.pn * 128 + wc * 16 + 4 * fq;
#pragma unroll
        for (int ai = 0; ai < 2; ++ai)
#pragma unroll
            for (int m = 0; m < 4; ++m) { bf16_t* rowp = HID + (size_t)(row0 + ai * HALF + m * 16) * 512 + hc0;
#pragma unroll
                for (int bj = 0; bj < 2; ++bj) { const f32x4 g = acc[ai][bj][m][0], up = acc[ai][bj][m][1]; float h[4];
#pragma unroll
                    for (int i = 0; i < 4; ++i) h[i] = g[i] / (1.f + __expf(-g[i])) * up[i];
                    typedef unsigned u32x2 __attribute__((ext_vector_type(2)));
                    u32x2 w; w.x = cvt_pk_bf16(h[0], h[1]); w.y = cvt_pk_bf16(h[2], h[3]);
                    *(u32x2*)(rowp + bj * 64) = w; } }
    }
};
struct EpiDown {
    static constexpr bool PERM = true, AFTER_DRAIN = false;
    bf16_t* YB; const float* gate;
    __device__ __forceinline__ void operator()(const f32x4 (&acc)[2][2][4][2], const Unit& u, int wr, int wc, int fr, int fq) const {
        const int row0 = u.pm * BM + wr * 64 + fr, col0 = u.pn * BM + wc * 32 + 8 * fq;
#pragma unroll
        for (int ai = 0; ai < 2; ++ai)
#pragma unroll
            for (int m = 0; m < 4; ++m) { const int row = row0 + ai * HALF + m * 16; const float gt = gate[row]; bf16_t* rowp = YB + (size_t)row * 1024 + col0;
#pragma unroll
                for (int bj = 0; bj < 2; ++bj) { const f32x4 v0 = acc[ai][bj][m][0] * gt, v1 = acc[ai][bj][m][1] * gt;
                    u32x4 w; w.x = cvt_pk_bf16(v0[0], v0[1]); w.y = cvt_pk_bf16(v0[2], v0[3]); w.z = cvt_pk_bf16(v1[0], v1[1]); w.w = cvt_pk_bf16(v1[2], v1[3]);
                    *(u32x4*)(rowp + bj * HALF) = w; } }
    }
};
}

#define GAS __attribute__((address_space(1)))
#define LAS __attribute__((address_space(3)))
constexpr int NWAVES = 8, LDS_BYTES = 163840, RING_BYTES = 131072, MISC_OFF = LDS_BYTES - 256;
constexpr int CW_BAR = 4096;
constexpr size_t CTL_ZERO_BYTES = 1u << 20;

#define XB_TMO      128
#define XB_XCNT(j)  (256  + 64 * (j))
#define XB_XSUB(j)  (1280 + 64 * (j))
#define XB_XGEN(j)  (2304 + 64 * (j))
#define XB_TOP      3328
#define XB_TOPGEN   3392
#define XCD_BAR_WORDS 3456
#define XB_SPIN_CAP (1u << 20)
__device__ __forceinline__ unsigned xb_ld(unsigned* p)              { return __hip_atomic_load(p, __ATOMIC_RELAXED, __HIP_MEMORY_SCOPE_AGENT); }
__device__ __forceinline__ unsigned xb_add(unsigned* p, unsigned v) { return __hip_atomic_fetch_add(p, v, __ATOMIC_RELAXED, __HIP_MEMORY_SCOPE_AGENT); }
__device__ __forceinline__ unsigned xb_xcc_id() { return (unsigned)__builtin_amdgcn_s_getreg((3 << 11) | 20) & 0xFu; }
#define XB_SPIN(cond, bar) do { unsigned _sp = 0; while (cond) { __builtin_amdgcn_s_sleep(1); \
    if ((++_sp & 255u) == 0u) { if (xb_ld(&(bar)[XB_TMO])) break; if (_sp > XB_SPIN_CAP) { atomicAdd(&(bar)[XB_TMO], 1u); break; } } } } while (0)
struct XcdBarrier { unsigned* bar; unsigned x; volatile LAS unsigned* st; };
__device__ __forceinline__ XcdBarrier xcd_barrier_post(unsigned* bar, volatile LAS unsigned* st) {
    XcdBarrier b; b.bar = bar; b.x = xb_xcc_id(); b.st = st;
    if (threadIdx.x == 0) (void)xb_add(&bar[XB_XCNT(b.x)], 1u);
    return b;
}
__device__ __forceinline__ void xcd_barrier_complete(unsigned* bar, unsigned x, unsigned& nloc, unsigned& nx) {
    const unsigned G = gridDim.x * gridDim.y * gridDim.z;
    unsigned sum, cnt, mine, sp = 0u;
    for (;;) {
        sum = 0u; cnt = 0u; mine = 0u;
#pragma unroll
        for (unsigned j = 0; j < 16; ++j) { const unsigned c = xb_ld(&bar[XB_XCNT(j)]); sum += c; cnt += (c > 0u) ? 1u : 0u; mine = (j == x) ? c : mine; }
        if (sum == G) break;
        __builtin_amdgcn_s_sleep(1);
        if ((++sp & 255u) == 0u) { if (xb_ld(&bar[XB_TMO])) break; if (sp > XB_SPIN_CAP) { atomicAdd(&bar[XB_TMO], 1u); break; } }
    }
    nloc = mine > 0u ? mine : 1u; nx = cnt > 0u ? cnt : 1u;
}
__device__ __forceinline__ void xcd_barrier(const XcdBarrier& b) {
    asm volatile("s_waitcnt vmcnt(0)" ::: "memory");
    __syncthreads();
    if (threadIdx.x == 0) {
        unsigned* bar = b.bar;
        __builtin_amdgcn_s_waitcnt(0);
        unsigned nloc = b.st[0], nx = b.st[1];
        if (nloc == 0u) { xcd_barrier_complete(bar, b.x, nloc, nx); b.st[0] = nloc; b.st[1] = nx; }
        const unsigned old = xb_add(&bar[XB_XSUB(b.x)], 1u);
        const unsigned gen = old / nloc;
        if (old + 1u == (gen + 1u) * nloc) {
            __builtin_amdgcn_fence(__ATOMIC_RELEASE, "agent");
            asm volatile("s_waitcnt vmcnt(0)" ::: "memory");
            const unsigned og = xb_add(&bar[XB_TOP], 1u);
            const unsigned tg = og / nx;
            if (og + 1u == (tg + 1u) * nx) xb_add(&bar[XB_TOPGEN], 1u);
            else XB_SPIN(xb_ld(&bar[XB_TOPGEN]) == tg, bar);
            __builtin_amdgcn_fence(__ATOMIC_ACQUIRE, "agent");
            xb_add(&bar[XB_XGEN(b.x)], 1u);
            asm volatile("s_waitcnt vmcnt(0)" ::: "memory");
        } else {
            XB_SPIN(xb_ld(&bar[XB_XGEN(b.x)]) == gen, bar);
            __builtin_amdgcn_fence(__ATOMIC_ACQUIRE, "agent");
            asm volatile("s_waitcnt vmcnt(0)" ::: "memory");
        }
    }
    __syncthreads();
}

enum { PH_KVGEMM = 1, PH_L0 = 2, PH_PER_LAYER = 15, PH_FINAL = 32, PH_COUNT = 33 };
enum { LP_NORM1 = 0, LP_GIN = 1, LP_QKN = 2, LP_MIX1 = 3, LP_SCAN = 4, LP_MIX2 = 5, LP_GOUT = 6, LP_NORM2 = 7, LP_GQ = 8, LP_CA = 9, LP_GO = 10, LP_ROUTER = 11, LP_GATHER = 12, LP_GGU = 13, LP_GDOWN = 14 };

struct MkArgs { const float* in[33]; float* out; unsigned char* ws; int ph_lo, ph_hi, bar_region, mask; };
constexpr size_t WS_HALO = 30 * MiB;
constexpr size_t WS_ACS = 524 * MiB, WS_DTS = 526 * MiB;
typedef unsigned u32x2_t __attribute__((ext_vector_type(2)));
typedef unsigned u32x4_t __attribute__((ext_vector_type(4)));
#define LDS_WAIT() asm volatile("s_waitcnt lgkmcnt(0)" ::: "memory")
__device__ __forceinline__ float wave_sum(float v) {
#pragma unroll
    for (int o = 1; o < 64; o <<= 1) v += __shfl_xor(v, o);
    return v;
}
__device__ __forceinline__ unsigned pkbf(float lo, float hi) { return pg8::cvt_pk_bf16(lo, hi); }
__device__ __forceinline__ float bflo(unsigned w) { return __uint_as_float(w << 16); }
__device__ __forceinline__ float bfhi(unsigned w) { return __uint_as_float(w & 0xffff0000u); }
__device__ __forceinline__ float fsilu(float x) { return x / (1.f + __expf(-x)); }
__device__ __forceinline__ float fsigm(float x) { return 1.f / (1.f + __expf(-x)); }

struct CJob { const float* src; const float* src2; const float* scale; bf16_t* dst; int K, N, ld, mode, nz; size_t src_es, dst_es; };
__device__ __forceinline__ void cvt_item(const CJob& j, LAS float* scr, int item, int lane) {
    const int nblk = j.N / 32, per_e = (j.K / 64) * nblk, e = item / per_e, it = item % per_e, kb = it / nblk, nb = it % nblk, k0 = 64 * kb, n0 = 32 * nb, nl = lane & 31;
    const float* base = j.src + (size_t)e * j.src_es;
    int col;
    if (j.mode == 0) col = n0 + nl;
    else if (j.mode == 1) col = n0 + nl + (n0 >= 1280 ? 6 : 0);
    else { col = (n0 >> 1) + (nl >> 3) * 4 + (nl & 3); if (nl & 4) base = j.src2 + (size_t)e * j.src_es; }
#pragma unroll 8
    for (int i = 0; i < 32; ++i) { const int kk = 2 * i + (lane >> 5); float v = base[(size_t)(k0 + kk) * j.ld + col]; if (j.scale) v *= j.scale[k0 + kk]; scr[kk * 33 + nl] = v; }
    LDS_WAIT(); asm volatile("" ::: "memory");
    const int c = lane & 7;
    bf16_t* d = j.dst + (size_t)e * j.dst_es;
#pragma unroll
    for (int q = 0; q < 4; ++q) { const int n = (lane >> 3) + 8 * q; const LAS float* s = scr + (8 * c) * 33 + n;
        u32x4_t o; o.x = pkbf(s[0 * 33], s[1 * 33]); o.y = pkbf(s[2 * 33], s[3 * 33]); o.z = pkbf(s[4 * 33], s[5 * 33]); o.w = pkbf(s[6 * 33], s[7 * 33]);
        *(u32x4_t*)(d + (size_t)(n0 + n) * j.K + k0 + 8 * c) = o; }
    LDS_WAIT(); asm volatile("" ::: "memory");
}
__device__ __forceinline__ void cvt_job(const CJob& j, LAS unsigned char* lds, int wave, int lane, int gw, int NGW) {
    LAS float* scr = (LAS float*)(lds + wave * 16384);
    const int nitems = (j.K / 64) * (j.N / 32) * j.nz;
    for (int it = gw; it < nitems; it += NGW) cvt_item(j, scr, it, lane);
}
__device__ __forceinline__ void cvt_layer_small(const MkArgs& args, int l, LAS unsigned char* lds, int wave, int lane, int gw, int NGW) {
    { CJob j{args.in[3] + (size_t)l * DM * NIN, nullptr, args.in[2] + l * DM, (bf16_t*)(args.ws + WS_WIN), DM, NP, NIN, 1, 1, 0, 0}; cvt_job(j, lds, wave, lane, gw, NGW); }
    { CJob j{args.in[17] + (size_t)l * 1536 * DM, nullptr, nullptr, (bf16_t*)(args.ws + WS_WOUT), 1536, DM, DM, 0, 1, 0, 0}; cvt_job(j, lds, wave, lane, gw, NGW); }
    { CJob j{args.in[20] + (size_t)l * DM * DM, nullptr, args.in[18] + l * DM, (bf16_t*)(args.ws + WS_WQ), DM, DM, DM, 0, 1, 0, 0}; cvt_job(j, lds, wave, lane, gw, NGW); }
    { CJob j{args.in[24] + (size_t)l * DM * DM, nullptr, nullptr, (bf16_t*)(args.ws + WS_WO), DM, DM, DM, 0, 1, 0, 0}; cvt_job(j, lds, wave, lane, gw, NGW); }
}
__device__ __forceinline__ void cvt_layer_experts(const MkArgs& args, int l, LAS unsigned char* lds, int wave, int lane, int gw, int NGW) {
    { CJob j{args.in[30] + (size_t)l * 32 * DM * 512, args.in[31] + (size_t)l * 32 * DM * 512, args.in[25] + l * DM, (bf16_t*)(args.ws + WS_WGU), DM, 1024, 512, 2, 32, (size_t)DM * 512, (size_t)1024 * DM}; cvt_job(j, lds, wave, lane, gw, NGW); }
    { CJob j{args.in[32] + (size_t)l * 32 * 512 * DM, nullptr, nullptr, (bf16_t*)(args.ws + WS_WD), 512, DM, DM, 0, 32, (size_t)512 * DM, (size_t)DM * 512}; cvt_job(j, lds, wave, lane, gw, NGW); }
}
__device__ __forceinline__ void ph_pro0(const MkArgs& args, LAS unsigned char* lds, int wave, int lane, int gw, int NGW) {
    for (int l = 0; l < 2; ++l) { CJob j{args.in[21] + (size_t)l * DM * 2048, nullptr, args.in[19] + l * DM, (bf16_t*)(args.ws + WS_WKV) + (size_t)l * 2048 * DM, DM, 2048, 2048, 0, 1, 0, 0}; cvt_job(j, lds, wave, lane, gw, NGW); }
    cvt_layer_small(args, 0, lds, wave, lane, gw, NGW);
    const float* mem = args.in[1]; bf16_t* MEMN = (bf16_t*)(args.ws + WS_MEMN);
    for (int m = gw; m < BATCH * MEML; m += NGW) {
        f32x4 v[4]; float ss = 0.f;
#pragma unroll
        for (int j = 0; j < 4; ++j) { v[j] = *(const f32x4*)(mem + (size_t)m * DM + 4 * lane + 256 * j); ss += v[j].x * v[j].x + v[j].y * v[j].y + v[j].z * v[j].z + v[j].w * v[j].w; }
        const float rs = rsqrtf(wave_sum(ss) * (1.f / DM) + 1e-6f);
#pragma unroll
        for (int j = 0; j < 4; ++j) { u32x2_t o; o.x = pkbf(v[j].x * rs, v[j].y * rs); o.y = pkbf(v[j].z * rs, v[j].w * rs); *(u32x2_t*)(MEMN + (size_t)m * DM + 4 * lane + 256 * j) = o; }
    }
}
__device__ __forceinline__ void ph_knorm(const MkArgs& args, int lane, int gw, int NGW) {
    bf16_t* KV = (bf16_t*)(args.ws + WS_KV); const float* kn = args.in[23];
    for (int s = gw; s < 512 * 8; s += NGW) {
        const int h = s & 3, l = (s >> 2) & 1, m = s >> 3;
        u32x2_t* p = (u32x2_t*)(KV + (size_t)m * 4096 + l * 2048 + h * 256 + 4 * lane);
        const u32x2_t w = *p; const float a = bflo(w.x), b = bfhi(w.x), c = bflo(w.y), d = bfhi(w.y);
        const float rs = rsqrtf(wave_sum(a * a + b * b + c * c + d * d) * (1.f / 256.f) + 1e-6f);
        const f32x4 g = *(const f32x4*)(kn + l * 256 + 4 * lane);
        u32x2_t o; o.x = pkbf(a * rs * g.x, b * rs * g.y); o.y = pkbf(c * rs * g.z, d * rs * g.w); *p = o;
    }
}
template <int l> __device__ __forceinline__ void ph_norm1(const MkArgs& args, int lane, int gw, int NGW) {
    const float* g = args.in[2] + l * DM; const float* w_in = args.in[3] + (size_t)l * DM * NIN;
    float wdt[16][6];
#pragma unroll
    for (int j = 0; j < 4; ++j)
#pragma unroll
        for (int i = 0; i < 4; ++i) { const int k = 4 * lane + 256 * j + i; const float gk = g[k];
#pragma unroll
            for (int q = 0; q < 6; ++q) wdt[j * 4 + i][q] = gk * w_in[(size_t)k * NIN + 1280 + q]; }
    float* X = args.out; bf16_t* XN = (bf16_t*)(args.ws + WS_XN); const bf16_t* YB = (const bf16_t*)(args.ws + WS_YB);
    const int* TOKDEST = (const int*)(args.ws + WS_TOKDEST); float* DT = (float*)(args.ws + WS_DT);
    for (int t = gw; t < T; t += NGW) {
        f32x4 v[4];
        if (l == 0) {
#pragma unroll
            for (int j = 0; j < 4; ++j) v[j] = *(const f32x4*)(args.in[0] + (size_t)t * DM + 4 * lane + 256 * j);
        } else {
            const int d0 = TOKDEST[2 * t], d1 = TOKDEST[2 * t + 1];
#pragma unroll
            for (int j = 0; j < 4; ++j) {
                const f32x4 x = *(const f32x4*)(X + (size_t)t * DM + 4 * lane + 256 * j);
                const u32x2_t y0 = *(const u32x2_t*)(YB + (size_t)d0 * DM + 4 * lane + 256 * j), y1 = *(const u32x2_t*)(YB + (size_t)d1 * DM + 4 * lane + 256 * j);
                v[j].x = x.x + bflo(y0.x) + bflo(y1.x); v[j].y = x.y + bfhi(y0.x) + bfhi(y1.x); v[j].z = x.z + bflo(y0.y) + bflo(y1.y); v[j].w = x.w + bfhi(y0.y) + bfhi(y1.y);
                *(f32x4*)(X + (size_t)t * DM + 4 * lane + 256 * j) = v[j];
            }
        }
        float ss = 0.f;
#pragma unroll
        for (int j = 0; j < 4; ++j) ss += v[j].x * v[j].x + v[j].y * v[j].y + v[j].z * v[j].z + v[j].w * v[j].w;
        const float rs = rsqrtf(wave_sum(ss) * (1.f / DM) + 1e-6f);
        float p[6] = {0.f, 0.f, 0.f, 0.f, 0.f, 0.f};
#pragma unroll
        for (int j = 0; j < 4; ++j) {
            u32x2_t o; o.x = pkbf(v[j].x * rs, v[j].y * rs); o.y = pkbf(v[j].z * rs, v[j].w * rs);
            *(u32x2_t*)(XN + (size_t)t * DM + 4 * lane + 256 * j) = o;
#pragma unroll
            for (int q = 0; q < 6; ++q) p[q] += v[j].x * wdt[j * 4 + 0][q] + v[j].y * wdt[j * 4 + 1][q] + v[j].z * wdt[j * 4 + 2][q] + v[j].w * wdt[j * 4 + 3][q];
        }
#pragma unroll
        for (int q = 0; q < 6; ++q) p[q] = wave_sum(p[q]) * rs;
        if (lane == 0) { *(f32x4*)(DT + (size_t)t * 8) = (f32x4){p[0], p[1], p[2], p[3]}; *(float2*)(DT + (size_t)t * 8 + 4) = make_float2(p[4], p[5]); }
    }
}
__device__ __forceinline__ void ph_norm2(const MkArgs& args, int lane, int gw, int NGW) {
    const float* X = args.out; bf16_t* XN = (bf16_t*)(args.ws + WS_XN);
    for (int t = gw; t < T; t += NGW) {
        f32x4 v[4]; float ss = 0.f;
#pragma unroll
        for (int j = 0; j < 4; ++j) { v[j] = *(const f32x4*)(X + (size_t)t * DM + 4 * lane + 256 * j); ss += v[j].x * v[j].x + v[j].y * v[j].y + v[j].z * v[j].z + v[j].w * v[j].w; }
        const float rs = rsqrtf(wave_sum(ss) * (1.f / DM) + 1e-6f);
#pragma unroll
        for (int j = 0; j < 4; ++j) { u32x2_t o; o.x = pkbf(v[j].x * rs, v[j].y * rs); o.y = pkbf(v[j].z * rs, v[j].w * rs); *(u32x2_t*)(XN + (size_t)t * DM + 4 * lane + 256 * j) = o; }
    }
}
template <int l> __device__ __forceinline__ void ph_qkn(const MkArgs& args, int lane, int gw, int NGW) {
    bf16_t* PROJ = (bf16_t*)(args.ws + WS_PROJ);
    const float* qn = args.in[11] + l * 64; const float* kn = args.in[12] + l * 64;
    const int li = lane & 15, grp = lane >> 4;
    const f32x4 gq = *(const f32x4*)(qn + 4 * li), gk = *(const f32x4*)(kn + 4 * li);
    for (int t = gw; t < T; t += NGW) {
#pragma unroll
        for (int ps = 0; ps < 3; ++ps) {
            const int seg = ps * 4 + grp;
            u32x2_t* p = (u32x2_t*)(PROJ + (size_t)t * NP + PC_Q + seg * 64 + 4 * li);
            const u32x2_t w = *p; const float a = bflo(w.x), b = bfhi(w.x), c = bflo(w.y), d = bfhi(w.y);
            float ss = a * a + b * b + c * c + d * d;
            ss += __shfl_xor(ss, 1); ss += __shfl_xor(ss, 2); ss += __shfl_xor(ss, 4); ss += __shfl_xor(ss, 8);
            const float rs = rsqrtf(ss * (1.f / 64.f) + 1e-6f) * (seg < 6 ? 0.125f : 1.f);
            const f32x4 gg = seg < 6 ? gq : gk;
            u32x2_t o; o.x = pkbf(a * rs * gg.x, b * rs * gg.y); o.y = pkbf(c * rs * gg.z, d * rs * gg.w); *p = o;
        }
    }
    bf16_t* HALO = (bf16_t*)(args.ws + WS_HALO);
    for (int r = gw; r < 256 * 3; r += NGW) {
        const int j = r % 3, bc = r / 3, c = bc & 127, b = bc >> 7;
        for (int q = lane; q < 112; q += 64) {
            u32x4_t v = (u32x4_t){0u, 0u, 0u, 0u};
            if (c > 0) v = *(const u32x4_t*)(PROJ + (size_t)(b * SEQ + c * 128 - 3 + j) * NP + PC_XBC + 8 * q);
            *(u32x4_t*)(HALO + (size_t)r * 896 + 8 * q) = v;
        }
    }
}
template <int l> __device__ __forceinline__ void ph_router(const MkArgs& args, LAS unsigned char* lds, int tid, int lane, int gw, int NGW) {
    LAS float* Wr = (LAS float*)lds;
    const float* g = args.in[25] + l * DM; const float* wg = args.in[26] + (size_t)l * DM * 4; const float* we = args.in[28] + (size_t)l * DM * 32;
    for (int k = tid; k < DM; k += NWAVES * 64) {
        const float gk = g[k];
        const f32x4 a = *(const f32x4*)(wg + (size_t)k * 4);
        Wr[0 * DM + k] = gk * a.x; Wr[1 * DM + k] = gk * a.y; Wr[2 * DM + k] = gk * a.z; Wr[3 * DM + k] = gk * a.w;
#pragma unroll
        for (int q = 0; q < 8; ++q) { const f32x4 e4 = *(const f32x4*)(we + (size_t)k * 32 + 4 * q);
            Wr[(4 + 4 * q + 0) * DM + k] = gk * e4.x; Wr[(4 + 4 * q + 1) * DM + k] = gk * e4.y; Wr[(4 + 4 * q + 2) * DM + k] = gk * e4.z; Wr[(4 + 4 * q + 3) * DM + k] = gk * e4.w; }
    }
    __syncthreads();
    const float* bg = args.in[27] + l * 4; const float* be = args.in[29] + l * 32;
    const float* X = args.out; bf16_t* XN = (bf16_t*)(args.ws + WS_XN);
    int* CNT = (int*)(args.ws + WS_CTL) + l * 1024 + CW_CNT; int* LIST = (int*)(args.ws + WS_LIST); float* GATEL = (float*)(args.ws + WS_GATEL);
    int nb = 0, my_e1 = 0, my_e2 = 0, my_t = 0; float my_g1 = 0.f, my_g2 = 0.f;
    for (int t = gw; ; t += NGW) {
        if (t < T) {
            f32x4 v[4]; float ss = 0.f;
#pragma unroll
            for (int j = 0; j < 4; ++j) { v[j] = *(const f32x4*)(X + (size_t)t * DM + 4 * lane + 256 * j); ss += v[j].x * v[j].x + v[j].y * v[j].y + v[j].z * v[j].z + v[j].w * v[j].w; }
            const float rs = rsqrtf(wave_sum(ss) * (1.f / DM) + 1e-6f);
#pragma unroll
            for (int j = 0; j < 4; ++j) { u32x2_t o; o.x = pkbf(v[j].x * rs, v[j].y * rs); o.y = pkbf(v[j].z * rs, v[j].w * rs); *(u32x2_t*)(XN + (size_t)t * DM + 4 * lane + 256 * j) = o; }
            float lg[36];
#pragma unroll
            for (int c = 0; c < 36; ++c) {
                float p = 0.f;
#pragma unroll
                for (int j = 0; j < 4; ++j) { const f32x4 w = *(const LAS f32x4*)(Wr + c * DM + 4 * lane + 256 * j); p += v[j].x * w.x + v[j].y * w.y + v[j].z * w.z + v[j].w * w.w; }
                lg[c] = p;
            }
#pragma unroll
            for (int c = 0; c < 36; ++c) lg[c] = wave_sum(lg[c]) * rs + (c < 4 ? bg[c] : be[c - 4]);
            int gi = 0; float gmx = lg[0];
#pragma unroll
            for (int i = 1; i < 4; ++i) if (lg[i] > gmx) { gmx = lg[i]; gi = i; }
            float den = 0.f;
#pragma unroll
            for (int i = 0; i < 4; ++i) den += __expf(lg[i] - gmx);
            const float gp = 1.f / den;
            float le[8];
#pragma unroll
            for (int i = 0; i < 8; ++i) le[i] = gi == 0 ? lg[4 + i] : (gi == 1 ? lg[12 + i] : (gi == 2 ? lg[20 + i] : lg[28 + i]));
            int i1 = 0; float m1 = le[0];
#pragma unroll
            for (int i = 1; i < 8; ++i) if (le[i] > m1) { m1 = le[i]; i1 = i; }
            int i2 = -1; float m2 = -INFINITY;
#pragma unroll
            for (int i = 0; i < 8; ++i) if (i != i1 && le[i] > m2) { m2 = le[i]; i2 = i; }
            const float r = __expf(m2 - m1);
            if (lane == nb) { my_e1 = gi * 8 + i1; my_e2 = gi * 8 + i2; my_g1 = gp / (1.f + r); my_g2 = gp * r / (1.f + r); my_t = t; }
            ++nb;
        }
        if (nb == 32 || t >= T) {
            if (lane < nb) {
                const int p1 = atomicAdd(&CNT[my_e1], 1); LIST[(size_t)my_e1 * LISTCAP + p1] = my_t * 2; GATEL[(size_t)my_e1 * LISTCAP + p1] = my_g1;
                const int p2 = atomicAdd(&CNT[my_e2], 1); LIST[(size_t)my_e2 * LISTCAP + p2] = my_t * 2 + 1; GATEL[(size_t)my_e2 * LISTCAP + p2] = my_g2;
            }
            nb = 0;
        }
        if (t >= T) break;
    }
}
template <int l> __device__ __forceinline__ void ph_gather(const MkArgs& args, LAS unsigned char* lds, int tid, int lane, int gw, int NGW) {
    LAS int* s_cnt = (LAS int*)lds; LAS int* s_sp = s_cnt + 32;
    int* CTLl = (int*)(args.ws + WS_CTL) + l * 1024;
    if (tid < 32) s_cnt[tid] = CTLl[CW_CNT + tid];
    __syncthreads();
    if (tid == 0) { int a = 0; s_sp[0] = 0; for (int e = 0; e < 32; ++e) { a += ((s_cnt[e] + 255) / 256) * 256; s_sp[e + 1] = a; } }
    __syncthreads();
    const int total = s_sp[32];
    if (blockIdx.x == 0 && tid == 0) CTLl[CW_NT] = total / 256;
    const int* LIST = (const int*)(args.ws + WS_LIST); const float* GATEL = (const float*)(args.ws + WS_GATEL);
    const bf16_t* XN = (const bf16_t*)(args.ws + WS_XN); bf16_t* BUF = (bf16_t*)(args.ws + WS_BUF);
    float* GATEBUF = (float*)(args.ws + WS_GATEBUF); int* TOKDEST = (int*)(args.ws + WS_TOKDEST);
    for (int r = gw; r < total; r += NGW) {
        int e = 0;
        while (r >= s_sp[e + 1]) ++e;
        const int pos = r - s_sp[e];
        if ((r & 255) == 0 && lane == 0) CTLl[CW_TILEE + (r >> 8)] = e;
        u32x4_t* dst = (u32x4_t*)(BUF + (size_t)r * DM);
        if (pos < s_cnt[e]) {
            const int entry = LIST[(size_t)e * LISTCAP + pos];
            const u32x4_t* src = (const u32x4_t*)(XN + (size_t)(entry >> 1) * DM);
            dst[lane] = src[lane]; dst[lane + 64] = src[lane + 64];
            if (lane == 0) { GATEBUF[r] = GATEL[(size_t)e * LISTCAP + pos]; TOKDEST[entry] = r; }
        } else {
            const u32x4_t z = (u32x4_t){0u, 0u, 0u, 0u};
            dst[lane] = z; dst[lane + 64] = z;
            if (lane == 0) GATEBUF[r] = 0.f;
        }
    }
}
__device__ __forceinline__ void ph_final(const MkArgs& args, int lane, int gw, int NGW) {
    float* X = args.out; const bf16_t* YB = (const bf16_t*)(args.ws + WS_YB); const int* TOKDEST = (const int*)(args.ws + WS_TOKDEST);
    for (int t = gw; t < T; t += NGW) {
        const int d0 = TOKDEST[2 * t], d1 = TOKDEST[2 * t + 1];
#pragma unroll
        for (int j = 0; j < 4; ++j) {
            f32x4 x = *(const f32x4*)(X + (size_t)t * DM + 4 * lane + 256 * j);
            const u32x2_t y0 = *(const u32x2_t*)(YB + (size_t)d0 * DM + 4 * lane + 256 * j), y1 = *(const u32x2_t*)(YB + (size_t)d1 * DM + 4 * lane + 256 * j);
            x.x += bflo(y0.x) + bflo(y1.x); x.y += bfhi(y0.x) + bfhi(y1.x); x.z += bflo(y0.y) + bflo(y1.y); x.w += bfhi(y0.y) + bfhi(y1.y);
            *(f32x4*)(X + (size_t)t * DM + 4 * lane + 256 * j) = x;
        }
    }
}
__device__ __forceinline__ void ph_attn_comb(const MkArgs& args, int lane, int gw, int NGW) {
    const bf16_t* OBR = (const bf16_t*)(args.ws + WS_OBR); const float* LSE = (const float*)(args.ws + WS_LSE); bf16_t* CAT = (bf16_t*)(args.ws + WS_CAT);
    for (int t = gw; t < T; t += NGW) {
        if (lane < 48) {
            const int h = lane >> 3;
            const float l0 = LSE[((size_t)0 * T + t) * 6 + h], l1 = LSE[((size_t)1 * T + t) * 6 + h], l2 = LSE[((size_t)2 * T + t) * 6 + h];
            const float mx = fmaxf(l0, fmaxf(l1, l2));
            float w0 = __expf(l0 - mx), w1 = __expf(l1 - mx), w2 = __expf(l2 - mx); const float inv = 1.f / (w0 + w1 + w2); w0 *= inv; w1 *= inv; w2 *= inv;
            const u32x4_t a = *(const u32x4_t*)(OBR + ((size_t)0 * T + t) * 384 + 8 * lane), b = *(const u32x4_t*)(OBR + ((size_t)1 * T + t) * 384 + 8 * lane), c = *(const u32x4_t*)(OBR + ((size_t)2 * T + t) * 384 + 8 * lane);
            u32x4_t o;
            o.x = pkbf(w0 * bflo(a.x) + w1 * bflo(b.x) + w2 * bflo(c.x), w0 * bfhi(a.x) + w1 * bfhi(b.x) + w2 * bfhi(c.x));
            o.y = pkbf(w0 * bflo(a.y) + w1 * bflo(b.y) + w2 * bflo(c.y), w0 * bfhi(a.y) + w1 * bfhi(b.y) + w2 * bfhi(c.y));
            o.z = pkbf(w0 * bflo(a.z) + w1 * bflo(b.z) + w2 * bflo(c.z), w0 * bfhi(a.z) + w1 * bfhi(b.z) + w2 * bfhi(c.z));
            o.w = pkbf(w0 * bflo(a.w) + w1 * bflo(b.w) + w2 * bflo(c.w), w0 * bfhi(a.w) + w1 * bfhi(b.w) + w2 * bfhi(c.w));
            *(u32x4_t*)(CAT + (size_t)t * 1536 + 768 + 8 * lane) = o;
        }
    }
}
template <int l> __device__ __forceinline__ void ph_cf(const MkArgs& args, LAS unsigned char* lds, int tid, int wave, int lane) {
    const bf16_t* PROJ = (const bf16_t*)(args.ws + WS_PROJ); bf16_t* CAT = (bf16_t*)(args.ws + WS_CAT);
    const float* cw = args.in[13] + l * 31 * 384; const float* cb = args.in[14] + l * 384; const float* lng = args.in[15] + l * 384; const float* lnb = args.in[16] + l * 384;
    const float* scw = args.in[10] + l * 3 * 384;
    LAS float* cwl = (LAS float*)lds;
    LAS bf16_t* gt = (LAS bf16_t*)(lds + 31 * 384 * 4);
    for (int i = tid; i < 31 * 384; i += NWAVES * 64) cwl[i] = cw[i];
    for (int u = blockIdx.x; u < T / 64; u += gridDim.x) {
        const int b = u / (SEQ / 64), t0 = (u % (SEQ / 64)) * 64;
        __syncthreads();
        for (int idx = tid; idx < 94 * 48; idx += NWAVES * 64) {
            const int rr = idx / 48, cg = idx % 48, tq = t0 - 30 + rr;
            u32x4_t o = (u32x4_t){0u, 0u, 0u, 0u};
            if (tq >= 0) {
                const bf16_t* pr = PROJ + (size_t)(b * SEQ + tq) * NP;
                const u32x4_t a = *(const u32x4_t*)(pr + PC_CFA + 8 * cg), gg = *(const u32x4_t*)(pr + PC_CFG + 8 * cg);
                o.x = pkbf(bflo(a.x) * fsigm(bflo(gg.x)), bfhi(a.x) * fsigm(bfhi(gg.x))); o.y = pkbf(bflo(a.y) * fsigm(bflo(gg.y)), bfhi(a.y) * fsigm(bfhi(gg.y)));
                o.z = pkbf(bflo(a.z) * fsigm(bflo(gg.z)), bfhi(a.z) * fsigm(bfhi(gg.z))); o.w = pkbf(bflo(a.w) * fsigm(bflo(gg.w)), bfhi(a.w) * fsigm(bfhi(gg.w)));
            }
            *(LAS u32x4_t*)(gt + rr * 384 + 8 * cg) = o;
        }
        __syncthreads();
        float su[8], sq[8];
#pragma unroll
        for (int tt = 0; tt < 8; ++tt) { su[tt] = 0.f; sq[tt] = 0.f; }
#pragma unroll 1
        for (int i = 0; i < 6; ++i) {
            const int c = lane + 64 * i;
            float gwv[38], uo[8];
#pragma unroll
            for (int r = 0; r < 38; ++r) gwv[r] = bf2f(gt[(wave * 8 + r) * 384 + c]);
            const float bias = cb[c];
#pragma unroll
            for (int tt = 0; tt < 8; ++tt) uo[tt] = bias;
#pragma unroll
            for (int k = 0; k < 31; ++k) { const float wk = cwl[k * 384 + c];
#pragma unroll
                for (int tt = 0; tt < 8; ++tt) uo[tt] += wk * gwv[tt + k]; }
#pragma unroll
            for (int tt = 0; tt < 8; ++tt) { su[tt] += uo[tt]; sq[tt] += uo[tt] * uo[tt]; }
        }
#pragma unroll
        for (int tt = 0; tt < 8; ++tt) {
            const float mean = wave_sum(su[tt]) * (1.f / 384.f);
            const float var = wave_sum(sq[tt]) * (1.f / 384.f) - mean * mean;
            su[tt] = mean; sq[tt] = rsqrtf(fmaxf(var, 0.f) + 1e-5f);
        }
#pragma unroll 1
        for (int i = 0; i < 6; ++i) {
            const int c = lane + 64 * i;
            float gwv[38], uo[8];
#pragma unroll
            for (int r = 0; r < 38; ++r) gwv[r] = bf2f(gt[(wave * 8 + r) * 384 + c]);
            const float bias = cb[c], lg = lng[c], lb = lnb[c];
#pragma unroll
            for (int tt = 0; tt < 8; ++tt) uo[tt] = bias;
#pragma unroll
            for (int k = 0; k < 31; ++k) { const float wk = cwl[k * 384 + c];
#pragma unroll
                for (int tt = 0; tt < 8; ++tt) uo[tt] += wk * gwv[tt + k]; }
#pragma unroll
            for (int tt = 0; tt < 8; ++tt) { const float y = (uo[tt] - su[tt]) * sq[tt] * lg + lb; CAT[(size_t)(b * SEQ + t0 + wave * 8 + tt) * 1536 + 1152 + c] = f2bf(fsilu(y)); }
        }
        if (lane < 48) {
            float w0[8], w1[8], w2[8];
#pragma unroll
            for (int i = 0; i < 8; ++i) { w0[i] = scw[0 * 384 + 8 * lane + i]; w1[i] = scw[1 * 384 + 8 * lane + i]; w2[i] = scw[2 * 384 + 8 * lane + i]; }
            for (int tt = 0; tt < 8; ++tt) {
                const int tp = t0 + wave * 8 + tt; const size_t row = (size_t)(b * SEQ + tp);
                float acc[8];
#pragma unroll
                for (int i = 0; i < 8; ++i) acc[i] = 0.f;
#pragma unroll
                for (int k = 0; k < 3; ++k) {
                    if (tp - 2 + k >= 0) {
                        const bf16_t* pr = PROJ + (row - 2 + k) * NP;
                        const u32x4_t c4 = *(const u32x4_t*)(pr + PC_SCC + 8 * lane), h4 = *(const u32x4_t*)(pr + PC_SCH + 8 * lane);
                        const float* wk = k == 0 ? w0 : (k == 1 ? w1 : w2);
                        acc[0] += wk[0] * bflo(c4.x) * bflo(h4.x); acc[1] += wk[1] * bfhi(c4.x) * bfhi(h4.x); acc[2] += wk[2] * bflo(c4.y) * bflo(h4.y); acc[3] += wk[3] * bfhi(c4.y) * bfhi(h4.y);
                        acc[4] += wk[4] * bflo(c4.z) * bflo(h4.z); acc[5] += wk[5] * bfhi(c4.z) * bfhi(h4.z); acc[6] += wk[6] * bflo(c4.w) * bflo(h4.w); acc[7] += wk[7] * bfhi(c4.w) * bfhi(h4.w);
                    }
                }
                const u32x4_t b4 = *(const u32x4_t*)(PROJ + row * NP + PC_SCB + 8 * lane);
                u32x4_t o; o.x = pkbf(bflo(b4.x) * acc[0], bfhi(b4.x) * acc[1]); o.y = pkbf(bflo(b4.y) * acc[2], bfhi(b4.y) * acc[3]);
                o.z = pkbf(bflo(b4.z) * acc[4], bfhi(b4.z) * acc[5]); o.w = pkbf(bflo(b4.w) * acc[6], bfhi(b4.w) * acc[7]);
                *(u32x4_t*)(CAT + row * 1536 + 384 + 8 * lane) = o;
            }
        }
    }
    __syncthreads();
}


typedef short v4i16_t __attribute__((ext_vector_type(4)));
__device__ __forceinline__ v4i16_t lds_tr16(LAS const unsigned char* p) { return __builtin_amdgcn_ds_read_tr16_b64_v4i16((LAS v4i16_t*)p); }
#define MFMA16(a, b, c) __builtin_amdgcn_mfma_f32_16x16x32_bf16((a), (b), (c), 0, 0, 0)
template <int l> __device__ __forceinline__ void ph_ca(const MkArgs& args, LAS unsigned char* lds, int tid, int wave, int lane) {
    constexpr int RS = 528;
    const bf16_t* Qb = (const bf16_t*)(args.ws + WS_Q); const bf16_t* KV = (const bf16_t*)(args.ws + WS_KV); bf16_t* Ob = (bf16_t*)(args.ws + WS_O);
    const float* qn = args.in[22] + l * 256;
    const int qi = lane & 15, kq = lane >> 4;
    for (int du = blockIdx.x; du < 512; du += gridDim.x) {
        const int bh = du >> 6, b = bh >> 2, h = bh & 3, qt2 = du & 63;
        __syncthreads();
        for (int idx = tid; idx < 256 * 32; idx += NWAVES * 64) { const int key = idx >> 5, c = idx & 31;
            *(LAS u32x4_t*)(lds + key * RS + 16 * c) = *(const u32x4_t*)(KV + (size_t)(b * MEML + key) * 4096 + l * 2048 + h * 256 + 8 * c); }
        __syncthreads();
        unsigned pP[2][32]; float linv[2];
#pragma unroll
        for (int qt = 0; qt < 2; ++qt) {
            const size_t t0 = (size_t)b * SEQ + (size_t)(qt2 * 2 + qt) * 128 + wave * 16;
            bf16x8 qf[8];
            {
                u32x4_t raw[8]; float ss = 0.f;
#pragma unroll
                for (int ks = 0; ks < 8; ++ks) { raw[ks] = *(const u32x4_t*)(Qb + (t0 + qi) * DM + h * 256 + 32 * ks + 8 * kq);
                    const float a0 = bflo(raw[ks].x), a1 = bfhi(raw[ks].x), a2 = bflo(raw[ks].y), a3 = bfhi(raw[ks].y), a4 = bflo(raw[ks].z), a5 = bfhi(raw[ks].z), a6 = bflo(raw[ks].w), a7 = bfhi(raw[ks].w);
                    ss += a0 * a0 + a1 * a1 + a2 * a2 + a3 * a3 + a4 * a4 + a5 * a5 + a6 * a6 + a7 * a7; }
                ss += __shfl_xor(ss, 16); ss += __shfl_xor(ss, 32);
                const float rs = rsqrtf(ss * (1.f / 256.f) + 1e-6f) * 0.0625f;
#pragma unroll
                for (int ks = 0; ks < 8; ++ks) { const f32x4 g0 = *(const f32x4*)(qn + 32 * ks + 8 * kq), g1 = *(const f32x4*)(qn + 32 * ks + 8 * kq + 4);
                    u32x4_t o; o.x = pkbf(bflo(raw[ks].x) * rs * g0.x, bfhi(raw[ks].x) * rs * g0.y); o.y = pkbf(bflo(raw[ks].y) * rs * g0.z, bfhi(raw[ks].y) * rs * g0.w);
                    o.z = pkbf(bflo(raw[ks].z) * rs * g1.x, bfhi(raw[ks].z) * rs * g1.y); o.w = pkbf(bflo(raw[ks].w) * rs * g1.z, bfhi(raw[ks].w) * rs * g1.w);
                    qf[ks] = __builtin_bit_cast(bf16x8, o); }
            }
            f32x4 sacc[16];
#pragma unroll
            for (int kt = 0; kt < 16; ++kt) { sacc[kt] = (f32x4){0.f, 0.f, 0.f, 0.f};
#pragma unroll
                for (int ks = 0; ks < 8; ++ks) { const bf16x8 a = *(const LAS bf16x8*)(lds + (16 * kt + qi) * RS + (32 * ks + 8 * kq) * 2); sacc[kt] = MFMA16(a, qf[ks], sacc[kt]); } }
            float m = sacc[0][0];
#pragma unroll
            for (int kt = 0; kt < 16; ++kt) m = fmaxf(fmaxf(m, fmaxf(sacc[kt][0], sacc[kt][1])), fmaxf(sacc[kt][2], sacc[kt][3]));
            m = fmaxf(m, __shfl_xor(m, 16)); m = fmaxf(m, __shfl_xor(m, 32));
            float sum = 0.f;
#pragma unroll
            for (int kt = 0; kt < 16; ++kt) { const float p0 = __expf(sacc[kt][0] - m), p1 = __expf(sacc[kt][1] - m), p2 = __expf(sacc[kt][2] - m), p3 = __expf(sacc[kt][3] - m);
                sum += (p0 + p1) + (p2 + p3); pP[qt][2 * kt] = pkbf(p0, p1); pP[qt][2 * kt + 1] = pkbf(p2, p3); }
            sum += __shfl_xor(sum, 16); sum += __shfl_xor(sum, 32);
            linv[qt] = 1.f / sum;
        }
        __syncthreads();
        for (int idx = tid; idx < 256 * 32; idx += NWAVES * 64) { const int key = idx >> 5, c = idx & 31;
            *(LAS u32x4_t*)(lds + key * RS + 16 * c) = *(const u32x4_t*)(KV + (size_t)(b * MEML + key) * 4096 + l * 2048 + 1024 + h * 256 + 8 * c); }
        __syncthreads();
#pragma unroll
        for (int qt = 0; qt < 2; ++qt) {
            const size_t t0 = (size_t)b * SEQ + (size_t)(qt2 * 2 + qt) * 128 + wave * 16;
            LAS const unsigned char* vb = lds + (4 * kq + (qi >> 2)) * RS + 8 * (qi & 3);
#pragma unroll 4
            for (int dt = 0; dt < 16; ++dt) {
                f32x4 o = (f32x4){0.f, 0.f, 0.f, 0.f};
#pragma unroll
                for (int kk = 0; kk < 8; ++kk) {
                    const v4i16_t lo = lds_tr16(vb + (32 * kk) * RS + 32 * dt), hi = lds_tr16(vb + (32 * kk + 16) * RS + 32 * dt);
                    const bf16x8 a = (bf16x8){lo[0], lo[1], lo[2], lo[3], hi[0], hi[1], hi[2], hi[3]};
                    const u32x4_t pb = (u32x4_t){pP[qt][4 * kk], pP[qt][4 * kk + 1], pP[qt][4 * kk + 2], pP[qt][4 * kk + 3]};
                    o = MFMA16(a, __builtin_bit_cast(bf16x8, pb), o);
                }
                u32x2_t w; w.x = pkbf(o[0] * linv[qt], o[1] * linv[qt]); w.y = pkbf(o[2] * linv[qt], o[3] * linv[qt]);
                *(u32x2_t*)(Ob + (t0 + qi) * DM + h * 256 + 16 * dt + 4 * kq) = w;
            }
        }
    }
    __syncthreads();
}
__device__ __forceinline__ void ph_dattn(const MkArgs& args, LAS unsigned char* lds, int tid, int wave, int lane) {
    constexpr int RS = 144, VOFF = 256 * RS;
    const bf16_t* PROJ = (const bf16_t*)(args.ws + WS_PROJ); bf16_t* OBR = (bf16_t*)(args.ws + WS_OBR); float* LSE = (float*)(args.ws + WS_LSE);
    const int qi = lane & 15, kq = lane >> 4;
    for (int idx = tid; idx < 16 * RS / 4; idx += NWAVES * 64) ((LAS unsigned*)(lds + VOFF + 256 * RS))[idx] = 0u;
    for (int u = blockIdx.x; u < 3 * 2 * 6 * 128; u += gridDim.x) {
        const int qt = u & 127, h = (u >> 7) % 6, bb = ((u >> 7) / 6) & 1, br = (u >> 7) / 12;
        const int dil = br == 0 ? 1 : (br == 1 ? 4 : 16), per = SEQ / dil / 128;
        const int res = qt / per, i0 = (qt % per) * 128;
        __syncthreads();
        for (int idx = tid; idx < 256 * 16; idx += NWAVES * 64) {
            const int jk = idx >> 4, c = idx & 15, isv = c >> 3, cc = c & 7, i = i0 - 128 + jk;
            u32x4_t v = (u32x4_t){0u, 0u, 0u, 0u};
            if (i >= 0) v = *(const u32x4_t*)(PROJ + (size_t)(bb * SEQ + i * dil + res) * NP + (isv ? PC_V : PC_K) + h * 64 + 8 * cc);
            *(LAS u32x4_t*)(lds + (isv ? VOFF : 0) + jk * RS + 16 * cc) = v;
        }
        const size_t tq = (size_t)bb * SEQ + (size_t)(i0 + wave * 16 + qi) * dil + res;
        const bf16x8 q0 = *(const bf16x8*)(PROJ + tq * NP + PC_Q + h * 64 + 8 * kq), q1 = *(const bf16x8*)(PROJ + tq * NP + PC_Q + h * 64 + 32 + 8 * kq);
        __syncthreads();
        f32x4 s[9];
#pragma unroll
        for (int kt = 0; kt < 9; ++kt) {
            LAS const unsigned char* kp = lds + (16 * (wave + kt) + qi) * RS + 16 * kq;
            s[kt] = MFMA16(*(const LAS bf16x8*)kp, q0, ((f32x4){0.f, 0.f, 0.f, 0.f}));
            s[kt] = MFMA16(*(const LAS bf16x8*)(kp + 64), q1, s[kt]);
        }
        float m = -INFINITY;
#pragma unroll
        for (int kt = 0; kt < 9; ++kt)
#pragma unroll
            for (int r = 0; r < 4; ++r) {
                const int dist = 128 + qi - 16 * kt - 4 * kq - r, ipos = i0 - 128 + 16 * (wave + kt) + 4 * kq + r;
                const bool ok = dist >= 0 && dist <= 128 && ipos >= 0;
                s[kt][r] = ok ? s[kt][r] : -INFINITY;
                m = fmaxf(m, s[kt][r]);
            }
        m = fmaxf(m, __shfl_xor(m, 16)); m = fmaxf(m, __shfl_xor(m, 32));
        float sum = 0.f; unsigned pp[20];
#pragma unroll
        for (int kt = 0; kt < 9; ++kt) { const float p0 = __expf(s[kt][0] - m), p1 = __expf(s[kt][1] - m), p2 = __expf(s[kt][2] - m), p3 = __expf(s[kt][3] - m);
            sum += (p0 + p1) + (p2 + p3); pp[2 * kt] = pkbf(p0, p1); pp[2 * kt + 1] = pkbf(p2, p3); }
        pp[18] = 0u; pp[19] = 0u;
        sum += __shfl_xor(sum, 16); sum += __shfl_xor(sum, 32);
        const float linv = 1.f / sum;
        LAS const unsigned char* vb = lds + VOFF + (16 * wave + 4 * kq + (qi >> 2)) * RS + 8 * (qi & 3);
        bf16_t* orow = OBR + ((size_t)br * T + tq) * 384 + h * 64;
#pragma unroll
        for (int dt = 0; dt < 4; ++dt) {
            f32x4 o = (f32x4){0.f, 0.f, 0.f, 0.f};
#pragma unroll
            for (int kk = 0; kk < 5; ++kk) {
                const v4i16_t lo = lds_tr16(vb + (32 * kk) * RS + 32 * dt), hi = lds_tr16(vb + (32 * kk + 16) * RS + 32 * dt);
                const bf16x8 a = (bf16x8){lo[0], lo[1], lo[2], lo[3], hi[0], hi[1], hi[2], hi[3]};
                const u32x4_t pb = (u32x4_t){pp[4 * kk], pp[4 * kk + 1], pp[4 * kk + 2], pp[4 * kk + 3]};
                o = MFMA16(a, __builtin_bit_cast(bf16x8, pb), o);
            }
            u32x2_t w; w.x = pkbf(o[0] * linv, o[1] * linv); w.y = pkbf(o[2] * linv, o[3] * linv);
            *(u32x2_t*)(orow + 16 * dt + 4 * kq) = w;
        }
        if (kq == 0) LSE[((size_t)br * T + tq) * 6 + h] = m + __logf(sum);
    }
    __syncthreads();
}

constexpr int SSD_RSX = 400, SSD_RSB = 272;
constexpr int SSD_OFF_ARR = 0;
constexpr int SSD_OFF_X = 9216, SSD_OFF_B = SSD_OFF_X + 128 * SSD_RSX, SSD_OFF_C = SSD_OFF_B + 128 * SSD_RSB;
__device__ __forceinline__ float fsoftplus(float x) { return fmaxf(x, 0.f) + log1pf(__expf(-fabsf(x))); }

template <int l> __device__ __forceinline__ void ph_ssd1(const MkArgs& args, LAS unsigned char* lds, int tid, int wave, int lane) {
    bf16_t* PROJ = (bf16_t*)(args.ws + WS_PROJ); const bf16_t* HALO = (const bf16_t*)(args.ws + WS_HALO);
    const float* DT = (const float*)(args.ws + WS_DT); float* ACS = (float*)(args.ws + WS_ACS); float* DTS = (float*)(args.ws + WS_DTS); float* STATES = (float*)(args.ws + WS_YS);
    const float* conv_w = args.in[4] + l * 4 * 896; const float* conv_b = args.in[5] + l * 896;
    const float* dt_bias = args.in[6] + l * 6; const float* a_log = args.in[7] + l * 6;
    LAS float* acs_l = (LAS float*)(lds + SSD_OFF_ARR); LAS float* dt_l = acs_l + 768; LAS float* fac_l = acs_l + 1536;
    const int qi = lane & 15, kq = lane >> 4;
    for (int u = blockIdx.x; u < 256; u += gridDim.x) {
        const int b = u >> 7, c = u & 127; const size_t row0 = (size_t)b * SEQ + (size_t)c * 128;
        __syncthreads();
        if (wave < 6) {
            const int h = wave; const float ah = -__expf(a_log[h]), bias = dt_bias[h];
            const float d0 = fsoftplus(DT[(row0 + 2 * lane) * 8 + h] + bias), d1 = fsoftplus(DT[(row0 + 2 * lane + 1) * 8 + h] + bias);
            const float v0 = d0 * ah, v1 = v0 + d1 * ah;
            float sc = v1;
#pragma unroll
            for (int o = 1; o < 64; o <<= 1) { const float t = __shfl_up(sc, o); if (lane >= o) sc += t; }
            const float ex = sc - v1, a0 = ex + v0, a1 = ex + v1, tot = __shfl(sc, 63);
            acs_l[h * 128 + 2 * lane] = a0; acs_l[h * 128 + 2 * lane + 1] = a1; dt_l[h * 128 + 2 * lane] = d0; dt_l[h * 128 + 2 * lane + 1] = d1;
            fac_l[h * 128 + 2 * lane] = d0 * __expf(tot - a0); fac_l[h * 128 + 2 * lane + 1] = d1 * __expf(tot - a1);
            ACS[(row0 + 2 * lane) * 8 + h] = a0; ACS[(row0 + 2 * lane + 1) * 8 + h] = a1; DTS[(row0 + 2 * lane) * 8 + h] = d0; DTS[(row0 + 2 * lane + 1) * 8 + h] = d1;
        }
#pragma unroll 1
        for (int g = 0; g < 2; ++g) {
            const int cg = tid % 56, seg = tid / 56, l0 = seg * 16;
            const int ci = cg < 24 ? g * 192 + 8 * cg : (cg < 40 ? 384 + g * 128 + 8 * (cg - 24) : 640 + g * 128 + 8 * (cg - 40));
            u32x4_t hr[3];
            if (tid < 448) {
#pragma unroll
                for (int r = 0; r < 3; ++r) { const int ll = l0 - 3 + r;
                    hr[r] = ll >= 0 ? *(const u32x4_t*)(PROJ + (row0 + ll) * NP + PC_XBC + ci) : *(const u32x4_t*)(HALO + ((size_t)u * 3 + (ll + 3)) * 896 + ci); }
            }
            asm volatile("s_waitcnt vmcnt(0)" ::: "memory");
            __syncthreads();
            if (tid < 448) {
                float w[4][8], bs[8];
#pragma unroll
                for (int i = 0; i < 8; ++i) { bs[i] = conv_b[ci + i];
#pragma unroll
                    for (int k = 0; k < 4; ++k) w[k][i] = conv_w[k * 896 + ci + i]; }
                const int hx = g * 3 + (cg >> 3);
                float win[4][8];
#define UNPK(dst, rr) do { dst[0] = bflo(rr.x); dst[1] = bfhi(rr.x); dst[2] = bflo(rr.y); dst[3] = bfhi(rr.y); dst[4] = bflo(rr.z); dst[5] = bfhi(rr.z); dst[6] = bflo(rr.w); dst[7] = bfhi(rr.w); } while (0)
                UNPK(win[0], hr[0]); UNPK(win[1], hr[1]); UNPK(win[2], hr[2]);
                bf16_t* prow = PROJ + (row0 + l0) * NP + PC_XBC + ci;
#pragma unroll 1
                for (int jb = 0; jb < 16; jb += 8) {
                    u32x4_t raw[8];
#pragma unroll
                    for (int j = 0; j < 8; ++j) raw[j] = *(const u32x4_t*)(prow + (size_t)(jb + j) * NP);
#pragma unroll
                    for (int j = 0; j < 8; ++j) {
                        UNPK(win[(j + 3) & 3], raw[j]);
                        float o[8];
#pragma unroll
                        for (int i = 0; i < 8; ++i) o[i] = fsilu(bs[i] + w[0][i] * win[j & 3][i] + w[1][i] * win[(j + 1) & 3][i] + w[2][i] * win[(j + 2) & 3][i] + w[3][i] * win[(j + 3) & 3][i]);
                        u32x4_t pk; pk.x = pkbf(o[0], o[1]); pk.y = pkbf(o[2], o[3]); pk.z = pkbf(o[4], o[5]); pk.w = pkbf(o[6], o[7]);
                        *(u32x4_t*)(prow + (size_t)(jb + j) * NP) = pk;
                        if (cg < 24) { const float f = fac_l[hx * 128 + l0 + jb + j];
                            u32x4_t ps; ps.x = pkbf(o[0] * f, o[1] * f); ps.y = pkbf(o[2] * f, o[3] * f); ps.z = pkbf(o[4] * f, o[5] * f); ps.w = pkbf(o[6] * f, o[7] * f);
                            *(LAS u32x4_t*)(lds + SSD_OFF_X + (l0 + jb + j) * SSD_RSX + 16 * cg) = ps; }
                        else if (cg < 40) *(LAS u32x4_t*)(lds + SSD_OFF_B + (l0 + jb + j) * SSD_RSB + 16 * (cg - 24)) = pk;
                    }
                }
            }
            __syncthreads();
            bf16x8 bfr[4];
#pragma unroll
            for (int ks = 0; ks < 4; ++ks) {
                LAS const unsigned char* bp = lds + SSD_OFF_B + (32 * ks + 4 * kq + (qi >> 2)) * SSD_RSB + (16 * wave + 4 * (qi & 3)) * 2;
                const v4i16_t lo = lds_tr16(bp), hi = lds_tr16(bp + 16 * SSD_RSB);
                bfr[ks] = (bf16x8){lo[0], lo[1], lo[2], lo[3], hi[0], hi[1], hi[2], hi[3]};
            }
#pragma unroll 1
            for (int hh = 0; hh < 3; ++hh) {
                float* sp = STATES + ((((size_t)u * 6 + g * 3 + hh) * 64) * 128);
#pragma unroll
                for (int pt = 0; pt < 4; ++pt) {
                    f32x4 acc = (f32x4){0.f, 0.f, 0.f, 0.f};
#pragma unroll
                    for (int ks = 0; ks < 4; ++ks) {
                        LAS const unsigned char* xp = lds + SSD_OFF_X + (32 * ks + 4 * kq + (qi >> 2)) * SSD_RSX + (hh * 64 + 16 * pt + 4 * (qi & 3)) * 2;
                        const v4i16_t lo = lds_tr16(xp), hi = lds_tr16(xp + 16 * SSD_RSX);
                        acc = MFMA16(((bf16x8){lo[0], lo[1], lo[2], lo[3], hi[0], hi[1], hi[2], hi[3]}), bfr[ks], acc);
                    }
#pragma unroll
                    for (int r = 0; r < 4; ++r) sp[(size_t)(16 * pt + 4 * kq + r) * 128 + 16 * wave + qi] = acc[r];
                }
            }
        }
    }
    __syncthreads();
}
__device__ __forceinline__ void ph_ssd_scan(const MkArgs& args, int tid) {
    float* STATES = (float*)(args.ws + WS_YS); const float* ACS = (const float*)(args.ws + WS_ACS);
    for (int e = (int)blockIdx.x * (NWAVES * 64) + tid; e < 2 * 6 * 64 * 128; e += (int)gridDim.x * NWAVES * 64) {
        const int pn = e & 8191, h = (e >> 13) % 6, b = e / (6 * 8192);
        float H = 0.f;
#pragma unroll 1
        for (int c0 = 0; c0 < 128; c0 += 8) {
            float s[8], d[8];
#pragma unroll
            for (int i = 0; i < 8; ++i) { s[i] = STATES[(((size_t)(b * 128 + c0 + i)) * 6 + h) * 8192 + pn]; d[i] = ACS[((size_t)b * SEQ + (size_t)(c0 + i) * 128 + 127) * 8 + h]; }
#pragma unroll
            for (int i = 0; i < 8; ++i) { STATES[(((size_t)(b * 128 + c0 + i)) * 6 + h) * 8192 + pn] = H; H = H * __expf(d[i]) + s[i]; }
        }
    }
}
template <int l> __device__ __forceinline__ void ph_ssd2(const MkArgs& args, LAS unsigned char* lds, int tid, int wave, int lane) {
    const bf16_t* PROJ = (const bf16_t*)(args.ws + WS_PROJ); bf16_t* CAT = (bf16_t*)(args.ws + WS_CAT);
    const float* ACS = (const float*)(args.ws + WS_ACS); const float* DTS = (const float*)(args.ws + WS_DTS); const float* STATES = (const float*)(args.ws + WS_YS);
    const float* dvec = args.in[8] + l * 6; const float* gn = args.in[9] + l * 384;
    LAS float* acs_l = (LAS float*)(lds + SSD_OFF_ARR); LAS float* dt_l = acs_l + 768;
    const int qi = lane & 15, kq = lane >> 4;
    for (int u = blockIdx.x; u < 256; u += gridDim.x) {
        const int b = u >> 7, c = u & 127; const size_t row0 = (size_t)b * SEQ + (size_t)c * 128;
        __syncthreads();
        for (int i = tid; i < 768; i += NWAVES * 64) { const int h = i >> 7, ll = i & 127; acs_l[i] = ACS[(row0 + ll) * 8 + h]; dt_l[i] = DTS[(row0 + ll) * 8 + h]; }
        float ssq[4] = {0.f, 0.f, 0.f, 0.f};
#pragma unroll 1
        for (int g = 0; g < 2; ++g) {
            __syncthreads();
            for (int idx = tid; idx < 128 * 56; idx += NWAVES * 64) {
                const int ll = idx / 56, cg = idx % 56;
                if (cg < 24) {
                    const u32x4_t v = *(const u32x4_t*)(PROJ + (row0 + ll) * NP + PC_XBC + g * 192 + 8 * cg);
                    const float f = dt_l[(g * 3 + (cg >> 3)) * 128 + ll];
                    u32x4_t ps; ps.x = pkbf(bflo(v.x) * f, bfhi(v.x) * f); ps.y = pkbf(bflo(v.y) * f, bfhi(v.y) * f); ps.z = pkbf(bflo(v.z) * f, bfhi(v.z) * f); ps.w = pkbf(bflo(v.w) * f, bfhi(v.w) * f);
                    *(LAS u32x4_t*)(lds + SSD_OFF_X + ll * SSD_RSX + 16 * cg) = ps;
                } else if (cg < 40) *(LAS u32x4_t*)(lds + SSD_OFF_B + ll * SSD_RSB + 16 * (cg - 24)) = *(const u32x4_t*)(PROJ + (row0 + ll) * NP + PC_XBC + 384 + g * 128 + 8 * (cg - 24));
                else *(LAS u32x4_t*)(lds + SSD_OFF_C + ll * SSD_RSB + 16 * (cg - 40)) = *(const u32x4_t*)(PROJ + (row0 + ll) * NP + PC_XBC + 640 + g * 128 + 8 * (cg - 40));
            }
            __syncthreads();
            bf16x8 cfr[4];
#pragma unroll
            for (int ks = 0; ks < 4; ++ks) cfr[ks] = *(const LAS bf16x8*)(lds + SSD_OFF_C + (16 * wave + qi) * SSD_RSB + (32 * ks + 8 * kq) * 2);
            f32x4 cb[8];
#pragma unroll
            for (int st = 0; st < 8; ++st) { cb[st] = (f32x4){0.f, 0.f, 0.f, 0.f};
                if (st <= wave) {
#pragma unroll
                    for (int ks = 0; ks < 4; ++ks) cb[st] = MFMA16(cfr[ks], *(const LAS bf16x8*)(lds + SSD_OFF_B + (16 * st + qi) * SSD_RSB + (32 * ks + 8 * kq) * 2), cb[st]); } }
            __syncthreads();
            LAS unsigned char* mw = lds + SSD_OFF_B + wave * (16 * SSD_RSB);
#pragma unroll 1
            for (int hh = 0; hh < 3; ++hh) {
                const int h = g * 3 + hh;
                float al[4], el[4];
#pragma unroll
                for (int r = 0; r < 4; ++r) { al[r] = acs_l[h * 128 + 16 * wave + 4 * kq + r]; el[r] = __expf(al[r]); }
#pragma unroll
                for (int st = 0; st < 8; ++st) { const int s = 16 * st + qi; const float as = acs_l[h * 128 + s];
#pragma unroll
                    for (int r = 0; r < 4; ++r) { const int ll = 16 * wave + 4 * kq + r; const float mv = s <= ll ? cb[st][r] * __expf(al[r] - as) : 0.f;
                        *(LAS bf16_t*)(mw + (4 * kq + r) * SSD_RSB + s * 2) = f2bf(mv); } }
                LDS_WAIT(); asm volatile("" ::: "memory");
                bf16x8 mfr[4];
#pragma unroll
                for (int ks = 0; ks < 4; ++ks) mfr[ks] = *(const LAS bf16x8*)(mw + qi * SSD_RSB + (32 * ks + 8 * kq) * 2);
                const float* prev = STATES + (((size_t)u * 6 + h) * 64) * 128;
                const float Dh = dvec[h];
#pragma unroll
                for (int pt = 0; pt < 4; ++pt) {
                    f32x4 yd = (f32x4){0.f, 0.f, 0.f, 0.f}, yo = (f32x4){0.f, 0.f, 0.f, 0.f};
#pragma unroll
                    for (int ks = 0; ks < 4; ++ks) {
                        LAS const unsigned char* xp = lds + SSD_OFF_X + (32 * ks + 8 * kq + (qi >> 2)) * SSD_RSX + (hh * 64 + 16 * pt + 4 * (qi & 3)) * 2;
                        const v4i16_t lo = lds_tr16(xp), hi = lds_tr16(xp + 4 * SSD_RSX);
                        yd = MFMA16(mfr[ks], ((bf16x8){lo[0], lo[1], lo[2], lo[3], hi[0], hi[1], hi[2], hi[3]}), yd);
                        const f32x4 p0 = *(const f32x4*)(prev + (size_t)(16 * pt + qi) * 128 + 32 * ks + 8 * kq), p1 = *(const f32x4*)(prev + (size_t)(16 * pt + qi) * 128 + 32 * ks + 8 * kq + 4);
                        u32x4_t pb; pb.x = pkbf(p0.x, p0.y); pb.y = pkbf(p0.z, p0.w); pb.z = pkbf(p1.x, p1.y); pb.w = pkbf(p1.z, p1.w);
                        yo = MFMA16(cfr[ks], __builtin_bit_cast(bf16x8, pb), yo);
                    }
#pragma unroll
                    for (int r = 0; r < 4; ++r) {
                        const size_t row = row0 + 16 * wave + 4 * kq + r; const int ch = h * 64 + 16 * pt + qi;
                        const float xs = bf2f(PROJ[row * NP + PC_XBC + ch]), z = bf2f(PROJ[row * NP + PC_Z + ch]);
                        const float v = (yd[r] + yo[r] * el[r] + Dh * xs) * fsilu(z);
                        CAT[row * 1536 + ch] = f2bf(v); ssq[r] += v * v;
                    }
                }
                LDS_WAIT(); asm volatile("" ::: "memory");
            }
        }
#pragma unroll
        for (int r = 0; r < 4; ++r) { float q = ssq[r]; q += __shfl_xor(q, 1); q += __shfl_xor(q, 2); q += __shfl_xor(q, 4); q += __shfl_xor(q, 8); ssq[r] = rsqrtf(q * (1.f / 384.f) + 1e-6f); }
#pragma unroll 1
        for (int hp = 0; hp < 24; ++hp) { const int ch = hp * 16 + qi; const float gg = gn[ch];
#pragma unroll
            for (int r = 0; r < 4; ++r) { bf16_t* p = CAT + (row0 + 16 * wave + 4 * kq + r) * 1536 + ch; *p = f2bf(bf2f(*p) * ssq[r] * gg); } }
    }
    __syncthreads();
}

#define WSP(type, off) ((type*)(args.ws + (off)))
#define IN(k) (lo <= (k) && (k) < hi)
#define SEAM(k) do { if (IN(k) && IN((k) + 1)) xcd_barrier(bar); } while (0)
template <int l> __device__ __forceinline__ void layer_phases(const MkArgs& args, LAS unsigned char* lds, const XcdBarrier& bar, const int lo, const int hi) {
    const int P0 = PH_L0 + l * PH_PER_LAYER;
    const int tid = threadIdx.x, lane = tid & 63, wave = __builtin_amdgcn_readfirstlane(tid >> 6);
    const int gw = (int)blockIdx.x * NWAVES + wave, NGW = (int)gridDim.x * NWAVES;
    if (IN(P0 + LP_NORM1)) {
        if (l == 0) ph_knorm(args, lane, gw, NGW); else cvt_layer_small(args, l, lds, wave, lane, gw, NGW);
        ph_norm1<l>(args, lane, gw, NGW);
    }
    SEAM(P0 + LP_NORM1);
    if (IN(P0 + LP_GIN)) {
        pg8::Gemm g{WSP(bf16_t, WS_XN), WSP(bf16_t, WS_WIN), T, NP, DM}; pg8::StaticOrder S; S.init(T, NP, gridDim.x, (int)blockIdx.x);
        pg8::EpiBf16<0> E{WSP(bf16_t, WS_PROJ), NP, nullptr, 0, 0, 1.f};
        pg8::gemm_phase<pg8::EpiBf16<0>, pg8::StaticOrder, true, true>(lds, g, S, E);
    }
    SEAM(P0 + LP_GIN);
    if (IN(P0 + LP_QKN)) ph_qkn<l>(args, lane, gw, NGW);
    SEAM(P0 + LP_QKN);
    if (IN(P0 + LP_MIX1)) {
        if (args.mask & 1) ph_cf<l>(args, lds, tid, wave, lane);
        if (args.mask & 2) ph_dattn(args, lds, tid, wave, lane);
        if (args.mask & 4) ph_ssd1<l>(args, lds, tid, wave, lane);
    }
    SEAM(P0 + LP_MIX1);
    if (IN(P0 + LP_SCAN)) ph_ssd_scan(args, tid);
    SEAM(P0 + LP_SCAN);
    if (IN(P0 + LP_MIX2)) {
        if (args.mask & 1) ph_attn_comb(args, lane, gw, NGW);
        if (args.mask & 4) ph_ssd2<l>(args, lds, tid, wave, lane);
    }
    SEAM(P0 + LP_MIX2);
    if (IN(P0 + LP_GOUT)) {
        pg8::Gemm g{WSP(bf16_t, WS_CAT), WSP(bf16_t, WS_WOUT), T, DM, 1536}; pg8::StaticOrder S; S.init(T, DM, gridDim.x, (int)blockIdx.x);
        pg8::EpiResAdd E{l == 0 ? args.in[0] : args.out, args.out, DM, 0};
        pg8::gemm_phase<pg8::EpiResAdd, pg8::StaticOrder, true, true>(lds, g, S, E);
    }
    SEAM(P0 + LP_GOUT);
    if (IN(P0 + LP_NORM2)) { ph_norm2(args, lane, gw, NGW); cvt_layer_experts(args, l, lds, wave, lane, gw, NGW); }
    SEAM(P0 + LP_NORM2);
    if (IN(P0 + LP_GQ)) {
        pg8::Gemm g{WSP(bf16_t, WS_XN), WSP(bf16_t, WS_WQ), T, DM, DM}; pg8::StaticOrder S; S.init(T, DM, gridDim.x, (int)blockIdx.x);
        pg8::EpiBf16<0> E{WSP(bf16_t, WS_Q), DM, nullptr, 0, 0, 1.f};
        pg8::gemm_phase<pg8::EpiBf16<0>, pg8::StaticOrder, true, true>(lds, g, S, E);
    }
    SEAM(P0 + LP_GQ);
    if (IN(P0 + LP_CA)) ph_ca<l>(args, lds, tid, wave, lane);
    SEAM(P0 + LP_CA);
    if (IN(P0 + LP_GO)) {
        pg8::Gemm g{WSP(bf16_t, WS_O), WSP(bf16_t, WS_WO), T, DM, DM}; pg8::StaticOrder S; S.init(T, DM, gridDim.x, (int)blockIdx.x);
        pg8::EpiResAdd E{args.out, args.out, DM, 0};
        pg8::gemm_phase<pg8::EpiResAdd, pg8::StaticOrder, true, true>(lds, g, S, E);
    }
    SEAM(P0 + LP_GO);
    if (IN(P0 + LP_ROUTER)) ph_router<l>(args, lds, tid, lane, gw, NGW);
    SEAM(P0 + LP_ROUTER);
    if (IN(P0 + LP_GATHER)) ph_gather<l>(args, lds, tid, lane, gw, NGW);
    SEAM(P0 + LP_GATHER);
    if (IN(P0 + LP_GGU)) {
        const int* CTLl = WSP(const int, WS_CTL) + l * 1024; const int nt = CTLl[CW_NT];
        pg8::Gemm g{WSP(bf16_t, WS_BUF), WSP(bf16_t, WS_WGU), nt * 256, 1024, DM}; pg8::MoeOrder S; S.init(nt, 4, gridDim.x, (int)blockIdx.x, CTLl + CW_TILEE, (size_t)1024 * DM * 2);
        pg8::EpiGateUp E{WSP(bf16_t, WS_HID)};
        pg8::gemm_phase<pg8::EpiGateUp, pg8::MoeOrder, true, true>(lds, g, S, E);
    }
    SEAM(P0 + LP_GGU);
    if (IN(P0 + LP_GDOWN)) {
        const int* CTLl = WSP(const int, WS_CTL) + l * 1024; const int nt = CTLl[CW_NT];
        pg8::Gemm g{WSP(bf16_t, WS_HID), WSP(bf16_t, WS_WD), nt * 256, 1024, 512}; pg8::MoeOrder S; S.init(nt, 4, gridDim.x, (int)blockIdx.x, CTLl + CW_TILEE, (size_t)DM * 512 * 2);
        pg8::EpiDown E{WSP(bf16_t, WS_YB), WSP(const float, WS_GATEBUF)};
        pg8::gemm_phase<pg8::EpiDown, pg8::MoeOrder, true, true>(lds, g, S, E);
    }
    SEAM(P0 + LP_GDOWN);
}
__global__ void __launch_bounds__(NWAVES * 64, 2) mk_fwd(MkArgs args) {
    extern __shared__ __attribute__((aligned(16))) unsigned char lds_raw[];
    LAS unsigned char* lds = (LAS unsigned char*)lds_raw;
    for (int u = threadIdx.x; u < 64; u += NWAVES * 64) ((LAS unsigned*)(lds + MISC_OFF))[u] = 0u;
    __syncthreads();
    XcdBarrier bar = xcd_barrier_post(WSP(unsigned, WS_CTL) + CW_BAR + args.bar_region * XCD_BAR_WORDS, (volatile LAS unsigned*)(lds + MISC_OFF) + 8);
    const int lo = args.ph_lo, hi = args.ph_hi;
    if (IN(0)) { const int tid = threadIdx.x, lane = tid & 63, wave = __builtin_amdgcn_readfirstlane(tid >> 6);
        ph_pro0(args, lds, wave, lane, (int)blockIdx.x * NWAVES + wave, (int)gridDim.x * NWAVES); }
    SEAM(0);
    if (IN(PH_KVGEMM)) {
        pg8::Gemm g{WSP(bf16_t, WS_MEMN), WSP(bf16_t, WS_WKV), 512, 4096, DM}; pg8::StaticOrder S; S.init(512, 4096, gridDim.x, (int)blockIdx.x);
        pg8::EpiBf16<0> E{WSP(bf16_t, WS_KV), 4096, nullptr, 0, 0, 1.f};
        pg8::gemm_phase<pg8::EpiBf16<0>, pg8::StaticOrder, true, true>(lds, g, S, E);
    }
    SEAM(PH_KVGEMM);
    layer_phases<0>(args, lds, bar, lo, hi);
    layer_phases<1>(args, lds, bar, lo, hi);
    if (IN(PH_FINAL)) { const int tid = threadIdx.x, lane = tid & 63, wave = __builtin_amdgcn_readfirstlane(tid >> 6);
        ph_final(args, lane, (int)blockIdx.x * NWAVES + wave, (int)gridDim.x * NWAVES); }
#undef IN
#undef SEAM
}

static void convert(hipStream_t s, const float* src, const float* src2, const float* scale, bf16_t* dst, int K, int N, int ld, int mode, int nz, size_t ses, size_t des) {
    CvtJob j{src, src2, scale, dst, K, N, ld, mode, ses, des};
    hipLaunchKernelGGL(k_convert, dim3(K / 32, N / 32, nz), dim3(32, 8), 0, s, j);
}
static int g_grid = 0, g_region = 0;
static void mk(hipStream_t stream, void* const* d_in, void* d_out, void* d_ws, int lo, int hi, int mask = 0) {
    MkArgs a{};
    for (int i = 0; i < 33; ++i) a.in[i] = (const float*)d_in[i];
    a.out = (float*)d_out; a.ws = (unsigned char*)d_ws; a.ph_lo = lo; a.ph_hi = hi; a.bar_region = g_region++; a.mask = mask;
    hipLaunchKernelGGL(mk_fwd, dim3(g_grid), dim3(NWAVES * 64), LDS_BYTES, stream, a);
}
#define USE_MK_GEMM 1

extern "C" void kernel_launch(void* const* d_in, const int* in_sizes, int n_in, void* d_out, int out_size, void* d_ws, size_t ws_size, hipStream_t stream) {
    if (n_in != 33 || ws_size < WS_END) { fprintf(stderr, "kernel_launch: bad n_in %d or ws %zu < %zu\n", n_in, ws_size, (size_t)WS_END); return; }
    if (g_grid == 0) {
        int dev = 0, cus = 0;
        (void)hipGetDevice(&dev); (void)hipDeviceGetAttribute(&cus, hipDeviceAttributeMultiprocessorCount, dev);
        if (hipFuncSetAttribute((const void*)mk_fwd, hipFuncAttributeMaxDynamicSharedMemorySize, LDS_BYTES) != hipSuccess) fprintf(stderr, "hipFuncSetAttribute failed\n");
        g_grid = cus > 0 ? cus : 256;
    }
    const float* const* in = (const float* const*)d_in;
    char* ws = (char*)d_ws;
    int* CTL = (int*)(ws + WS_CTL);
    bf16_t *KV = (bf16_t*)(ws + WS_KV), *PROJ = (bf16_t*)(ws + WS_PROJ), *Qb = (bf16_t*)(ws + WS_Q), *Ob = (bf16_t*)(ws + WS_O), *CAT = (bf16_t*)(ws + WS_CAT);
    bf16_t *OBR = (bf16_t*)(ws + WS_OBR);
    float *LSE = (float*)(ws + WS_LSE), *YS = (float*)(ws + WS_YS), *DT = (float*)(ws + WS_DT);

    (void)hipMemsetAsync(CTL, 0, CTL_ZERO_BYTES, stream);
    g_region = 0;
#define MK(lo, hi, mask) mk(stream, d_in, d_out, d_ws, (lo), (hi), (mask))
    MK(0, PH_COUNT, 7);
#undef MK
}
```

```cpp
#include <hip/hip_runtime.h>
#include <stdint.h>
#include <stdio.h>

typedef unsigned short bf16_t;
typedef short bf16x8 __attribute__((ext_vector_type(8)));
typedef float f32x4 __attribute__((ext_vector_type(4)));

constexpr int DM = 1024, BATCH = 2, SEQ = 16384, T = BATCH * SEQ, MEML = 256;
constexpr int NIN = 4358, NP = 4352;
constexpr int PC_Z = 0, PC_XBC = 384, PC_SCB = 1280, PC_SCC = 1664, PC_SCH = 2048, PC_Q = 2432, PC_K = 2816, PC_V = 3200, PC_CFA = 3584, PC_CFG = 3968;
constexpr int NEXP = 32, LISTCAP = 65536, PROWS = 65536 + 32 * 256;
constexpr size_t MiB = 1u << 20;
constexpr size_t WS_CTL = 0, WS_WIN = 1 * MiB, WS_WOUT = 10 * MiB, WS_WQ = 13 * MiB, WS_WO = 15 * MiB, WS_WKV = 17 * MiB, WS_MEMN = 25 * MiB, WS_KV = 26 * MiB;
constexpr size_t WS_PROJ = 33 * MiB, WS_Q = 33 * MiB, WS_O = 97 * MiB, WS_BUF = 33 * MiB, WS_YB = 33 * MiB, WS_HID = 177 * MiB;
constexpr size_t WS_CAT = 305 * MiB, WS_XN = 305 * MiB;
constexpr size_t WS_OBR = 401 * MiB, WS_LSE = 473 * MiB, WS_YS = 476 * MiB, WS_DT = 525 * MiB;
constexpr size_t WS_WGU = 401 * MiB, WS_WD = 465 * MiB;
constexpr size_t WS_LIST = 527 * MiB, WS_GATEL = 535 * MiB, WS_TOKDEST = 543 * MiB, WS_GATEBUF = 544 * MiB, WS_END = 545 * MiB;
constexpr int CW_CNT = 0, CW_CNT_STRIDE = 32, CW_NT = 1024, CW_TILEE = 1088, CW_LAYER = 2048;

__device__ __forceinline__ float bf2f(bf16_t v) { return __uint_as_float(((unsigned)v) << 16); }
__device__ __forceinline__ bf16_t f2bf(float f) { unsigned u = __float_as_uint(f); return (bf16_t)((u + 0x7fffu + ((u >> 16) & 1u)) >> 16); }

namespace pg8 {
#define PG8_LAS __attribute__((address_space(3)))
typedef unsigned short bf16_t;
typedef short bf16x8 __attribute__((ext_vector_type(8)));
typedef float f32x4 __attribute__((ext_vector_type(4)));
typedef unsigned u32x4 __attribute__((ext_vector_type(4)));
constexpr int BM = 256, BK = 64, HALF = 128, HTB = HALF * BK * 2  , STAGE_BYTES = 8 * HTB, NXCD = 8, WGM = 8;

__host__ __device__ __forceinline__ int lds_byte(int r, int c) { const int st = (r >> 4) * 2 + (c >> 5), rr = r & 15, cc = c & 31, ob = rr * 64 + cc * 2; return st * 1024 + (ob ^ (((ob >> 9) & 1) << 5)); }
__host__ __device__ __forceinline__ void stage_rc(int b, int& R, int& C) { const int st = b / 1024, sb = b % 1024, swz = sb ^ (((sb >> 9) & 1) << 5); R = (st >> 1) * 16 + swz / 64; C = (st & 1) * 32 + (swz % 64) / 2; }
__host__ __device__ __forceinline__ int perm32(int rho) { const int n = rho >> 4, i = rho & 15; return 8 * (i >> 2) + 4 * n + (i & 3); }

struct Unit { int pm, pn; };
struct Gemm { const bf16_t* A; const bf16_t* Bt; int M, N, K; };

struct StaticOrder {
    static constexpr bool GATHER = false;
    __device__ __forceinline__ unsigned a_rowoff(const Unit&, int) const { return 0u; }
    int nM, nN, nwg, G, c;
    __host__ __device__ void init(int M, int N, int G_, int c_) { nM = M / BM; nN = N / BM; nwg = nM * nN; G = G_; c = c_; }
    __host__ __device__ bool next(int i, Unit& u) const {
        const long L = (long)i * G + c; if (L >= nwg) return false;
        int wgid = (int)L; { const int q = nwg / NXCD, r = nwg % NXCD, xcd = wgid % NXCD, off = wgid / NXCD; wgid = (xcd < r ? xcd * (q + 1) : r * (q + 1) + (xcd - r) * q) + off; }
        const int nig = WGM * nN, gid = wgid / nig, fm = gid * WGM, gsz = (nM - fm) < WGM ? (nM - fm) : WGM;
        u.pm = fm + ((wgid % nig) % gsz); u.pn = (wgid % nig) / gsz; return true;
    }
    __device__ __forceinline__ void a_ready(const Unit&) const {}
    __device__ __forceinline__ const char* b_base(const Gemm& g, const Unit&) const { return (const char*)g.Bt; }
    __device__ __forceinline__ void done(const Unit&) const {}
};

__device__ __forceinline__ unsigned cvt_pk_bf16(float lo, float hi) { unsigned r; asm volatile("v_cvt_pk_bf16_f32 %0, %1, %2" : "=v"(r) : "v"(lo), "v"(hi)); return r; }
typedef float f32x2 __attribute__((ext_vector_type(2)));
__device__ __forceinline__ f32x2 gelu_pk(f32x2 v) {
    const f32x2 av = __builtin_elementwise_abs(v), d = av * 0.2316418882f + 1.0f;
    f32x2 t; t.x = __builtin_amdgcn_rcpf(d.x); t.y = __builtin_amdgcn_rcpf(d.y);
    f32x2 q = t * 0.5307027145f + (-0.7265760135f); q = q * t + 0.7107068705f; q = q * t + (-0.142248368f); q = q * t + 0.127414796f; q = q * t;
    const f32x2 s = (v * v) * (-0.72134752044f);
    f32x2 e; e.x = __builtin_amdgcn_exp2f(s.x); e.y = __builtin_amdgcn_exp2f(s.y);
    const f32x2 m = v * (q * e), r = v - m;
    f32x2 o; o.x = v.x < 0.f ? m.x : r.x; o.y = v.y < 0.f ? m.y : r.y; return o;
}

template <int ACT  > struct EpiBf16 {
    static constexpr bool PERM = true, AFTER_DRAIN = false; static_assert(ACT == 0 || ACT == 1, "EpiBf16: ACT is 0 (none) or 1 (gelu_pk)");
    bf16_t* O; int ldc; const float* bias; int split_cols; size_t split_stride; float scale0;
    __device__ __forceinline__ void operator()(const f32x4 (&acc)[2][2][4][2], const Unit& u, int wr, int wc, int fr, int fq) const {
        const int row0 = u.pm * BM + wr * 64 + fr; int colt = u.pn * BM; bf16_t* base = O;
        float sc = 1.f; if (split_cols) { const int t = colt / split_cols; base += (size_t)t * split_stride; colt -= t * split_cols; if (t == 0) sc = scale0; }
        const int col0 = colt + wc * 32 + 8 * fq, bcol0 = u.pn * BM + wc * 32 + 8 * fq;
        f32x4 bv[2][2];
#pragma unroll
        for (int bj = 0; bj < 2; ++bj)
#pragma unroll
            for (int n = 0; n < 2; ++n) bv[bj][n] = bias ? *(const f32x4*)(bias + bcol0 + bj * HALF + 4 * n) : (f32x4){0.f, 0.f, 0.f, 0.f};
#pragma unroll
        for (int ai = 0; ai < 2; ++ai)
#pragma unroll
            for (int m = 0; m < 4; ++m) { bf16_t* rowp = base + (size_t)(row0 + ai * HALF + m * 16) * ldc + col0;
#pragma unroll
                for (int bj = 0; bj < 2; ++bj) { f32x4 v0 = acc[ai][bj][m][0] + bv[bj][0], v1 = acc[ai][bj][m][1] + bv[bj][1];
                    if (ACT == 1) { f32x2 a = gelu_pk((f32x2){v0[0], v0[1]}), b = gelu_pk((f32x2){v0[2], v0[3]}), c = gelu_pk((f32x2){v1[0], v1[1]}), d = gelu_pk((f32x2){v1[2], v1[3]});
                        v0 = (f32x4){a.x, a.y, b.x, b.y}; v1 = (f32x4){c.x, c.y, d.x, d.y}; }
                    v0 = v0 * sc; v1 = v1 * sc; u32x4 w; w.x = cvt_pk_bf16(v0[0], v0[1]); w.y = cvt_pk_bf16(v0[2], v0[3]); w.z = cvt_pk_bf16(v1[0], v1[1]); w.w = cvt_pk_bf16(v1[2], v1[3]);
                    *(u32x4*)(rowp + bj * HALF) = w; } }
    }
};
template <class Epi, class Sched, bool ALIGN_EPI = false, bool SP2 = false>
__device__ __forceinline__ void gemm_phase(PG8_LAS unsigned char* lds, const Gemm g, const Sched& S, const Epi& E) {
    const int tid = threadIdx.x, wid = __builtin_amdgcn_readfirstlane(tid >> 6), lane = tid & 63, wr = wid >> 2, wc = wid & 3, fr = lane & 15, fq = lane >> 4;
    const int K = g.K, nt = K / BK;
    unsigned voffA[2], voffB[2]; int rowA[2], colA2[2];
#pragma unroll
    for (int i = 0; i < 2; ++i) { int R, C; stage_rc(tid * 16 + i * 8192, R, C); const int Rb = Epi::PERM ? ((R & ~31) + perm32(R & 31)) : R;
        voffA[i] = (unsigned)(R * K + C) * 2u; voffB[i] = (unsigned)(Rb * K + C) * 2u; rowA[i] = R; colA2[i] = C * 2; }
    unsigned voffAc[2][2], voffAn[2][2];
    const size_t kstep = (size_t)(BK * 2);
    const size_t hstep = (size_t)HALF * K * 2;
    const size_t tstep = 2 * hstep;
    const unsigned ldsw = (unsigned)wid * 1024u;
    const int aoff = lds_byte(wr * 64 + fr, fq * 8), boff = lds_byte(wc * 32 + fr, fq * 8);
#define PG8_SA(b, h) (((b) * 2 + (h)) * HTB)
#define PG8_SB(b, h) ((4 + (b) * 2 + (h)) * HTB)
#define PG8_STAGE(bufoff, gbase, voff) do { _Pragma("unroll") for (int _i = 0; _i < 2; ++_i) \
        __builtin_amdgcn_global_load_lds((const unsigned*)((const char*)(gbase) + (voff)[_i]), (PG8_LAS unsigned*)(lds + (bufoff) + ldsw + _i * 8192), 16, 0, 0); } while (0)
#define PG8_STAGE_A(bufoff, gbase, half, usen) do { if constexpr (Sched::GATHER) { _Pragma("unroll") for (int _i = 0; _i < 2; ++_i) { const unsigned _vo = (usen) ? voffAn[half][_i] : voffAc[half][_i]; \
        __builtin_amdgcn_global_load_lds((const unsigned*)((const char*)(gbase) + _vo), (PG8_LAS unsigned*)(lds + (bufoff) + ldsw + _i * 8192), 16, 0, 0); } } \
        else { PG8_STAGE(bufoff, (gbase) + ((half) ? hstep : 0), voffA); } } while (0)
#define PG8_LDA(dst, b, h) do { _Pragma("unroll") for (int m = 0; m < 4; ++m) _Pragma("unroll") for (int k = 0; k < 2; ++k) dst[m][k] = *(const PG8_LAS bf16x8*)(lds + PG8_SA(b, h) + aoff + m * 2048 + k * 1024); } while (0)
#define PG8_LDB(dst, b, h) do { _Pragma("unroll") for (int n = 0; n < 2; ++n) _Pragma("unroll") for (int k = 0; k < 2; ++k) dst[n][k] = *(const PG8_LAS bf16x8*)(lds + PG8_SB(b, h) + boff + n * 2048 + k * 1024); } while (0)
#define PG8_MMA(ai, bj, At, Bt) do { __builtin_amdgcn_s_setprio(1); _Pragma("unroll") for (int m = 0; m < 4; ++m) _Pragma("unroll") for (int n = 0; n < 2; ++n) _Pragma("unroll") for (int k = 0; k < 2; ++k) \
        acc[ai][bj][m][n] = __builtin_amdgcn_mfma_f32_16x16x32_bf16(Bt[n][k], At[m][k], acc[ai][bj][m][n], 0, 0, 0); __builtin_amdgcn_s_setprio(0); } while (0)
#define PG8_WAIT_V(n) asm volatile("s_waitcnt vmcnt(" #n ")" ::: "memory")
#define PG8_WAIT_L(n) asm volatile("s_waitcnt lgkmcnt(" #n ")" ::: "memory")
#define PG8_BAR __builtin_amdgcn_s_barrier()
#define PG8_SCHED __builtin_amdgcn_sched_barrier(0)
    Unit cur, nxt; int ui = 0;
    if (!S.next(0, cur)) return;
    f32x4 acc[2][2][4][2];
#pragma unroll
    for (int a = 0; a < 2; ++a)
#pragma unroll
        for (int b = 0; b < 2; ++b)
#pragma unroll
            for (int m = 0; m < 4; ++m)
#pragma unroll
                for (int n = 0; n < 2; ++n) acc[a][b][m][n] = (f32x4){0.f, 0.f, 0.f, 0.f};
    bf16x8 At[4][2], B0[2][2], B1[2][2];
    const char* cA = (const char*)g.A + (Sched::GATHER ? (size_t)0 : (size_t)cur.pm * tstep); const char* cB = S.b_base(g, cur) + (size_t)cur.pn * tstep;
    if constexpr (Sched::GATHER) { static_assert(!Sched::GATHER || SP2, "gather needs the SP2 loop");
#pragma unroll
        for (int h = 0; h < 2; ++h)
#pragma unroll
            for (int i = 0; i < 2; ++i) voffAc[h][i] = S.a_rowoff(cur, h * HALF + rowA[i]) + (unsigned)colA2[i]; }
    S.a_ready(cur);
    if constexpr (SP2) {
        PG8_STAGE(PG8_SB(0, 0), cB, voffB); PG8_STAGE(PG8_SB(0, 1), cB + hstep, voffB); PG8_STAGE_A(PG8_SA(0, 0), cA, 0, false); PG8_STAGE_A(PG8_SA(0, 1), cA, 1, false);
        if (wr == 1) PG8_BAR;
        PG8_WAIT_V(2); PG8_BAR;
        PG8_STAGE(PG8_SB(1, 0), cB + kstep, voffB); PG8_STAGE_A(PG8_SA(1, 0), cA + kstep, 0, false); PG8_STAGE(PG8_SB(1, 1), cB + hstep + kstep, voffB);
        PG8_WAIT_V(6); PG8_BAR;
    } else {
        PG8_STAGE(PG8_SB(0, 0), cB, voffB); PG8_STAGE(PG8_SA(0, 0), cA, voffA); PG8_STAGE(PG8_SB(0, 1), cB + hstep, voffB); PG8_STAGE(PG8_SA(0, 1), cA + hstep, voffA);
        if (wr == 1) PG8_BAR;
        PG8_WAIT_V(4); PG8_BAR;
        PG8_STAGE(PG8_SB(1, 0), cB + kstep, voffB); PG8_STAGE(PG8_SA(1, 0), cA + kstep, voffA); PG8_STAGE(PG8_SB(1, 1), cB + hstep + kstep, voffB);
        PG8_WAIT_V(6); PG8_BAR;
    }
    for (;;) {
        const bool has_next = S.next(ui + 1, nxt);
        if constexpr (Sched::GATHER) { if (has_next) {
#pragma unroll
            for (int h = 0; h < 2; ++h)
#pragma unroll
                for (int i = 0; i < 2; ++i) voffAn[h][i] = S.a_rowoff(nxt, h * HALF + rowA[i]) + (unsigned)colA2[i]; } }
        const char* nA = has_next ? (const char*)g.A + (Sched::GATHER ? (size_t)0 : (size_t)nxt.pm * tstep) : cA; const char* nB = has_next ? S.b_base(g, nxt) + (size_t)nxt.pn * tstep : cB;
        for (int t = 0; t < nt; t += 2) {
            const bool last = (t == nt - 2);
            const char* a1 = cA + (size_t)(t + 1) * kstep;
            const char* a2 = last ? nA : cA + (size_t)(t + 2) * kstep; const char* b2 = last ? nB : cB + (size_t)(t + 2) * kstep;
            const char* a3 = a2 + kstep; const char* b3 = b2 + kstep;
            if (last && has_next) S.a_ready(nxt);
            if constexpr (SP2) {
            const bool lastn = last && has_next; (void)lastn;
            PG8_LDB(B0, 0, 0); PG8_LDB(B1, 0, 1); PG8_SCHED; PG8_LDA(At, 0, 0); PG8_STAGE_A(PG8_SA(1, 1), a1, 1, false);
            PG8_WAIT_V(8); PG8_WAIT_L(0); PG8_BAR; PG8_MMA(0, 0, At, B0); PG8_MMA(0, 1, At, B1); PG8_BAR; PG8_SCHED;
            PG8_LDA(At, 0, 1); PG8_STAGE(PG8_SB(0, 0), b2, voffB); PG8_STAGE(PG8_SB(0, 1), b2 + hstep, voffB); PG8_STAGE_A(PG8_SA(0, 0), a2, 0, lastn);
            PG8_WAIT_V(8); PG8_WAIT_L(0); PG8_BAR; PG8_MMA(1, 0, At, B0); PG8_MMA(1, 1, At, B1); PG8_BAR; PG8_SCHED;
            PG8_LDB(B0, 1, 0); PG8_LDB(B1, 1, 1); PG8_SCHED; PG8_LDA(At, 1, 0); PG8_STAGE_A(PG8_SA(0, 1), a2, 1, lastn);
            PG8_WAIT_V(8); PG8_WAIT_L(0); PG8_BAR; PG8_MMA(0, 0, At, B0); PG8_MMA(0, 1, At, B1); PG8_BAR; PG8_SCHED;
            PG8_LDA(At, 1, 1); PG8_STAGE(PG8_SB(1, 0), b3, voffB); PG8_STAGE(PG8_SB(1, 1), b3 + hstep, voffB); PG8_STAGE_A(PG8_SA(1, 0), a3, 0, lastn);
            PG8_WAIT_V(8); PG8_WAIT_L(0); PG8_BAR; PG8_MMA(1, 0, At, B0); PG8_MMA(1, 1, At, B1); PG8_BAR; PG8_SCHED;
            } else {
            PG8_LDB(B0, 0, 0); PG8_SCHED; PG8_LDA(At, 0, 0); PG8_STAGE(PG8_SA(1, 1), a1 + hstep, voffA);
            PG8_WAIT_L(8); PG8_BAR; PG8_WAIT_L(0); PG8_MMA(0, 0, At, B0); PG8_BAR; PG8_SCHED;
            PG8_LDB(B1, 0, 1); PG8_STAGE(PG8_SB(0, 0), b2, voffB);
            PG8_BAR; PG8_WAIT_L(0); PG8_MMA(0, 1, At, B1); PG8_BAR;
            PG8_LDA(At, 0, 1); PG8_STAGE(PG8_SA(0, 0), a2, voffA);
            PG8_BAR; PG8_WAIT_L(0); PG8_MMA(1, 0, At, B0); PG8_BAR; PG8_SCHED;
            PG8_STAGE(PG8_SB(0, 1), b2 + hstep, voffB);
            PG8_WAIT_V(6); PG8_BAR; PG8_MMA(1, 1, At, B1); PG8_BAR;
            PG8_LDB(B0, 1, 0); PG8_SCHED; PG8_LDA(At, 1, 0); PG8_STAGE(PG8_SA(0, 1), a2 + hstep, voffA);
            PG8_WAIT_L(8); PG8_BAR; PG8_WAIT_L(0); PG8_MMA(0, 0, At, B0); PG8_BAR; PG8_SCHED;
            PG8_LDB(B1, 1, 1); PG8_STAGE(PG8_SB(1, 0), b3, voffB);
            PG8_BAR; PG8_WAIT_L(0); PG8_MMA(0, 1, At, B1); PG8_BAR;
            PG8_LDA(At, 1, 1); PG8_STAGE(PG8_SA(1, 0), a3, voffA);
            PG8_BAR; PG8_WAIT_L(0); PG8_MMA(1, 0, At, B0); PG8_BAR; PG8_SCHED;
            PG8_STAGE(PG8_SB(1, 1), b3 + hstep, voffB);
            PG8_WAIT_V(6); PG8_BAR; PG8_MMA(1, 1, At, B1); PG8_BAR;
            }
        }
        if constexpr (ALIGN_EPI) { if (wr == 0) PG8_BAR; }
        if constexpr (!Epi::AFTER_DRAIN) { E(acc, cur, wr, wc, fr, fq); S.done(cur); }
        if (!has_next) break;
#pragma unroll
        for (int a = 0; a < 2; ++a)
#pragma unroll
            for (int b = 0; b < 2; ++b)
#pragma unroll
                for (int m = 0; m < 4; ++m)
#pragma unroll
                    for (int n = 0; n < 2; ++n) acc[a][b][m][n] = (f32x4){0.f, 0.f, 0.f, 0.f};
        cur = nxt; cA = nA; cB = nB; ++ui;
        if constexpr (Sched::GATHER) {
#pragma unroll
            for (int h = 0; h < 2; ++h)
#pragma unroll
                for (int i = 0; i < 2; ++i) voffAc[h][i] = voffAn[h][i]; }
        if constexpr (ALIGN_EPI) { if (wr == 1) PG8_BAR; }
    }
    PG8_WAIT_V(0);
    if constexpr (!ALIGN_EPI) { if (wr == 0) PG8_BAR; }
    PG8_BAR;
    if constexpr (Epi::AFTER_DRAIN) { E.fused(acc, cur, wr, wc, fr, fq, lds, wid, lane); S.done(cur); }
#undef PG8_SA
#undef PG8_SB
#undef PG8_STAGE
#undef PG8_STAGE_A
#undef PG8_LDA
#undef PG8_LDB
#undef PG8_MMA
#undef PG8_WAIT_V
#undef PG8_WAIT_L
#undef PG8_BAR
#undef PG8_SCHED
}
}

namespace pg8 {
template <bool GA> struct MoeOrder {
    static constexpr bool GATHER = GA;
    int nM, nN, nwg, G, c; const PG8_LAS int* tb; size_t es_bytes; const int* LIST; unsigned rowbytes;
    __device__ void init(int nN_, int G_, int c_, const PG8_LAS int* tb_, size_t es, const int* list_, unsigned rowbytes_) { tb = tb_; nM = tb_[32] / 256; nN = nN_; nwg = nM * nN; G = G_; c = c_; es_bytes = es; LIST = list_; rowbytes = rowbytes_; }
    __device__ bool next(int i, Unit& u) const {
        const long L = (long)i * G + c; if (L >= nwg) return false;
        int wgid = (int)L; { const int q = nwg / NXCD, r = nwg % NXCD, xcd = wgid % NXCD, off = wgid / NXCD; wgid = (xcd < r ? xcd * (q + 1) : r * (q + 1) + (xcd - r) * q) + off; }
        const int nig = WGM * nN, gid = wgid / nig, fm = gid * WGM, gsz = (nM - fm) < WGM ? (nM - fm) : WGM;
        u.pm = fm + ((wgid % nig) % gsz); u.pn = (wgid % nig) / gsz; return true;
    }
    __device__ __forceinline__ void a_ready(const Unit&) const {}
    __device__ __forceinline__ void done(const Unit&) const {}
    __device__ __forceinline__ const char* b_base(const Gemm& g, const Unit& u) const { return (const char*)g.Bt + (size_t)tb[128 + u.pm] * es_bytes; }
    __device__ __forceinline__ unsigned a_rowoff(const Unit& u, int rloc) const {
        const int e = tb[128 + u.pm], pos = u.pm * 256 + rloc - tb[e];
        const bool ok = pos < tb[64 + e]; const int tok = LIST[(size_t)e * 65536 + (ok ? pos : 0)] >> 1;
        return (unsigned)(ok ? tok : 0) * rowbytes;
    }
};
struct EpiProj {
    static constexpr bool PERM = true, AFTER_DRAIN = false;
    bf16_t* PROJ; bf16_t* HALO; const float* RSN;
    __device__ __forceinline__ void operator()(const f32x4 (&acc)[2][2][4][2], const Unit& u, int wr, int wc, int fr, int fq) const {
        const int row0 = u.pm * BM + wr * 64 + fr, col0 = u.pn * BM + wc * 32 + 8 * fq;
        float rsv[2][4];
#pragma unroll
        for (int ai = 0; ai < 2; ++ai)
#pragma unroll
            for (int m = 0; m < 4; ++m) rsv[ai][m] = RSN[row0 + ai * HALF + m * 16];
        __builtin_amdgcn_sched_barrier(0);
#pragma unroll
        for (int ai = 0; ai < 2; ++ai)
#pragma unroll
            for (int m = 0; m < 4; ++m) { const int row = row0 + ai * HALF + m * 16; bf16_t* rowp = PROJ + (size_t)row * 4352 + col0; const float rs = rsv[ai][m];
#pragma unroll
                for (int bj = 0; bj < 2; ++bj) { const f32x4 v0 = acc[ai][bj][m][0] * rs, v1 = acc[ai][bj][m][1] * rs; const int col = col0 + bj * HALF;
                    u32x4 w; w.x = cvt_pk_bf16(v0[0], v0[1]); w.y = cvt_pk_bf16(v0[2], v0[3]); w.z = cvt_pk_bf16(v1[0], v1[1]); w.w = cvt_pk_bf16(v1[2], v1[3]);
                    *(u32x4*)(rowp + bj * HALF) = w;
                    if (col >= 384 && col < 1280 && (row & 127) >= 125 && ((row >> 7) & 127) != 127)
                        *(u32x4*)(HALO + ((size_t)((row >> 7) + 1) * 3 + ((row & 127) - 125)) * 896 + (col - 384)) = w; } }
    }
};
template <bool BASE_F32, bool WITH_SSQ> struct EpiResB {
    static constexpr bool PERM = true, AFTER_DRAIN = false;
    const void* base; bf16_t* XB; float* SSQ;
    __device__ __forceinline__ void operator()(const f32x4 (&acc)[2][2][4][2], const Unit& u, int wr, int wc, int fr, int fq) const {
        const int row0 = u.pm * BM + wr * 64 + fr, col0 = u.pn * BM + wc * 32 + 8 * fq;
        static_assert(!BASE_F32, "EpiResB: bf16 base only (the base pieces of a row half are preloaded)");
#pragma unroll
        for (int ai = 0; ai < 2; ++ai) {
            u32x4 bw[4][2];
#pragma unroll
            for (int m = 0; m < 4; ++m)
#pragma unroll
                for (int bj = 0; bj < 2; ++bj) bw[m][bj] = *(const u32x4*)((const bf16_t*)base + (size_t)(row0 + ai * HALF + m * 16) * 1024 + col0 + bj * HALF);
            __builtin_amdgcn_sched_barrier(0);
#pragma unroll
            for (int m = 0; m < 4; ++m) { const int row = row0 + ai * HALF + m * 16; const size_t off = (size_t)row * 1024 + col0; float ss = 0.f;
#pragma unroll
                for (int bj = 0; bj < 2; ++bj) {
                    f32x4 x0, x1;
                    { const u32x4 w = bw[m][bj];
                        x0 = (f32x4){__uint_as_float(w.x << 16), __uint_as_float(w.x & 0xffff0000u), __uint_as_float(w.y << 16), __uint_as_float(w.y & 0xffff0000u)};
                        x1 = (f32x4){__uint_as_float(w.z << 16), __uint_as_float(w.z & 0xffff0000u), __uint_as_float(w.w << 16), __uint_as_float(w.w & 0xffff0000u)}; }
                    x0 = x0 + acc[ai][bj][m][0]; x1 = x1 + acc[ai][bj][m][1];
                    u32x4 o; o.x = cvt_pk_bf16(x0[0], x0[1]); o.y = cvt_pk_bf16(x0[2], x0[3]); o.z = cvt_pk_bf16(x1[0], x1[1]); o.w = cvt_pk_bf16(x1[2], x1[3]);
                    *(u32x4*)(XB + off + bj * HALF) = o;
                    ss += ((x0[0] * x0[0] + x0[1] * x0[1]) + (x0[2] * x0[2] + x0[3] * x0[3])) + ((x1[0] * x1[0] + x1[1] * x1[1]) + (x1[2] * x1[2] + x1[3] * x1[3])); }
                if (WITH_SSQ) { ss += __shfl_xor(ss, 16); ss += __shfl_xor(ss, 32); if (fq == 0) SSQ[(size_t)row * 16 + u.pn * 4 + wc] = ss; } }
        }
    }
};
struct EpiBf16RowScale {
    static constexpr bool PERM = true, AFTER_DRAIN = false;
    bf16_t* O; const float* SSQ;
    __device__ __forceinline__ void operator()(const f32x4 (&acc)[2][2][4][2], const Unit& u, int wr, int wc, int fr, int fq) const {
        const int row0 = u.pm * BM + wr * 64 + fr, col0 = u.pn * BM + wc * 32 + 8 * fq;
        f32x4 sq[2][4];
#pragma unroll
        for (int ai = 0; ai < 2; ++ai)
#pragma unroll
            for (int m = 0; m < 4; ++m) sq[ai][m] = *(const f32x4*)(SSQ + (size_t)(row0 + ai * HALF + m * 16) * 16 + 4 * fq);
        __builtin_amdgcn_sched_barrier(0);
#pragma unroll
        for (int ai = 0; ai < 2; ++ai)
#pragma unroll
            for (int m = 0; m < 4; ++m) { const int row = row0 + ai * HALF + m * 16;
                float tot = (sq[ai][m][0] + sq[ai][m][1]) + (sq[ai][m][2] + sq[ai][m][3]); tot += __shfl_xor(tot, 16); tot += __shfl_xor(tot, 32);
                const float rs = rsqrtf(tot * (1.f / 1024.f) + 1e-6f);
                bf16_t* rowp = O + (size_t)row * 1024 + col0;
#pragma unroll
                for (int bj = 0; bj < 2; ++bj) { const f32x4 v0 = acc[ai][bj][m][0] * rs, v1 = acc[ai][bj][m][1] * rs;
                    u32x4 w; w.x = cvt_pk_bf16(v0[0], v0[1]); w.y = cvt_pk_bf16(v0[2], v0[3]); w.z = cvt_pk_bf16(v1[0], v1[1]); w.w = cvt_pk_bf16(v1[2], v1[3]);
                    *(u32x4*)(rowp + bj * HALF) = w; } }
    }
};
struct EpiGateUp {
    static constexpr bool PERM = true, AFTER_DRAIN = false;
    bf16_t* HID; const float* RS; const int* LIST; const PG8_LAS int* tb;
    __device__ __forceinline__ void operator()(const f32x4 (&acc)[2][2][4][2], const Unit& u, int wr, int wc, int fr, int fq) const {
        const int row0 = u.pm * BM + wr * 64 + fr, hc0 = u.pn * 128 + wc * 16 + 4 * fq;
        const int e = tb[128 + u.pm], sp = tb[e], cn = tb[64 + e];
        float rsv[2][4];
#pragma unroll
        for (int ai = 0; ai < 2; ++ai)
#pragma unroll
            for (int m = 0; m < 4; ++m) { const int pos = row0 + ai * HALF + m * 16 - sp; const int tok = LIST[(size_t)e * 65536 + (pos < cn ? pos : 0)] >> 1; rsv[ai][m] = RS[tok]; }
        __builtin_amdgcn_sched_barrier(0);
#pragma unroll
        for (int ai = 0; ai < 2; ++ai)
#pragma unroll
            for (int m = 0; m < 4; ++m) { bf16_t* rowp = HID + (size_t)(row0 + ai * HALF + m * 16) * 512 + hc0; const float rs = rsv[ai][m];
#pragma unroll
                for (int bj = 0; bj < 2; ++bj) { const f32x4 g = acc[ai][bj][m][0] * rs, up = acc[ai][bj][m][1] * rs; float h[4];
#pragma unroll
                    for (int i = 0; i < 4; ++i) h[i] = g[i] * __builtin_amdgcn_rcpf(1.f + __expf(-g[i])) * up[i];
                    typedef unsigned u32x2 __attribute__((ext_vector_type(2)));
                    u32x2 w; w.x = cvt_pk_bf16(h[0], h[1]); w.y = cvt_pk_bf16(h[2], h[3]);
                    *(u32x2*)(rowp + bj * 64) = w; } }
    }
};
struct EpiDown {
    static constexpr bool PERM = true, AFTER_DRAIN = false;
    bf16_t* YB; const float* GATEL; const PG8_LAS int* tb;
    __device__ __forceinline__ void operator()(const f32x4 (&acc)[2][2][4][2], const Unit& u, int wr, int wc, int fr, int fq) const {
        const int row0 = u.pm * BM + wr * 64 + fr, col0 = u.pn * BM + wc * 32 + 8 * fq;
        const int e = tb[128 + u.pm], sp = tb[e], cn = tb[64 + e];
        float gtv[2][4], gvm[2][4];
#pragma unroll
        for (int ai = 0; ai < 2; ++ai)
#pragma unroll
            for (int m = 0; m < 4; ++m) { const int pos = row0 + ai * HALF + m * 16 - sp; gtv[ai][m] = GATEL[(size_t)e * 65536 + (pos < cn ? pos : 0)]; gvm[ai][m] = pos < cn ? 1.f : 0.f; }
        __builtin_amdgcn_sched_barrier(0);
#pragma unroll
        for (int ai = 0; ai < 2; ++ai)
#pragma unroll
            for (int m = 0; m < 4; ++m) { const int row = row0 + ai * HALF + m * 16; const float gt = gtv[ai][m] * gvm[ai][m]; bf16_t* rowp = YB + (size_t)row * 1024 + col0;
#pragma unroll
                for (int bj = 0; bj < 2; ++bj) { const f32x4 v0 = acc[ai][bj][m][0] * gt, v1 = acc[ai][bj][m][1] * gt;
                    u32x4 w; w.x = cvt_pk_bf16(v0[0], v0[1]); w.y = cvt_pk_bf16(v0[2], v0[3]); w.z = cvt_pk_bf16(v1[0], v1[1]); w.w = cvt_pk_bf16(v1[2], v1[3]);
                    *(u32x4*)(rowp + bj * HALF) = w; } }
    }
};
}

#define GAS __attribute__((address_space(1)))
#define LAS __attribute__((address_space(3)))
constexpr int NWAVES = 8, LDS_BYTES = 163840, RING_BYTES = 131072, MISC_OFF = LDS_BYTES - 256;
constexpr int CW_BAR = 4096;
constexpr size_t CTL_ZERO_BYTES = 65536;

#define XB_TMO      128
#define XB_XCNT(j)  (256  + 64 * (j))
#define XB_XSUB(j)  (1280 + 64 * (j))
#define XB_XGEN(j)  (2304 + 64 * (j))
#define XB_TOP      3328
#define XB_TOPGEN   3392
#define XCD_BAR_WORDS 3456
#define XB_SPIN_CAP (1u << 20)
__device__ __forceinline__ unsigned xb_ld(unsigned* p)              { return __hip_atomic_load(p, __ATOMIC_RELAXED, __HIP_MEMORY_SCOPE_AGENT); }
__device__ __forceinline__ unsigned xb_add(unsigned* p, unsigned v) { return __hip_atomic_fetch_add(p, v, __ATOMIC_RELAXED, __HIP_MEMORY_SCOPE_AGENT); }
__device__ __forceinline__ unsigned xb_xcc_id() { return (unsigned)__builtin_amdgcn_s_getreg((3 << 11) | 20) & 0xFu; }
#define XB_SPIN(cond, bar) do { unsigned _sp = 0; while (cond) { __builtin_amdgcn_s_sleep(1); \
    if ((++_sp & 255u) == 0u) { if (xb_ld(&(bar)[XB_TMO])) break; if (_sp > XB_SPIN_CAP) { atomicAdd(&(bar)[XB_TMO], 1u); break; } } } } while (0)
struct XcdBarrier { unsigned* bar; unsigned x; volatile LAS unsigned* st; };
__device__ __forceinline__ XcdBarrier xcd_barrier_post(unsigned* bar, volatile LAS unsigned* st) {
    XcdBarrier b; b.bar = bar; b.x = xb_xcc_id(); b.st = st;
    if (threadIdx.x == 0) (void)xb_add(&bar[XB_XCNT(b.x)], 1u);
    return b;
}
__device__ __forceinline__ void xcd_barrier_complete(unsigned* bar, unsigned x, unsigned& nloc, unsigned& nx) {
    const unsigned G = gridDim.x * gridDim.y * gridDim.z;
    unsigned sum, cnt, mine, sp = 0u;
    for (;;) {
        sum = 0u; cnt = 0u; mine = 0u;
#pragma unroll
        for (unsigned j = 0; j < 16; ++j) { const unsigned c = xb_ld(&bar[XB_XCNT(j)]); sum += c; cnt += (c > 0u) ? 1u : 0u; mine = (j == x) ? c : mine; }
        if (sum == G) break;
        __builtin_amdgcn_s_sleep(1);
        if ((++sp & 255u) == 0u) { if (xb_ld(&bar[XB_TMO])) break; if (sp > XB_SPIN_CAP) { atomicAdd(&bar[XB_TMO], 1u); break; } }
    }
    nloc = mine > 0u ? mine : 1u; nx = cnt > 0u ? cnt : 1u;
}
__device__ __forceinline__ void xcd_barrier(const XcdBarrier& b) {
    asm volatile("s_waitcnt vmcnt(0)" ::: "memory");
    __syncthreads();
    if (threadIdx.x == 0) {
        unsigned* bar = b.bar;
        __builtin_amdgcn_s_waitcnt(0);
        unsigned nloc = b.st[0], nx = b.st[1];
        if (nloc == 0u) { xcd_barrier_complete(bar, b.x, nloc, nx); b.st[0] = nloc; b.st[1] = nx; }
        const unsigned old = xb_add(&bar[XB_XSUB(b.x)], 1u);
        const unsigned gen = old / nloc;
        if (old + 1u == (gen + 1u) * nloc) {
            __builtin_amdgcn_fence(__ATOMIC_RELEASE, "agent");
            asm volatile("s_waitcnt vmcnt(0)" ::: "memory");
            const unsigned og = xb_add(&bar[XB_TOP], 1u);
            const unsigned tg = og / nx;
            if (og + 1u == (tg + 1u) * nx) xb_add(&bar[XB_TOPGEN], 1u);
            else XB_SPIN(xb_ld(&bar[XB_TOPGEN]) == tg, bar);
            __builtin_amdgcn_fence(__ATOMIC_ACQUIRE, "agent");
            xb_add(&bar[XB_XGEN(b.x)], 1u);
            asm volatile("s_waitcnt vmcnt(0)" ::: "memory");
        } else {
            XB_SPIN(xb_ld(&bar[XB_XGEN(b.x)]) == gen, bar);
            __builtin_amdgcn_fence(__ATOMIC_ACQUIRE, "agent");
            asm volatile("s_waitcnt vmcnt(0)" ::: "memory");
        }
    }
    __syncthreads();
}

enum { PH_KVGEMM = 1, PH_L0 = 2, PH_PER_LAYER = 15, PH_FINAL = 32, PH_COUNT = 33 };
enum { LP_NORM1 = 0, LP_GIN = 1, LP_QKN = 2, LP_MIX1 = 3, LP_SCAN = 4, LP_MIX2 = 5, LP_GOUT = 6, LP_NORM2 = 7, LP_GQ = 8, LP_CA = 9, LP_GO = 10, LP_ROUTER = 11, LP_GATHER = 12, LP_GGU = 13, LP_GDOWN = 14 };

struct MkArgs { const float* in[33]; float* out; unsigned char* ws; int ph_lo, ph_hi, bar_region, mask; };
constexpr size_t WS_SSQ = WS_LIST, WS_XB1 = WS_OBR;
constexpr size_t WS_HALO = 30 * MiB;
constexpr size_t WS_ACS = 524 * MiB, WS_DTS = 526 * MiB;
typedef unsigned u32x2_t __attribute__((ext_vector_type(2)));
typedef float f32x2_t __attribute__((ext_vector_type(2)));
typedef unsigned u32x4_t __attribute__((ext_vector_type(4)));
#define LDS_WAIT() asm volatile("s_waitcnt lgkmcnt(0)" ::: "memory")
#define MFMA16(a, b, c) __builtin_amdgcn_mfma_f32_16x16x32_bf16((a), (b), (c), 0, 0, 0)
__device__ __forceinline__ float wave_sum(float v) {
#pragma unroll
    for (int o = 1; o < 64; o <<= 1) v += __shfl_xor(v, o);
    return v;
}
__device__ __forceinline__ unsigned pkbf(float lo, float hi) { unsigned r; asm("v_cvt_pk_bf16_f32 %0, %1, %2" : "=v"(r) : "v"(lo), "v"(hi)); return r; }
__device__ __forceinline__ float bflo(unsigned w) { return __uint_as_float(w << 16); }
__device__ __forceinline__ float bfhi(unsigned w) { return __uint_as_float(w & 0xffff0000u); }
__device__ __forceinline__ float fsilu(float x) { return x * __builtin_amdgcn_rcpf(1.f + __expf(-x)); }
__device__ __forceinline__ float fsigm(float x) { return __builtin_amdgcn_rcpf(1.f + __expf(-x)); }

struct CJob { const float* src; const float* src2; const float* scale; bf16_t* dst; int K, N, ld, mode, nz; size_t src_es, dst_es; };
__device__ __forceinline__ void cvt_item(const CJob& j, LAS float* scr, int item, int lane) {
    const int nblk = j.N / 32, per_e = (j.K / 64) * nblk, e = item / per_e, it = item % per_e, kb = it / nblk, nb = it % nblk, k0 = 64 * kb, n0 = 32 * nb;
    if (j.mode == 1) {
        const int nl = lane & 31, col = n0 + nl + (n0 >= 1280 ? 6 : 0);
        const float* base = j.src;
#pragma unroll 8
        for (int i = 0; i < 32; ++i) { const int kk = 2 * i + (lane >> 5); float v = base[(size_t)(k0 + kk) * j.ld + col]; if (j.scale) v *= j.scale[k0 + kk]; scr[kk * 33 + nl] = v; }
    } else {
        const int c4 = lane & 7, rsub = lane >> 3;
        const float* base; int col, nl;
        if (j.mode == 0) { base = j.src + (size_t)e * j.src_es; col = n0 + 4 * c4; nl = 4 * c4; }
        else { base = (c4 < 4 ? j.src : j.src2) + (size_t)e * j.src_es; col = (n0 >> 1) + 4 * (c4 & 3); nl = 8 * (c4 & 3) + (c4 >= 4 ? 4 : 0); }
        f32x4 v[8];
#pragma unroll
        for (int i = 0; i < 8; ++i) v[i] = *(const f32x4*)(base + (size_t)(k0 + 8 * i + rsub) * j.ld + col);
#pragma unroll
        for (int i = 0; i < 8; ++i) { const int kk = 8 * i + rsub; const float sc = j.scale ? j.scale[k0 + kk] : 1.f; LAS float* d = scr + kk * 33 + nl;
            d[0] = v[i].x * sc; d[1] = v[i].y * sc; d[2] = v[i].z * sc; d[3] = v[i].w * sc; }
    }
    LDS_WAIT(); asm volatile("" ::: "memory");
    const int c = lane & 7;
    bf16_t* d = j.dst + (size_t)e * j.dst_es;
#pragma unroll
    for (int q = 0; q < 4; ++q) { const int n = (lane >> 3) + 8 * q; const LAS float* sp = scr + (8 * c) * 33 + n;
        u32x4_t o; o.x = pkbf(sp[0 * 33], sp[1 * 33]); o.y = pkbf(sp[2 * 33], sp[3 * 33]); o.z = pkbf(sp[4 * 33], sp[5 * 33]); o.w = pkbf(sp[6 * 33], sp[7 * 33]);
        *(u32x4_t*)(d + (size_t)(n0 + n) * j.K + k0 + 8 * c) = o; }
    LDS_WAIT(); asm volatile("" ::: "memory");
}
__device__ __forceinline__ void cvt_job(const CJob& j, LAS unsigned char* lds, int wave, int lane, int gw, int NGW, int& rot) {
    LAS float* scr = (LAS float*)(lds + wave * 16384);
    const int nitems = (j.K / 64) * (j.N / 32) * j.nz;
    int first = gw - (rot % NGW); if (first < 0) first += NGW;
    for (int it = first; it < nitems; it += NGW) cvt_item(j, scr, it, lane);
    rot += nitems;
}
__device__ __forceinline__ void cvt_layer_small(const MkArgs& args, int l, LAS unsigned char* lds, int wave, int lane, int gw, int NGW, int rot = 0) {
    { CJob j{args.in[3] + (size_t)l * DM * NIN, nullptr, args.in[2] + l * DM, (bf16_t*)(args.ws + WS_WIN), DM, NP, NIN, 1, 1, 0, 0}; cvt_job(j, lds, wave, lane, gw, NGW, rot); }
    { CJob j{args.in[17] + (size_t)l * 1536 * DM, nullptr, nullptr, (bf16_t*)(args.ws + WS_WOUT), 1536, DM, DM, 0, 1, 0, 0}; cvt_job(j, lds, wave, lane, gw, NGW, rot); }
    { CJob j{args.in[20] + (size_t)l * DM * DM, nullptr, args.in[18] + l * DM, (bf16_t*)(args.ws + WS_WQ), DM, DM, DM, 0, 1, 0, 0}; cvt_job(j, lds, wave, lane, gw, NGW, rot); }
    { CJob j{args.in[24] + (size_t)l * DM * DM, nullptr, nullptr, (bf16_t*)(args.ws + WS_WO), DM, DM, DM, 0, 1, 0, 0}; cvt_job(j, lds, wave, lane, gw, NGW, rot); }
}
__device__ __forceinline__ void cvt_layer_experts(const MkArgs& args, int l, LAS unsigned char* lds, int wave, int lane, int gw, int NGW) {
    int rot = 0;
    { CJob j{args.in[30] + (size_t)l * 32 * DM * 512, args.in[31] + (size_t)l * 32 * DM * 512, args.in[25] + l * DM, (bf16_t*)(args.ws + WS_WGU), DM, 1024, 512, 2, 32, (size_t)DM * 512, (size_t)1024 * DM}; cvt_job(j, lds, wave, lane, gw, NGW, rot); }
    { CJob j{args.in[32] + (size_t)l * 32 * 512 * DM, nullptr, nullptr, (bf16_t*)(args.ws + WS_WD), 512, DM, DM, 0, 32, (size_t)512 * DM, (size_t)DM * 512}; cvt_job(j, lds, wave, lane, gw, NGW, rot); }
}
__device__ __forceinline__ void ph_pro0(const MkArgs& args, LAS unsigned char* lds, int wave, int lane, int gw, int NGW) {
    int rot = 0;
    for (int l = 0; l < 2; ++l) { CJob j{args.in[21] + (size_t)l * DM * 2048, nullptr, args.in[19] + l * DM, (bf16_t*)(args.ws + WS_WKV) + (size_t)l * 2048 * DM, DM, 2048, 2048, 0, 1, 0, 0}; cvt_job(j, lds, wave, lane, gw, NGW, rot); }
    cvt_layer_small(args, 0, lds, wave, lane, gw, NGW, rot);
    const float* mem = args.in[1]; bf16_t* MEMN = (bf16_t*)(args.ws + WS_MEMN);
    for (int m = gw; m < BATCH * MEML; m += NGW) {
        f32x4 v[4]; float ss = 0.f;
#pragma unroll
        for (int j = 0; j < 4; ++j) { v[j] = *(const f32x4*)(mem + (size_t)m * DM + 4 * lane + 256 * j); ss += v[j].x * v[j].x + v[j].y * v[j].y + v[j].z * v[j].z + v[j].w * v[j].w; }
        const float rs = rsqrtf(wave_sum(ss) * (1.f / DM) + 1e-6f);
#pragma unroll
        for (int j = 0; j < 4; ++j) { u32x2_t o; o.x = pkbf(v[j].x * rs, v[j].y * rs); o.y = pkbf(v[j].z * rs, v[j].w * rs); *(u32x2_t*)(MEMN + (size_t)m * DM + 4 * lane + 256 * j) = o; }
    }
}
__device__ __forceinline__ void ph_knorm(const MkArgs& args, int lane, int gw, int NGW) {
    bf16_t* KV = (bf16_t*)(args.ws + WS_KV); const float* kn = args.in[23];
    for (int s = gw; s < 512 * 8; s += NGW) {
        const int h = s & 3, l = (s >> 2) & 1, m = s >> 3;
        u32x2_t* p = (u32x2_t*)(KV + (size_t)m * 4096 + l * 2048 + h * 256 + 4 * lane);
        const u32x2_t w = *p; const float a = bflo(w.x), b = bfhi(w.x), c = bflo(w.y), d = bfhi(w.y);
        const float rs = rsqrtf(wave_sum(a * a + b * b + c * c + d * d) * (1.f / 256.f) + 1e-6f);
        const f32x4 g = *(const f32x4*)(kn + l * 256 + 4 * lane);
        u32x2_t o; o.x = pkbf(a * rs * g.x, b * rs * g.y); o.y = pkbf(c * rs * g.z, d * rs * g.w); *p = o;
    }
}
template <int l> __device__ __forceinline__ void ph_norm1(const MkArgs& args, const LAS int* tb, LAS unsigned char* lds, int tid, int lane, int gw, int NGW) {
    constexpr int R = (l == 0) ? 4 : 2;
    const float* g = args.in[2] + l * DM; const float* w_in = args.in[3] + (size_t)l * DM * NIN;
    LAS float* wdt = (LAS float*)(lds + 135168);
    for (int k = tid; k < DM; k += NWAVES * 64) { const float gk = g[k];
#pragma unroll
        for (int q = 0; q < 6; ++q) wdt[q * DM + k] = gk * w_in[(size_t)k * NIN + 1280 + q]; }
    __syncthreads();
    bf16_t* Xres = (bf16_t*)args.out; bf16_t* XN = (bf16_t*)(args.ws + WS_XN); const bf16_t* YB = (const bf16_t*)(args.ws + WS_YB);
    const int* TOKDEST = (const int*)(args.ws + WS_TOKDEST); float* DT = (float*)(args.ws + WS_DT);
    float* RSN = (float*)(args.ws + WS_GATEBUF) + 65536;
    int qn[R][2];
#pragma unroll
    for (int r = 0; r < R; ++r) { qn[r][0] = 0; qn[r][1] = 0; if (l != 0 && gw * R < T) { qn[r][0] = TOKDEST[2 * (gw * R + r)]; qn[r][1] = TOKDEST[2 * (gw * R + r) + 1]; } }
    for (int t0 = gw * R; t0 < T; t0 += NGW * R) {
        f32x4 v[R][4];
        if (l == 0) {
#pragma unroll
            for (int r = 0; r < R; ++r)
#pragma unroll
                for (int j = 0; j < 4; ++j) v[r][j] = *(const f32x4*)(args.in[0] + (size_t)(t0 + r) * DM + 4 * lane + 256 * j);
        } else {
            int d0[R], d1[R];
#pragma unroll
            for (int r = 0; r < R; ++r) { const int q0 = qn[r][0], q1 = qn[r][1]; d0[r] = tb[q0 >> 16] + (q0 & 0xffff); d1[r] = tb[q1 >> 16] + (q1 & 0xffff); }
            if (t0 + NGW * R < T) {
#pragma unroll
                for (int r = 0; r < R; ++r) { qn[r][0] = TOKDEST[2 * (t0 + NGW * R + r)]; qn[r][1] = TOKDEST[2 * (t0 + NGW * R + r) + 1]; } }
            u32x2_t y0[R][4], y1[R][4], xb[R][4];
#pragma unroll
            for (int r = 0; r < R; ++r)
#pragma unroll
                for (int j = 0; j < 4; ++j) { xb[r][j] = *(const u32x2_t*)(XN + (size_t)(t0 + r) * DM + 4 * lane + 256 * j);
                    y0[r][j] = *(const u32x2_t*)(YB + (size_t)d0[r] * DM + 4 * lane + 256 * j); y1[r][j] = *(const u32x2_t*)(YB + (size_t)d1[r] * DM + 4 * lane + 256 * j); }
#pragma unroll
            for (int r = 0; r < R; ++r)
#pragma unroll
                for (int j = 0; j < 4; ++j) {
                    v[r][j].x = bflo(xb[r][j].x) + bflo(y0[r][j].x) + bflo(y1[r][j].x); v[r][j].y = bfhi(xb[r][j].x) + bfhi(y0[r][j].x) + bfhi(y1[r][j].x);
                    v[r][j].z = bflo(xb[r][j].y) + bflo(y0[r][j].y) + bflo(y1[r][j].y); v[r][j].w = bfhi(xb[r][j].y) + bfhi(y0[r][j].y) + bfhi(y1[r][j].y);
                }
        }
#pragma unroll
        for (int r = 0; r < R; ++r) {
            float ss = 0.f; float p[6] = {0.f, 0.f, 0.f, 0.f, 0.f, 0.f};
#pragma unroll
            for (int j = 0; j < 4; ++j) {
                u32x2_t o; o.x = pkbf(v[r][j].x, v[r][j].y); o.y = pkbf(v[r][j].z, v[r][j].w);
                *(u32x2_t*)(Xres + (size_t)(t0 + r) * DM + 4 * lane + 256 * j) = o;
                const float a0 = bflo(o.x), a1 = bfhi(o.x), a2 = bflo(o.y), a3 = bfhi(o.y);
                ss += a0 * a0 + a1 * a1 + a2 * a2 + a3 * a3;
#pragma unroll
                for (int q = 0; q < 6; ++q) { const f32x4 w = *(const LAS f32x4*)(wdt + q * DM + 4 * lane + 256 * j); p[q] += a0 * w.x + a1 * w.y + a2 * w.z + a3 * w.w; }
            }
            const float rs = rsqrtf(wave_sum(ss) * (1.f / DM) + 1e-6f);
#pragma unroll
            for (int q = 0; q < 6; ++q) p[q] = wave_sum(p[q]) * rs;
            if (lane == 0) { *(f32x4*)(DT + (size_t)(t0 + r) * 8) = (f32x4){p[0], p[1], p[2], p[3]}; *(float2*)(DT + (size_t)(t0 + r) * 8 + 4) = make_float2(p[4], p[5]); RSN[t0 + r] = rs; }
        }
    }
}
template <int l> __device__ __forceinline__ void ph_router(const MkArgs& args, LAS unsigned char* lds, int tid, int lane, int gw, int NGW) {
    constexpr int RSW = 2064;
    LAS unsigned char* Wh = lds; LAS unsigned char* Wl = lds + 36 * RSW;
    const float* g = args.in[25] + l * DM; const float* wg = args.in[26] + (size_t)l * DM * 4; const float* we = args.in[28] + (size_t)l * DM * 32;
    for (int k = tid; k < DM; k += NWAVES * 64) {
        const float gk = g[k];
        float wv[36];
        { const f32x4 a = *(const f32x4*)(wg + (size_t)k * 4); wv[0] = a.x; wv[1] = a.y; wv[2] = a.z; wv[3] = a.w; }
#pragma unroll
        for (int q = 0; q < 8; ++q) { const f32x4 e4 = *(const f32x4*)(we + (size_t)k * 32 + 4 * q); wv[4 + 4 * q] = e4.x; wv[5 + 4 * q] = e4.y; wv[6 + 4 * q] = e4.z; wv[7 + 4 * q] = e4.w; }
#pragma unroll
        for (int c = 0; c < 36; ++c) { const float v = gk * wv[c]; const bf16_t hi = f2bf(v); *(LAS bf16_t*)(Wh + c * RSW + 2 * k) = hi; *(LAS bf16_t*)(Wl + c * RSW + 2 * k) = f2bf(v - bf2f(hi)); }
    }
    __syncthreads();
    const float* bg = args.in[27] + l * 4; const float* be = args.in[29] + l * 32;
    const bf16_t* X = (const bf16_t*)(args.ws + WS_XN); float* RSb = (float*)(args.ws + WS_GATEBUF);
    int* CNT = (int*)(args.ws + WS_CTL) + l * CW_LAYER + CW_CNT; int* LIST = (int*)(args.ws + WS_LIST); float* GATEL = (float*)(args.ws + WS_GATEL); int* TOKPOS = (int*)(args.ws + WS_TOKDEST);
    const int qi = lane & 15, kq = lane >> 4;
    float biasv[3][4];
#pragma unroll
    for (int nt = 0; nt < 3; ++nt)
#pragma unroll
        for (int r = 0; r < 4; ++r) { const int n = 16 * nt + 4 * kq + r; biasv[nt][r] = n < 4 ? bg[n] : (n < 36 ? be[n - 4] : 0.f); }
    int wrow[3];
#pragma unroll
    for (int nt = 0; nt < 3; ++nt) { const int n = 16 * nt + qi; wrow[nt] = (n < 36 ? n : 35) * RSW + 16 * kq; }
    LAS int* lcnt = (LAS int*)(lds + 2 * 36 * RSW); LAS int* lbase = lcnt + 32;
    if (tid < 32) lcnt[tid] = 0;
    __syncthreads();
    for (int tile0 = 0; tile0 < T / 16; tile0 += NGW) {
        const int tile = tile0 + gw; const bool valid = tile < T / 16;
        const size_t t0 = (size_t)(valid ? tile : 0) * 16;
        const bf16_t* xr = X + (t0 + qi) * DM + 8 * kq;
        f32x4 acc[3]; acc[0] = (f32x4){0.f, 0.f, 0.f, 0.f}; acc[1] = acc[0]; acc[2] = acc[0];
        float ss = 0.f;
        u32x4_t xwv[32];
#pragma unroll
        for (int ks = 0; ks < 32; ++ks) xwv[ks] = *(const u32x4_t*)(xr + 32 * ks);
#pragma unroll
        for (int ks = 0; ks < 32; ++ks) {
            const u32x4_t xw = xwv[ks];
            { const float a0 = bflo(xw.x), a1 = bfhi(xw.x), a2 = bflo(xw.y), a3 = bfhi(xw.y), a4 = bflo(xw.z), a5 = bfhi(xw.z), a6 = bflo(xw.w), a7 = bfhi(xw.w);
              ss += a0 * a0 + a1 * a1 + a2 * a2 + a3 * a3 + a4 * a4 + a5 * a5 + a6 * a6 + a7 * a7; }
            const bf16x8 bh = __builtin_bit_cast(bf16x8, xw);
#pragma unroll
            for (int nt = 0; nt < 3; ++nt) {
                const bf16x8 wh = *(const LAS bf16x8*)(Wh + wrow[nt] + 64 * ks), wl = *(const LAS bf16x8*)(Wl + wrow[nt] + 64 * ks);
                acc[nt] = MFMA16(wh, bh, acc[nt]); acc[nt] = MFMA16(wl, bh, acc[nt]);
            }
        }
        ss += __shfl_xor(ss, 16); ss += __shfl_xor(ss, 32);
        const float rs = rsqrtf(ss * (1.f / DM) + 1e-6f);
#pragma unroll
        for (int nt = 0; nt < 3; ++nt)
#pragma unroll
            for (int r = 0; r < 4; ++r) acc[nt][r] = acc[nt][r] * rs + biasv[nt][r];
        float lgp[4];
#pragma unroll
        for (int r = 0; r < 4; ++r) lgp[r] = __shfl(acc[0][r], qi);
        int gi = 0; float gmx = lgp[0];
#pragma unroll
        for (int i = 1; i < 4; ++i) if (lgp[i] > gmx) { gmx = lgp[i]; gi = i; }
        float den = 0.f;
#pragma unroll
        for (int i = 0; i < 4; ++i) den += __expf(lgp[i] - gmx);
        const float gp = 1.f / den;
        const int cA = 1 + 2 * gi, cB = 2 + 2 * gi, srcA = qi + 16 * (cA & 3), srcB = qi + 16 * (cB & 3), tA = cA >> 2, tB = cB >> 2;
        float le[8];
#pragma unroll
        for (int r = 0; r < 4; ++r) {
            const float a0 = __shfl(acc[0][r], srcA), a1 = __shfl(acc[1][r], srcA);
            le[r] = tA == 0 ? a0 : a1;
            const float b0 = __shfl(acc[0][r], srcB), b1 = __shfl(acc[1][r], srcB), b2 = __shfl(acc[2][r], srcB);
            le[4 + r] = tB == 0 ? b0 : (tB == 1 ? b1 : b2);
        }
        int i1 = 0; float m1 = le[0];
#pragma unroll
        for (int i = 1; i < 8; ++i) if (le[i] > m1) { m1 = le[i]; i1 = i; }
        int i2 = -1; float m2 = -INFINITY;
#pragma unroll
        for (int i = 0; i < 8; ++i) if (i != i1 && le[i] > m2) { m2 = le[i]; i2 = i; }
        if (i2 < 0) i2 = i1 == 0 ? 1 : 0;
        const float rr = __expf(m2 - m1);
        const int e1 = gi * 8 + i1, e2 = gi * 8 + i2, tk = (int)(t0 + qi);
        int r1 = 0, r2 = 0;
        if (kq == 0 && valid) { r1 = atomicAdd((int*)&lcnt[e1], 1); r2 = atomicAdd((int*)&lcnt[e2], 1); }
        __syncthreads();
        if (tid < 32) { const int c = lcnt[tid]; lbase[tid] = c ? atomicAdd(&CNT[tid * CW_CNT_STRIDE], c) : 0; lcnt[tid] = 0; }
        __syncthreads();
        if (kq == 0 && valid) {
            const int p1 = lbase[e1] + r1, p2 = lbase[e2] + r2;
            LIST[(size_t)e1 * LISTCAP + p1] = tk * 2; GATEL[(size_t)e1 * LISTCAP + p1] = gp / (1.f + rr);
            LIST[(size_t)e2 * LISTCAP + p2] = tk * 2 + 1; GATEL[(size_t)e2 * LISTCAP + p2] = gp * rr / (1.f + rr);
            TOKPOS[tk * 2] = (e1 << 16) | p1; TOKPOS[tk * 2 + 1] = (e2 << 16) | p2;
        }
        if (!valid) continue;
        if (kq == 0) RSb[t0 + qi] = rs;
    }
}
constexpr int MOE_TB_OFF = RING_BYTES;
__device__ __forceinline__ LAS int* moe_tables(const MkArgs& args, int l, LAS unsigned char* lds, int tid) {
    LAS int* tb = (LAS int*)(lds + MOE_TB_OFF);
    const int* CTLl = (const int*)(args.ws + WS_CTL) + l * CW_LAYER;
    __syncthreads();
    if (tid < 64) {
        const int cnt = tid < 32 ? CTLl[CW_CNT + tid * CW_CNT_STRIDE] : 0, nt = (cnt + 255) / 256;
        int incl = nt;
#pragma unroll
        for (int d = 1; d < 32; d <<= 1) { const int v = __shfl_up(incl, d); if (tid >= d) incl += v; }
        const int first = incl - nt;
        if (tid < 32) { tb[64 + tid] = cnt; tb[tid] = first * 256; for (int t = 0; t < nt; ++t) tb[128 + first + t] = tid; }
        if (tid == 31) tb[32] = incl * 256;
    }
    __syncthreads();
    return tb;
}
__device__ __forceinline__ void ph_final(const MkArgs& args, const LAS int* tb, int lane, int gw, int NGW) {
    float* OUT = args.out; const bf16_t* X2 = (const bf16_t*)(args.ws + WS_XN); const bf16_t* YB = (const bf16_t*)(args.ws + WS_YB); const int* TOKDEST = (const int*)(args.ws + WS_TOKDEST);
    int qn[2][2] = {{0, 0}, {0, 0}};
    if (gw * 2 < T) {
#pragma unroll
        for (int r = 0; r < 2; ++r) { qn[r][0] = TOKDEST[2 * (gw * 2 + r)]; qn[r][1] = TOKDEST[2 * (gw * 2 + r) + 1]; } }
    for (int t0 = gw * 2; t0 < T; t0 += NGW * 2) {
        int d0[2], d1[2];
#pragma unroll
        for (int r = 0; r < 2; ++r) { const int q0 = qn[r][0], q1 = qn[r][1]; d0[r] = tb[q0 >> 16] + (q0 & 0xffff); d1[r] = tb[q1 >> 16] + (q1 & 0xffff); }
        if (t0 + NGW * 2 < T) {
#pragma unroll
            for (int r = 0; r < 2; ++r) { qn[r][0] = TOKDEST[2 * (t0 + NGW * 2 + r)]; qn[r][1] = TOKDEST[2 * (t0 + NGW * 2 + r) + 1]; } }
        u32x2_t xb[2][4], y0[2][4], y1[2][4];
#pragma unroll
        for (int r = 0; r < 2; ++r)
#pragma unroll
            for (int j = 0; j < 4; ++j) { xb[r][j] = *(const u32x2_t*)(X2 + (size_t)(t0 + r) * DM + 4 * lane + 256 * j);
                y0[r][j] = *(const u32x2_t*)(YB + (size_t)d0[r] * DM + 4 * lane + 256 * j); y1[r][j] = *(const u32x2_t*)(YB + (size_t)d1[r] * DM + 4 * lane + 256 * j); }
#pragma unroll
        for (int r = 0; r < 2; ++r)
#pragma unroll
            for (int j = 0; j < 4; ++j) { f32x4 x;
                x.x = bflo(xb[r][j].x) + bflo(y0[r][j].x) + bflo(y1[r][j].x); x.y = bfhi(xb[r][j].x) + bfhi(y0[r][j].x) + bfhi(y1[r][j].x);
                x.z = bflo(xb[r][j].y) + bflo(y0[r][j].y) + bflo(y1[r][j].y); x.w = bfhi(xb[r][j].y) + bfhi(y0[r][j].y) + bfhi(y1[r][j].y);
                *(f32x4*)(OUT + (size_t)(t0 + r) * DM + 4 * lane + 256 * j) = x; }
    }
}
__device__ __forceinline__ void ph_attn_comb(const MkArgs& args, int lane, int gw, int NGW) {
    const bf16_t* OBR = (const bf16_t*)(args.ws + WS_OBR); const float* LSE = (const float*)(args.ws + WS_LSE); bf16_t* CAT = (bf16_t*)(args.ws + WS_CAT);
    constexpr int R = 4;
    for (int t0 = gw * R; t0 < T; t0 += NGW * R) {
        if (lane < 48) {
            const int h = lane >> 3;
            float lv[R][3]; u32x4_t av[R][3];
#pragma unroll
            for (int r = 0; r < R; ++r)
#pragma unroll
                for (int br = 0; br < 3; ++br) { lv[r][br] = LSE[((size_t)br * T + t0 + r) * 6 + h]; av[r][br] = *(const u32x4_t*)(OBR + ((size_t)br * T + t0 + r) * 384 + 8 * lane); }
#pragma unroll
            for (int r = 0; r < R; ++r) {
                const float l0 = lv[r][0], l1 = lv[r][1], l2 = lv[r][2];
                const float mx = fmaxf(l0, fmaxf(l1, l2));
                float w0 = __expf(l0 - mx), w1 = __expf(l1 - mx), w2 = __expf(l2 - mx); const float inv = __builtin_amdgcn_rcpf(w0 + w1 + w2); w0 *= inv; w1 *= inv; w2 *= inv;
                const u32x4_t a = av[r][0], b = av[r][1], c = av[r][2];
                u32x4_t o;
                o.x = pkbf(w0 * bflo(a.x) + w1 * bflo(b.x) + w2 * bflo(c.x), w0 * bfhi(a.x) + w1 * bfhi(b.x) + w2 * bfhi(c.x));
                o.y = pkbf(w0 * bflo(a.y) + w1 * bflo(b.y) + w2 * bflo(c.y), w0 * bfhi(a.y) + w1 * bfhi(b.y) + w2 * bfhi(c.y));
                o.z = pkbf(w0 * bflo(a.z) + w1 * bflo(b.z) + w2 * bflo(c.z), w0 * bfhi(a.z) + w1 * bfhi(b.z) + w2 * bfhi(c.z));
                o.w = pkbf(w0 * bflo(a.w) + w1 * bflo(b.w) + w2 * bflo(c.w), w0 * bfhi(a.w) + w1 * bfhi(b.w) + w2 * bfhi(c.w));
                *(u32x4_t*)(CAT + (size_t)(t0 + r) * 1536 + 768 + 8 * lane) = o;
            }
        }
    }
}
template <int l> __device__ __forceinline__ void ph_cf(const MkArgs& args, LAS unsigned char* lds, int tid, int wave, int lane) {
    const bf16_t* PROJ = (const bf16_t*)(args.ws + WS_PROJ); bf16_t* CAT = (bf16_t*)(args.ws + WS_CAT);
    const float* cw = args.in[13] + l * 31 * 384; const float* cb = args.in[14] + l * 384; const float* lng = args.in[15] + l * 384; const float* lnb = args.in[16] + l * 384;
    const float* scw = args.in[10] + l * 3 * 384;
    LAS float* cwl = (LAS float*)lds;
    LAS bf16_t* gt = (LAS bf16_t*)(lds + 31 * 384 * 4);
    {
        f32x4 cwv[6];
#pragma unroll
        for (int k = 0; k < 6; ++k) { const int i = tid + NWAVES * 64 * k; cwv[k] = (f32x4){0.f, 0.f, 0.f, 0.f}; if (i < 31 * 384 / 4) cwv[k] = ((const f32x4*)cw)[i]; }
#pragma unroll
        for (int k = 0; k < 6; ++k) { const int i = tid + NWAVES * 64 * k; if (i < 31 * 384 / 4) ((LAS f32x4*)cwl)[i] = cwv[k]; }
    }
    float cbv[6], lgv[6], lbv[6];
#pragma unroll
    for (int i = 0; i < 6; ++i) { cbv[i] = cb[lane + 64 * i]; lgv[i] = lng[lane + 64 * i]; lbv[i] = lnb[lane + 64 * i]; }
    for (int u = blockIdx.x; u < T / 64; u += gridDim.x) {
        const int b = u / (SEQ / 64), t0 = (u % (SEQ / 64)) * 64;
        __syncthreads();
#pragma unroll 1
        for (int hb = 0; hb < 9; hb += 3) {
            u32x4_t av[3], gv[3];
#pragma unroll
            for (int i = 0; i < 3; ++i) { const int idx = tid + NWAVES * 64 * (hb + i), rr = idx / 48, cg = idx % 48, tq = t0 - 30 + rr;
                av[i] = (u32x4_t){0u, 0u, 0u, 0u}; gv[i] = av[i];
                if (idx < 94 * 48 && tq >= 0) { const bf16_t* pr = PROJ + (size_t)(b * SEQ + tq) * NP; av[i] = *(const u32x4_t*)(pr + PC_CFA + 8 * cg); gv[i] = *(const u32x4_t*)(pr + PC_CFG + 8 * cg); } }
#pragma unroll
            for (int i = 0; i < 3; ++i) { const int idx = tid + NWAVES * 64 * (hb + i), rr = idx / 48, cg = idx % 48;
                if (idx < 94 * 48) { const u32x4_t a = av[i], gg = gv[i]; u32x4_t o;
                    o.x = pkbf(bflo(a.x) * fsigm(bflo(gg.x)), bfhi(a.x) * fsigm(bfhi(gg.x))); o.y = pkbf(bflo(a.y) * fsigm(bflo(gg.y)), bfhi(a.y) * fsigm(bfhi(gg.y)));
                    o.z = pkbf(bflo(a.z) * fsigm(bflo(gg.z)), bfhi(a.z) * fsigm(bfhi(gg.z))); o.w = pkbf(bflo(a.w) * fsigm(bflo(gg.w)), bfhi(a.w) * fsigm(bfhi(gg.w)));
                    *(LAS u32x4_t*)(gt + rr * 384 + 8 * cg) = o; } }
        }
        __syncthreads();
        float uo[8][6];
#pragma unroll
        for (int tt = 0; tt < 8; ++tt)
#pragma unroll
            for (int j = 0; j < 6; ++j) uo[tt][j] = 0.f;
#pragma unroll 1
        for (int i = 0; i < 6; ++i) {
            const int c = lane + 64 * i;
            float gwv[38], u8[8];
#pragma unroll
            for (int r = 0; r < 38; ++r) gwv[r] = bf2f(gt[(wave * 8 + r) * 384 + c]);
#pragma unroll
            for (int tt = 0; tt < 8; ++tt) u8[tt] = 0.f;
#pragma unroll
            for (int k = 0; k < 31; ++k) { const float wk = cwl[k * 384 + c];
#pragma unroll
                for (int tt = 0; tt < 8; ++tt) u8[tt] += wk * gwv[tt + k]; }
#pragma unroll
            for (int tt = 0; tt < 8; ++tt)
#pragma unroll
                for (int j = 0; j < 6; ++j) uo[tt][j] = (i == j) ? u8[tt] + cbv[j] : uo[tt][j];
        }
#pragma unroll
        for (int tt = 0; tt < 8; ++tt) {
            float s1 = 0.f;
#pragma unroll
            for (int i = 0; i < 6; ++i) s1 += uo[tt][i];
            const float mean = wave_sum(s1) * (1.f / 384.f);
            float q = 0.f;
#pragma unroll
            for (int i = 0; i < 6; ++i) { const float d = uo[tt][i] - mean; q += d * d; }
            const float rstd = rsqrtf(wave_sum(q) * (1.f / 384.f) + 1e-5f);
            bf16_t* orow = CAT + (size_t)(b * SEQ + t0 + wave * 8 + tt) * 1536 + 1152;
#pragma unroll
            for (int i = 0; i < 6; ++i) orow[lane + 64 * i] = f2bf(fsilu((uo[tt][i] - mean) * rstd * lgv[i] + lbv[i]));
        }
        if (lane < 48) {
            float wk[3][8];
#pragma unroll
            for (int i = 0; i < 8; ++i) { wk[0][i] = scw[0 * 384 + 8 * lane + i]; wk[1][i] = scw[1 * 384 + 8 * lane + i]; wk[2][i] = scw[2 * 384 + 8 * lane + i]; }
            const int tp0 = t0 + wave * 8; const size_t rowb = (size_t)b * SEQ + tp0;
#pragma unroll 1
            for (int hf = 0; hf < 2; ++hf) {
                const size_t rb = rowb + 4 * hf; const int tp = tp0 + 4 * hf;
                u32x4_t c4[6], h4[6], b4[4];
#pragma unroll
                for (int r = 0; r < 6; ++r) { c4[r] = (u32x4_t){0u, 0u, 0u, 0u}; h4[r] = c4[r];
                    if (tp - 2 + r >= 0) { const bf16_t* pr = PROJ + (rb - 2 + r) * NP; c4[r] = *(const u32x4_t*)(pr + PC_SCC + 8 * lane); h4[r] = *(const u32x4_t*)(pr + PC_SCH + 8 * lane); } }
#pragma unroll
                for (int tt = 0; tt < 4; ++tt) b4[tt] = *(const u32x4_t*)(PROJ + (rb + tt) * NP + PC_SCB + 8 * lane);
                float pr_[6][8];
#pragma unroll
                for (int r = 0; r < 6; ++r) { pr_[r][0] = bflo(c4[r].x) * bflo(h4[r].x); pr_[r][1] = bfhi(c4[r].x) * bfhi(h4[r].x); pr_[r][2] = bflo(c4[r].y) * bflo(h4[r].y); pr_[r][3] = bfhi(c4[r].y) * bfhi(h4[r].y);
                    pr_[r][4] = bflo(c4[r].z) * bflo(h4[r].z); pr_[r][5] = bfhi(c4[r].z) * bfhi(h4[r].z); pr_[r][6] = bflo(c4[r].w) * bflo(h4[r].w); pr_[r][7] = bfhi(c4[r].w) * bfhi(h4[r].w); }
#pragma unroll
                for (int tt = 0; tt < 4; ++tt) {
                    float acc[8];
#pragma unroll
                    for (int i = 0; i < 8; ++i) acc[i] = wk[0][i] * pr_[tt][i] + wk[1][i] * pr_[tt + 1][i] + wk[2][i] * pr_[tt + 2][i];
                    u32x4_t o; o.x = pkbf(bflo(b4[tt].x) * acc[0], bfhi(b4[tt].x) * acc[1]); o.y = pkbf(bflo(b4[tt].y) * acc[2], bfhi(b4[tt].y) * acc[3]);
                    o.z = pkbf(bflo(b4[tt].z) * acc[4], bfhi(b4[tt].z) * acc[5]); o.w = pkbf(bflo(b4[tt].w) * acc[6], bfhi(b4[tt].w) * acc[7]);
                    *(u32x4_t*)(CAT + (rb + tt) * 1536 + 384 + 8 * lane) = o;
                }
            }
        }
    }
    __syncthreads();
}


typedef short v4i16_t __attribute__((ext_vector_type(4)));
__device__ __forceinline__ v4i16_t lds_tr16(LAS const unsigned char* p) { return __builtin_amdgcn_ds_read_tr16_b64_v4i16((LAS v4i16_t*)p); }
template <int l> __device__ __forceinline__ void ph_ca(const MkArgs& args, LAS unsigned char* lds, int tid, int wave, int lane) {
    constexpr int RS = 544;
    const bf16_t* Qb = (const bf16_t*)(args.ws + WS_Q); const bf16_t* KV = (const bf16_t*)(args.ws + WS_KV); bf16_t* Ob = (bf16_t*)(args.ws + WS_O);
    const float* qn = args.in[22] + l * 256;
    const int qi = lane & 15, kq = lane >> 4;
    for (int du = blockIdx.x; du < 512; du += gridDim.x) {
        const int bh = du >> 6, b = bh >> 2, h = bh & 3, qt2 = du & 63;
        u32x4_t rawq[2][8];
#pragma unroll
        for (int qt = 0; qt < 2; ++qt)
#pragma unroll
            for (int ks = 0; ks < 8; ++ks) rawq[qt][ks] = *(const u32x4_t*)(Qb + ((size_t)b * SEQ + (size_t)(qt2 * 2 + qt) * 128 + wave * 16 + qi) * DM + h * 256 + 32 * ks + 8 * kq);
        __syncthreads();
        if (lane < 32) {
#pragma unroll
            for (int i = 0; i < 32; ++i) { const int key = wave * 32 + i;
                __builtin_amdgcn_global_load_lds((const unsigned*)(KV + (size_t)(b * MEML + key) * 4096 + l * 2048 + h * 256 + 8 * lane), (LAS unsigned*)(lds + key * RS), 16, 0, 0); }
        }
        unsigned pP[2][32]; float linv[2];
        {
            bf16x8 qf[2][8];
#pragma unroll
            for (int qt = 0; qt < 2; ++qt) {
                const size_t t0 = (size_t)b * SEQ + (size_t)(qt2 * 2 + qt) * 128 + wave * 16;
                u32x4_t raw[8]; float ss = 0.f;
#pragma unroll
                for (int ks = 0; ks < 8; ++ks) { raw[ks] = rawq[qt][ks];
                    const float a0 = bflo(raw[ks].x), a1 = bfhi(raw[ks].x), a2 = bflo(raw[ks].y), a3 = bfhi(raw[ks].y), a4 = bflo(raw[ks].z), a5 = bfhi(raw[ks].z), a6 = bflo(raw[ks].w), a7 = bfhi(raw[ks].w);
                    ss += a0 * a0 + a1 * a1 + a2 * a2 + a3 * a3 + a4 * a4 + a5 * a5 + a6 * a6 + a7 * a7; }
                ss += __shfl_xor(ss, 16); ss += __shfl_xor(ss, 32);
                const float rs = rsqrtf(ss * (1.f / 256.f) + 1e-6f) * 0.0625f;
#pragma unroll
                for (int ks = 0; ks < 8; ++ks) { const f32x4 g0 = *(const f32x4*)(qn + 32 * ks + 8 * kq), g1 = *(const f32x4*)(qn + 32 * ks + 8 * kq + 4);
                    u32x4_t o; o.x = pkbf(bflo(raw[ks].x) * rs * g0.x, bfhi(raw[ks].x) * rs * g0.y); o.y = pkbf(bflo(raw[ks].y) * rs * g0.z, bfhi(raw[ks].y) * rs * g0.w);
                    o.z = pkbf(bflo(raw[ks].z) * rs * g1.x, bfhi(raw[ks].z) * rs * g1.y); o.w = pkbf(bflo(raw[ks].w) * rs * g1.z, bfhi(raw[ks].w) * rs * g1.w);
                    qf[qt][ks] = __builtin_bit_cast(bf16x8, o); }
            }
            asm volatile("s_waitcnt vmcnt(0)" ::: "memory");
            __syncthreads();
            f32x4 s0[16], s1[16];
#pragma unroll
            for (int kt = 0; kt < 16; ++kt) { s0[kt] = (f32x4){0.f, 0.f, 0.f, 0.f}; s1[kt] = s0[kt];
                bf16x8 ka[8];
#pragma unroll
                for (int ks = 0; ks < 8; ++ks) ka[ks] = *(const LAS bf16x8*)(lds + (16 * kt + qi) * RS + (32 * ks + 8 * kq) * 2);
#pragma unroll
                for (int ks = 0; ks < 8; ++ks) { s0[kt] = MFMA16(ka[ks], qf[0][ks], s0[kt]); s1[kt] = MFMA16(ka[ks], qf[1][ks], s1[kt]); }
                __builtin_amdgcn_sched_group_barrier(0x100, 8, 0); __builtin_amdgcn_sched_group_barrier(0x008, 16, 0); }
#define CA_SOFTMAX(sacc, qt) { f32x2_t t2[16][2];   \
            _Pragma("unroll") for (int kt = 0; kt < 16; ++kt) { t2[kt][0] = (f32x2_t){sacc[kt][0], sacc[kt][1]} * (f32x2_t){1.44269504f, 1.44269504f}; t2[kt][1] = (f32x2_t){sacc[kt][2], sacc[kt][3]} * (f32x2_t){1.44269504f, 1.44269504f}; } \
            float m = t2[0][0].x; \
            _Pragma("unroll") for (int kt = 0; kt < 16; ++kt) m = fmaxf(fmaxf(m, fmaxf(t2[kt][0].x, t2[kt][0].y)), fmaxf(t2[kt][1].x, t2[kt][1].y)); \
            m = fmaxf(m, __shfl_xor(m, 16)); m = fmaxf(m, __shfl_xor(m, 32)); float sum = 0.f; const f32x2_t m2 = (f32x2_t){m, m}; \
            _Pragma("unroll") for (int kt = 0; kt < 16; ++kt) { const f32x2_t e0 = t2[kt][0] - m2, e1 = t2[kt][1] - m2; \
                const float p0 = __builtin_amdgcn_exp2f(e0.x), p1 = __builtin_amdgcn_exp2f(e0.y), p2 = __builtin_amdgcn_exp2f(e1.x), p3 = __builtin_amdgcn_exp2f(e1.y); \
                sum += (p0 + p1) + (p2 + p3); pP[qt][2 * kt] = pkbf(p0, p1); pP[qt][2 * kt + 1] = pkbf(p2, p3); } \
            sum += __shfl_xor(sum, 16); sum += __shfl_xor(sum, 32); linv[qt] = __builtin_amdgcn_rcpf(sum); }
            CA_SOFTMAX(s0, 0)
            CA_SOFTMAX(s1, 1)
#undef CA_SOFTMAX
        }
        __syncthreads();
        if (lane < 32) {
#pragma unroll
            for (int i = 0; i < 32; ++i) { const int key = wave * 32 + i;
                __builtin_amdgcn_global_load_lds((const unsigned*)(KV + (size_t)(b * MEML + key) * 4096 + l * 2048 + 1024 + h * 256 + 8 * lane), (LAS unsigned*)(lds + key * RS), 16, 0, 0); }
        }
        asm volatile("s_waitcnt vmcnt(0)" ::: "memory");
        __syncthreads();
        {
            const size_t t0 = (size_t)b * SEQ + (size_t)(qt2 * 2) * 128 + wave * 16;
            LAS const unsigned char* vb = lds + (4 * kq + (qi >> 2)) * RS + 8 * (qi & 3);
#pragma unroll 4
            for (int dt = 0; dt < 16; ++dt) {
                f32x4 o0 = (f32x4){0.f, 0.f, 0.f, 0.f}, o1 = o0;
                v4i16_t vlo[8], vhi[8];
#pragma unroll
                for (int kk = 0; kk < 8; ++kk) { vlo[kk] = lds_tr16(vb + (32 * kk) * RS + 32 * dt); vhi[kk] = lds_tr16(vb + (32 * kk + 16) * RS + 32 * dt); }
#pragma unroll
                for (int kk = 0; kk < 8; ++kk) {
                    const v4i16_t lo = vlo[kk], hi = vhi[kk];
                    const bf16x8 a = (bf16x8){lo[0], lo[1], lo[2], lo[3], hi[0], hi[1], hi[2], hi[3]};
                    const u32x4_t pb0 = (u32x4_t){pP[0][4 * kk], pP[0][4 * kk + 1], pP[0][4 * kk + 2], pP[0][4 * kk + 3]};
                    const u32x4_t pb1 = (u32x4_t){pP[1][4 * kk], pP[1][4 * kk + 1], pP[1][4 * kk + 2], pP[1][4 * kk + 3]};
                    o0 = MFMA16(a, __builtin_bit_cast(bf16x8, pb0), o0); o1 = MFMA16(a, __builtin_bit_cast(bf16x8, pb1), o1);
                }
                __builtin_amdgcn_sched_group_barrier(0x100, 16, 0); __builtin_amdgcn_sched_group_barrier(0x008, 16, 0);
                u32x2_t w; w.x = pkbf(o0[0] * linv[0], o0[1] * linv[0]); w.y = pkbf(o0[2] * linv[0], o0[3] * linv[0]);
                *(u32x2_t*)(Ob + (t0 + qi) * DM + h * 256 + 16 * dt + 4 * kq) = w;
                w.x = pkbf(o1[0] * linv[1], o1[1] * linv[1]); w.y = pkbf(o1[2] * linv[1], o1[3] * linv[1]);
                *(u32x2_t*)(Ob + (t0 + 128 + qi) * DM + h * 256 + 16 * dt + 4 * kq) = w;
            }
        }
    }
    __syncthreads();
}
template <int l> __device__ __forceinline__ void ph_dattn(const MkArgs& args, LAS unsigned char* lds, int tid, int wave, int lane) {
    constexpr int RS = 144, RSV = 160, KH = 128 * RS, VS = 144 * RSV;
    constexpr int VB0 = 20480, KB0 = VB0 + 3 * VS, DEND = KB0 + 3 * KH;
    static_assert(DEND <= MISC_OFF, "dattn LDS");
    constexpr int NU = 3 * 2 * 6 * 128;
    const bf16_t* PROJ = (const bf16_t*)(args.ws + WS_PROJ); bf16_t* OBR = (bf16_t*)(args.ws + WS_OBR); float* LSE = (float*)(args.ws + WS_LSE);
    const int qi = lane & 15, kq = lane >> 4;
    for (int idx = tid; idx < (DEND - VB0) / 16; idx += NWAVES * 64) ((LAS u32x4_t*)(lds + VB0))[idx] = (u32x4_t){0u, 0u, 0u, 0u};
    __syncthreads();
    const float* qn = args.in[11] + l * 64; const float* kn = args.in[12] + l * 64;
    const f32x4 qg0 = *(const f32x4*)(qn + 8 * kq) * *(const f32x4*)(kn + 8 * kq), qg1 = *(const f32x4*)(qn + 8 * kq + 4) * *(const f32x4*)(kn + 8 * kq + 4),
                qg2 = *(const f32x4*)(qn + 32 + 8 * kq) * *(const f32x4*)(kn + 32 + 8 * kq), qg3 = *(const f32x4*)(qn + 32 + 8 * kq + 4) * *(const f32x4*)(kn + 32 + 8 * kq + 4);
    f32x2_t mb0[2], mb8[2];
#pragma unroll
    for (int r = 0; r < 4; ++r) { mb0[r >> 1][r & 1] = (128 + qi - 4 * kq - r <= 128) ? 0.f : -INFINITY; mb8[r >> 1][r & 1] = (qi - 4 * kq - r >= 0) ? 0.f : -INFINITY; }
    struct DSet { u32x4_t pre[4]; bf16x8 q0, q1; size_t tq; int br, h, i0; };
    DSet sA, sB; sA.tq = 0; sA.br = sA.h = sA.i0 = 0; sB.tq = 0; sB.br = sB.h = sB.i0 = 0;
#define DATTN_DECODE(u_, br_, bb_, h_, dil_, res_, i0_) const int qt_ = (u_) & 127, h_ = ((u_) >> 7) % 6, bb_ = (((u_) >> 7) / 6) & 1, br_ = ((u_) >> 7) / 12; \
        const int dil_ = br_ == 0 ? 1 : (br_ == 1 ? 4 : 16), per_ = SEQ / dil_ / 128, res_ = qt_ / per_, i0_ = (qt_ % per_) * 128;
#define DATTN_LOADH(S_, bb_, h_, dil_, res_, ibase_) do { \
        _Pragma("unroll") for (int j = 0; j < 4; ++j) { const int idx = tid + NWAVES * 64 * (j & 1), jk = idx >> 3, cc = idx & 7, isv = j >> 1; \
            (S_).pre[j] = *(const u32x4_t*)(PROJ + (size_t)((bb_) * SEQ + ((ibase_) + jk) * (dil_) + (res_)) * NP + (isv ? PC_V : PC_K) + (h_) * 64 + 8 * cc); } } while (0)
#define DATTN_LOAD(S_, u_) do { DATTN_DECODE(u_, br, bb, h, dil, res, i0) DATTN_LOADH(S_, bb, h, dil, res, i0); \
        const size_t tq_ = (size_t)bb * SEQ + (size_t)(i0 + wave * 16 + qi) * dil + res; (S_).tq = tq_; (S_).br = br; (S_).h = h; (S_).i0 = i0; \
        (S_).q0 = *(const bf16x8*)(PROJ + tq_ * NP + PC_Q + h * 64 + 8 * kq); (S_).q1 = *(const bf16x8*)(PROJ + tq_ * NP + PC_Q + h * 64 + 32 + 8 * kq); } while (0)
#define DATTN_STAGE(S_, slot_) do { \
        _Pragma("unroll") for (int j = 0; j < 4; ++j) { const int idx = tid + NWAVES * 64 * (j & 1), jk = idx >> 3, cc = idx & 7, isv = j >> 1; \
            u32x4_t v = (S_).pre[j]; \
            if (!isv) { \
                const float a0 = bflo(v.x), a1 = bfhi(v.x), a2 = bflo(v.y), a3 = bfhi(v.y), a4 = bflo(v.z), a5 = bfhi(v.z), a6 = bflo(v.w), a7 = bfhi(v.w); \
                float ss = a0 * a0 + a1 * a1 + a2 * a2 + a3 * a3 + a4 * a4 + a5 * a5 + a6 * a6 + a7 * a7; \
                ss += __shfl_xor(ss, 1); ss += __shfl_xor(ss, 2); ss += __shfl_xor(ss, 4); \
                const float rs = rsqrtf(ss * (1.f / 64.f) + 1e-6f); const f32x2_t r2 = (f32x2_t){rs, rs}; \
                const f32x2_t x0 = (f32x2_t){a0, a1} * r2, x1 = (f32x2_t){a2, a3} * r2, x2 = (f32x2_t){a4, a5} * r2, x3 = (f32x2_t){a6, a7} * r2; \
                v.x = pkbf(x0.x, x0.y); v.y = pkbf(x1.x, x1.y); v.z = pkbf(x2.x, x2.y); v.w = pkbf(x3.x, x3.y); \
            } \
            *(LAS u32x4_t*)(lds + (isv ? VB0 + (slot_) * VS + jk * RSV : KB0 + (slot_) * KH + jk * RS) + 16 * cc) = v; } } while (0)
    const int G_ = (int)gridDim.x;
    const int u_lo = (int)(((long long)blockIdx.x * NU) / G_), u_hi = (int)(((long long)(blockIdx.x + 1) * NU) / G_);
    int slo = 0, shi = 1;
    if (u_lo < u_hi) {
        { DATTN_DECODE(u_lo, br, bb, h, dil, res, i0) (void)br;
          if (i0 > 0) { DATTN_LOADH(sA, bb, h, dil, res, i0 - 128); DATTN_STAGE(sA, 0); } }
        DATTN_LOAD(sA, u_lo); if (u_lo + 1 < u_hi) DATTN_LOAD(sB, u_lo + 1);
    }
    auto unit = [&](DSet& S, const int u) __attribute__((always_inline)) {
        DATTN_STAGE(S, shi);
        bf16x8 cq0, cq1;
        {
            const u32x4_t u0 = __builtin_bit_cast(u32x4_t, S.q0), u1 = __builtin_bit_cast(u32x4_t, S.q1);
            float ss = bflo(u0.x) * bflo(u0.x) + bfhi(u0.x) * bfhi(u0.x) + bflo(u0.y) * bflo(u0.y) + bfhi(u0.y) * bfhi(u0.y) + bflo(u0.z) * bflo(u0.z) + bfhi(u0.z) * bfhi(u0.z) + bflo(u0.w) * bflo(u0.w) + bfhi(u0.w) * bfhi(u0.w)
                     + bflo(u1.x) * bflo(u1.x) + bfhi(u1.x) * bfhi(u1.x) + bflo(u1.y) * bflo(u1.y) + bfhi(u1.y) * bfhi(u1.y) + bflo(u1.z) * bflo(u1.z) + bfhi(u1.z) * bfhi(u1.z) + bflo(u1.w) * bflo(u1.w) + bfhi(u1.w) * bfhi(u1.w);
            ss += __shfl_xor(ss, 16); ss += __shfl_xor(ss, 32);
            const float rs = rsqrtf(ss * (1.f / 64.f) + 1e-6f) * 0.125f;
            u32x4_t o0, o1; const f32x2_t r2 = (f32x2_t){rs, rs};
#define DATTN_QP(w_, g_, hi_) ({ const f32x2_t x_ = (f32x2_t){bflo(w_), bfhi(w_)} * r2 * ((hi_) ? (f32x2_t){(g_).z, (g_).w} : (f32x2_t){(g_).x, (g_).y}); pkbf(x_.x, x_.y); })
            o0.x = DATTN_QP(u0.x, qg0, 0); o0.y = DATTN_QP(u0.y, qg0, 1); o0.z = DATTN_QP(u0.z, qg1, 0); o0.w = DATTN_QP(u0.w, qg1, 1);
            o1.x = DATTN_QP(u1.x, qg2, 0); o1.y = DATTN_QP(u1.y, qg2, 1); o1.z = DATTN_QP(u1.z, qg3, 0); o1.w = DATTN_QP(u1.w, qg3, 1);
#undef DATTN_QP
            cq0 = __builtin_bit_cast(bf16x8, o0); cq1 = __builtin_bit_cast(bf16x8, o1);
        }
        const size_t ctq = S.tq; const int cbr = S.br, ch = S.h, i0 = S.i0;
        __syncthreads();
        if (u + 2 < u_hi) DATTN_LOAD(S, u + 2);
        const int kA = KB0 + slo * KH + (16 * wave + qi) * RS + 16 * kq, kB = KB0 + shi * KH - KH + (16 * wave + qi) * RS + 16 * kq;
        f32x4 s[9];
        {
            bf16x8 ka[9], kb[9];
#pragma unroll
            for (int kt = 0; kt < 9; ++kt) { LAS const unsigned char* kp = lds + (wave + kt < 8 ? kA : kB) + 16 * kt * RS; ka[kt] = *(const LAS bf16x8*)kp; kb[kt] = *(const LAS bf16x8*)(kp + 64); }
#pragma unroll
            for (int kt = 0; kt < 9; ++kt) { s[kt] = MFMA16(ka[kt], cq0, ((f32x4){0.f, 0.f, 0.f, 0.f})); s[kt] = MFMA16(kb[kt], cq1, s[kt]); }
            __builtin_amdgcn_sched_group_barrier(0x100, 18, 0); __builtin_amdgcn_sched_group_barrier(0x008, 18, 0);
        }
        f32x2_t t2[9][2];
#pragma unroll
        for (int kt = 0; kt < 9; ++kt) {
            f32x2_t b0, b1;
            if (kt == 0) { b0 = i0 == 0 ? (f32x2_t){-INFINITY, -INFINITY} : mb0[0]; b1 = i0 == 0 ? (f32x2_t){-INFINITY, -INFINITY} : mb0[1]; }
            else if (kt == 8) { b0 = mb8[0]; b1 = mb8[1]; }
            else { const float tb = (i0 == 0 && wave + kt < 8) ? -INFINITY : 0.f; b0 = (f32x2_t){tb, tb}; b1 = b0; }
            t2[kt][0] = __builtin_elementwise_fma((f32x2_t){s[kt][0], s[kt][1]}, (f32x2_t){1.44269504f, 1.44269504f}, b0);
            t2[kt][1] = __builtin_elementwise_fma((f32x2_t){s[kt][2], s[kt][3]}, (f32x2_t){1.44269504f, 1.44269504f}, b1);
        }
        float m = -INFINITY;
#pragma unroll
        for (int kt = 0; kt < 9; ++kt) m = fmaxf(fmaxf(m, fmaxf(t2[kt][0].x, t2[kt][0].y)), fmaxf(t2[kt][1].x, t2[kt][1].y));
        m = fmaxf(m, __shfl_xor(m, 16)); m = fmaxf(m, __shfl_xor(m, 32));
        float sum = 0.f; unsigned pp[20]; const f32x2_t m2 = (f32x2_t){m, m};
#pragma unroll
        for (int kt = 0; kt < 9; ++kt) { const f32x2_t e0 = t2[kt][0] - m2, e1 = t2[kt][1] - m2;
            const float p0 = __builtin_amdgcn_exp2f(e0.x), p1 = __builtin_amdgcn_exp2f(e0.y), p2 = __builtin_amdgcn_exp2f(e1.x), p3 = __builtin_amdgcn_exp2f(e1.y);
            sum += (p0 + p1) + (p2 + p3); pp[2 * kt] = pkbf(p0, p1); pp[2 * kt + 1] = pkbf(p2, p3); }
        pp[18] = 0u; pp[19] = 0u;
        sum += __shfl_xor(sum, 16); sum += __shfl_xor(sum, 32);
        const float linv = __builtin_amdgcn_rcpf(sum);
        const int vrow = (16 * wave + 4 * kq + (qi >> 2)) * RSV + 8 * (qi & 3);
        const int vA = VB0 + slo * VS + vrow, vB = VB0 + shi * VS - 128 * RSV + vrow;
        bf16_t* orow = OBR + ((size_t)cbr * T + ctq) * 384 + ch * 64;
#pragma unroll
        for (int dp = 0; dp < 2; ++dp) {
            v4i16_t lo[2][5], hi[2][5];
#pragma unroll
            for (int d2 = 0; d2 < 2; ++d2)
#pragma unroll
                for (int kk = 0; kk < 5; ++kk) {
                    lo[d2][kk] = lds_tr16(lds + (wave + 2 * kk < 8 ? vA : vB) + (32 * kk) * RSV + 32 * (2 * dp + d2));
                    hi[d2][kk] = lds_tr16(lds + (wave + 2 * kk + 1 < 8 ? vA : vB) + (32 * kk + 16) * RSV + 32 * (2 * dp + d2)); }
            f32x4 o[2]; o[0] = (f32x4){0.f, 0.f, 0.f, 0.f}; o[1] = o[0];
#pragma unroll
            for (int kk = 0; kk < 5; ++kk) {
                const u32x4_t pb = (u32x4_t){pp[4 * kk], pp[4 * kk + 1], pp[4 * kk + 2], pp[4 * kk + 3]};
#pragma unroll
                for (int d2 = 0; d2 < 2; ++d2) o[d2] = MFMA16(((bf16x8){lo[d2][kk][0], lo[d2][kk][1], lo[d2][kk][2], lo[d2][kk][3], hi[d2][kk][0], hi[d2][kk][1], hi[d2][kk][2], hi[d2][kk][3]}), __builtin_bit_cast(bf16x8, pb), o[d2]);
            }
            __builtin_amdgcn_sched_group_barrier(0x100, 20, 0); __builtin_amdgcn_sched_group_barrier(0x008, 10, 0);
#pragma unroll
            for (int d2 = 0; d2 < 2; ++d2) { u32x2_t w; w.x = pkbf(o[d2][0] * linv, o[d2][1] * linv); w.y = pkbf(o[d2][2] * linv, o[d2][3] * linv);
                *(u32x2_t*)(orow + 16 * (2 * dp + d2) + 4 * kq) = w; }
        }
        if (kq == 0) LSE[((size_t)cbr * T + ctq) * 6 + ch] = (m + __builtin_amdgcn_logf(sum)) * 0.69314718f;
        slo = shi; shi = shi == 2 ? 0 : shi + 1;
    };
    for (int u = u_lo; u < u_hi; u += 2) { unit(sA, u); if (u + 1 < u_hi) unit(sB, u + 1); }
#undef DATTN_DECODE
#undef DATTN_LOADH
#undef DATTN_LOAD
#undef DATTN_STAGE
    __syncthreads();
}
constexpr int SSD_RSX = 400, SSD_RSB = 288;
constexpr int SSD_OFF_ARR = 0;
constexpr int SSD_OFF_X = 9216, SSD_OFF_B = SSD_OFF_X + 128 * SSD_RSX, SSD_OFF_C = SSD_OFF_B + 128 * SSD_RSB;
__device__ __forceinline__ float fsoftplus(float x) { return fmaxf(x, 0.f) + log1pf(__expf(-fabsf(x))); }

template <int l> __device__ __forceinline__ void ph_ssd1(const MkArgs& args, LAS unsigned char* lds, int tid, int wave, int lane) {
    bf16_t* PROJ = (bf16_t*)(args.ws + WS_PROJ); const bf16_t* HALO = (const bf16_t*)(args.ws + WS_HALO);
    const float* DT = (const float*)(args.ws + WS_DT); float* ACS = (float*)(args.ws + WS_ACS); float* DTS = (float*)(args.ws + WS_DTS); bf16_t* STATES = (bf16_t*)(args.ws + WS_YS);
    const float* conv_w = args.in[4] + l * 4 * 896; const float* conv_b = args.in[5] + l * 896;
    const float* dt_bias = args.in[6] + l * 6; const float* a_log = args.in[7] + l * 6;
    LAS float* acs_l = (LAS float*)(lds + SSD_OFF_ARR); LAS float* dt_l = acs_l + 768; LAS float* fac_l = acs_l + 1536;
    const int qi = lane & 15, kq = lane >> 4;
    const float ah_w = wave < 6 ? -__expf(a_log[wave]) : 0.f, bias_w = wave < 6 ? dt_bias[wave] : 0.f;
    for (int u = blockIdx.x; u < 256; u += gridDim.x) {
        const int b = u >> 7, c = u & 127; const size_t row0 = (size_t)b * SEQ + (size_t)c * 128;
        __syncthreads();
        if (wave < 6) {
            const int h = wave; const float ah = ah_w, bias = bias_w;
            const float d0 = fsoftplus(DT[(row0 + 2 * lane) * 8 + h] + bias), d1 = fsoftplus(DT[(row0 + 2 * lane + 1) * 8 + h] + bias);
            const float v0 = d0 * ah, v1 = v0 + d1 * ah;
            float sc = v1;
#pragma unroll
            for (int o = 1; o < 64; o <<= 1) { const float t = __shfl_up(sc, o); if (lane >= o) sc += t; }
            const float ex = sc - v1, a0 = ex + v0, a1 = ex + v1, tot = __shfl(sc, 63);
            acs_l[h * 128 + 2 * lane] = a0; acs_l[h * 128 + 2 * lane + 1] = a1; dt_l[h * 128 + 2 * lane] = d0; dt_l[h * 128 + 2 * lane + 1] = d1;
            fac_l[h * 128 + 2 * lane] = d0 * __expf(tot - a0); fac_l[h * 128 + 2 * lane + 1] = d1 * __expf(tot - a1);
            ACS[(row0 + 2 * lane) * 8 + h] = a0; ACS[(row0 + 2 * lane + 1) * 8 + h] = a1; DTS[(row0 + 2 * lane) * 8 + h] = d0; DTS[(row0 + 2 * lane + 1) * 8 + h] = d1;
        }
#pragma unroll 1
        for (int g = 0; g < 2; ++g) {
            const int cg = tid % 56, seg = tid / 56, l0 = seg * 16;
            const int ci = cg < 24 ? g * 192 + 8 * cg : (cg < 40 ? 384 + g * 128 + 8 * (cg - 24) : 640 + g * 128 + 8 * (cg - 40));
            u32x4_t hr[3];
            if (tid < 448) {
#pragma unroll
                for (int r = 0; r < 3; ++r) { const int ll = l0 - 3 + r;
                    hr[r] = ll >= 0 ? *(const u32x4_t*)(PROJ + (row0 + ll) * NP + PC_XBC + ci) : (c > 0 ? *(const u32x4_t*)(HALO + ((size_t)u * 3 + (ll + 3)) * 896 + ci) : (u32x4_t){0u, 0u, 0u, 0u}); }
            }
            asm volatile("s_waitcnt vmcnt(0)" ::: "memory");
            __syncthreads();
            if (tid < 448) {
                float w[4][8], bs[8];
#pragma unroll
                for (int i = 0; i < 8; ++i) { bs[i] = conv_b[ci + i];
#pragma unroll
                    for (int k = 0; k < 4; ++k) w[k][i] = conv_w[k * 896 + ci + i]; }
                const int hx = g * 3 + (cg >> 3);
                float win[4][8];
#define UNPK(dst, rr) do { dst[0] = bflo(rr.x); dst[1] = bfhi(rr.x); dst[2] = bflo(rr.y); dst[3] = bfhi(rr.y); dst[4] = bflo(rr.z); dst[5] = bfhi(rr.z); dst[6] = bflo(rr.w); dst[7] = bfhi(rr.w); } while (0)
                UNPK(win[0], hr[0]); UNPK(win[1], hr[1]); UNPK(win[2], hr[2]);
                bf16_t* prow = PROJ + (row0 + l0) * NP + PC_XBC + ci;
#pragma unroll 1
                for (int jb = 0; jb < 16; jb += 8) {
                    u32x4_t raw[8];
#pragma unroll
                    for (int j = 0; j < 8; ++j) raw[j] = *(const u32x4_t*)(prow + (size_t)(jb + j) * NP);
#pragma unroll
                    for (int j = 0; j < 8; ++j) {
                        UNPK(win[(j + 3) & 3], raw[j]);
                        float o[8];
#pragma unroll
                        for (int i = 0; i < 8; ++i) o[i] = fsilu(bs[i] + w[0][i] * win[j & 3][i] + w[1][i] * win[(j + 1) & 3][i] + w[2][i] * win[(j + 2) & 3][i] + w[3][i] * win[(j + 3) & 3][i]);
                        u32x4_t pk; pk.x = pkbf(o[0], o[1]); pk.y = pkbf(o[2], o[3]); pk.z = pkbf(o[4], o[5]); pk.w = pkbf(o[6], o[7]);
                        *(u32x4_t*)(prow + (size_t)(jb + j) * NP) = pk;
                        if (cg < 24) { const float f = fac_l[hx * 128 + l0 + jb + j];
                            u32x4_t ps; ps.x = pkbf(o[0] * f, o[1] * f); ps.y = pkbf(o[2] * f, o[3] * f); ps.z = pkbf(o[4] * f, o[5] * f); ps.w = pkbf(o[6] * f, o[7] * f);
                            *(LAS u32x4_t*)(lds + SSD_OFF_X + (l0 + jb + j) * SSD_RSX + 16 * cg) = ps; }
                        else if (cg < 40) *(LAS u32x4_t*)(lds + SSD_OFF_B + (l0 + jb + j) * SSD_RSB + 16 * (cg - 24)) = pk;
                    }
                }
            }
            __syncthreads();
            bf16x8 bfr[4];
#pragma unroll
            for (int ks = 0; ks < 4; ++ks) {
                LAS const unsigned char* bp = lds + SSD_OFF_B + (32 * ks + 4 * kq + (qi >> 2)) * SSD_RSB + (16 * wave + 4 * (qi & 3)) * 2;
                const v4i16_t lo = lds_tr16(bp), hi = lds_tr16(bp + 16 * SSD_RSB);
                bfr[ks] = (bf16x8){lo[0], lo[1], lo[2], lo[3], hi[0], hi[1], hi[2], hi[3]};
            }
#pragma unroll 1
            for (int hh = 0; hh < 3; ++hh) {
                bf16_t* sp = STATES + ((((size_t)u * 6 + g * 3 + hh) * 64) * 128);
#pragma unroll
                for (int pt = 0; pt < 4; ++pt) {
                    f32x4 acc = (f32x4){0.f, 0.f, 0.f, 0.f};
                    v4i16_t xlo[4], xhi[4];
#pragma unroll
                    for (int ks = 0; ks < 4; ++ks) {
                        LAS const unsigned char* xp = lds + SSD_OFF_X + (32 * ks + 4 * kq + (qi >> 2)) * SSD_RSX + (hh * 64 + 16 * pt + 4 * (qi & 3)) * 2;
                        xlo[ks] = lds_tr16(xp); xhi[ks] = lds_tr16(xp + 16 * SSD_RSX);
                    }
#pragma unroll
                    for (int ks = 0; ks < 4; ++ks) acc = MFMA16(((bf16x8){xlo[ks][0], xlo[ks][1], xlo[ks][2], xlo[ks][3], xhi[ks][0], xhi[ks][1], xhi[ks][2], xhi[ks][3]}), bfr[ks], acc);
                    __builtin_amdgcn_sched_group_barrier(0x100, 8, 0); __builtin_amdgcn_sched_group_barrier(0x008, 4, 0);
#pragma unroll
                    for (int r = 0; r < 4; ++r) sp[(size_t)(16 * pt + 4 * kq + r) * 128 + 16 * wave + qi] = f2bf(acc[r]);
                }
            }
        }
    }
    __syncthreads();
}
__device__ __forceinline__ void ph_ssd_scan(const MkArgs& args, int tid) {
    unsigned* STATES = (unsigned*)(args.ws + WS_YS); const float* ACS = (const float*)(args.ws + WS_ACS);
    constexpr int NE = 2 * 6 * 64 * 64;
    const int G_ = (int)gridDim.x, per = (((NE + G_ - 1) / G_) + 63) & ~63, lane = tid & 63;
    for (int i0 = 0; i0 < per; i0 += NWAVES * 64) {
        const int e = (int)blockIdx.x * per + i0 + tid;
        if (i0 + tid < per && e < NE) {
            const int pn2 = e & 4095, h = (e >> 12) % 6, b = e / (6 * 4096);
            unsigned* sp = STATES + ((size_t)(b * 128) * 6 + h) * 4096 + pn2;
            const float ed0 = __expf(ACS[((size_t)b * SEQ + (size_t)lane * 128 + 127) * 8 + h]), ed1 = __expf(ACS[((size_t)b * SEQ + (size_t)(64 + lane) * 128 + 127) * 8 + h]);
            float H0 = 0.f, H1 = 0.f;
#pragma unroll 1
            for (int hf = 0; hf < 2; ++hf) {
                unsigned* sq = sp + (size_t)hf * 64 * 6 * 4096; const float edv = hf ? ed1 : ed0;
                unsigned sv[64];
#pragma unroll
                for (int c = 0; c < 64; ++c) sv[c] = sq[(size_t)c * 6 * 4096];
#pragma unroll
                for (int c = 0; c < 64; ++c) {
                    sq[(size_t)c * 6 * 4096] = pkbf(H0, H1);
                    const float ed = __builtin_bit_cast(float, __builtin_amdgcn_readlane(__builtin_bit_cast(int, edv), c));
                    H0 = H0 * ed + bflo(sv[c]); H1 = H1 * ed + bfhi(sv[c]);
                }
            }
        }
    }
}
template <int l> __device__ __forceinline__ void ph_ssd2(const MkArgs& args, LAS unsigned char* lds, int tid, int wave, int lane) {
    const bf16_t* PROJ = (const bf16_t*)(args.ws + WS_PROJ); bf16_t* CAT = (bf16_t*)(args.ws + WS_CAT);
    const float* ACS = (const float*)(args.ws + WS_ACS); const float* DTS = (const float*)(args.ws + WS_DTS); const bf16_t* STATES = (const bf16_t*)(args.ws + WS_YS);
    const float* dvec = args.in[8] + l * 6; const float* gn = args.in[9] + l * 384;
    LAS float* acs_l = (LAS float*)(lds + SSD_OFF_ARR); LAS float* dt_l = acs_l + 768;
    constexpr int SSD_OFF_P2 = SSD_OFF_C + 128 * SSD_RSB;
    const int qi = lane & 15, kq = lane >> 4, erow = lane >> 2, epq = lane & 3;
    for (int u = blockIdx.x; u < 256; u += gridDim.x) {
        const int b = u >> 7, c = u & 127; const size_t row0 = (size_t)b * SEQ + (size_t)c * 128;
        __syncthreads();
        for (int i = tid; i < 768; i += NWAVES * 64) { const int h = i >> 7, ll = i & 127; acs_l[i] = ACS[(row0 + ll) * 8 + h]; dt_l[i] = DTS[(row0 + ll) * 8 + h]; }
        float ssq = 0.f;
        const size_t erow_g = row0 + 16 * wave + erow;
#pragma unroll 1
        for (int g = 0; g < 2; ++g) {
            __syncthreads();
            {
                const int ll = tid >> 2, c4 = tid & 3; const bf16_t* prow = PROJ + (row0 + ll) * NP + PC_XBC;
                u32x4_t sv[14];
#pragma unroll
                for (int i = 0; i < 14; ++i) { const int cg = c4 + 4 * i; sv[i] = *(const u32x4_t*)(prow + (i < 6 ? g * 192 + 8 * cg : (i < 10 ? 384 + g * 128 + 8 * (cg - 24) : 640 + g * 128 + 8 * (cg - 40)))); }
#pragma unroll
                for (int i = 0; i < 14; ++i) { const int cg = c4 + 4 * i; const u32x4_t v = sv[i];
                    if (i < 6) { const float f = dt_l[(g * 3 + (cg >> 3)) * 128 + ll];
                        u32x4_t ps; ps.x = pkbf(bflo(v.x) * f, bfhi(v.x) * f); ps.y = pkbf(bflo(v.y) * f, bfhi(v.y) * f); ps.z = pkbf(bflo(v.z) * f, bfhi(v.z) * f); ps.w = pkbf(bflo(v.w) * f, bfhi(v.w) * f);
                        *(LAS u32x4_t*)(lds + SSD_OFF_X + ll * SSD_RSX + 16 * cg) = ps; }
                    else if (i < 10) *(LAS u32x4_t*)(lds + SSD_OFF_B + ll * SSD_RSB + 16 * (cg - 24)) = v;
                    else *(LAS u32x4_t*)(lds + SSD_OFF_C + ll * SSD_RSB + 16 * (cg - 40)) = v; }
            }
            u32x4_t pv[6];
#pragma unroll
            for (int i = 0; i < 6; ++i) pv[i] = *(const u32x4_t*)(STATES + (((size_t)u * 6 + g * 3) * 64) * 128 + (size_t)(tid + NWAVES * 64 * i) * 8);
            __syncthreads();
            bf16x8 cfr[4];
#pragma unroll
            for (int ks = 0; ks < 4; ++ks) cfr[ks] = *(const LAS bf16x8*)(lds + SSD_OFF_C + (16 * wave + qi) * SSD_RSB + (32 * ks + 8 * kq) * 2);
            f32x4 cb[8];
#pragma unroll
            for (int st = 0; st < 8; ++st) { cb[st] = (f32x4){0.f, 0.f, 0.f, 0.f};
                if (st <= wave) {
#pragma unroll
                    for (int ks = 0; ks < 4; ++ks) cb[st] = MFMA16(cfr[ks], *(const LAS bf16x8*)(lds + SSD_OFF_B + (16 * st + qi) * SSD_RSB + (32 * ks + 8 * kq) * 2), cb[st]); } }
            __syncthreads();
#pragma unroll
            for (int i = 0; i < 6; ++i) { const int e8 = tid + NWAVES * 64 * i, hh = e8 >> 10, p = (e8 >> 4) & 63, n8 = e8 & 15;
                *(LAS u32x4_t*)(lds + (hh < 2 ? SSD_OFF_C + hh * 64 * SSD_RSB : SSD_OFF_P2) + p * SSD_RSB + 16 * n8) = pv[i]; }
            __syncthreads();
            LAS unsigned char* mw = lds + SSD_OFF_B + wave * (16 * SSD_RSB);
#pragma unroll 1
            for (int hh = 0; hh < 3; ++hh) {
                const int h = g * 3 + hh;
                const int ch0 = h * 64 + 16 * epq; const bf16_t* prow = PROJ + erow_g * NP;
                const u32x4_t x0 = *(const u32x4_t*)(prow + PC_XBC + ch0), x1 = *(const u32x4_t*)(prow + PC_XBC + ch0 + 8), z0 = *(const u32x4_t*)(prow + PC_Z + ch0), z1 = *(const u32x4_t*)(prow + PC_Z + ch0 + 8);
                const float Dh = dvec[h];
                float al[4], el[4];
#pragma unroll
                for (int r = 0; r < 4; ++r) { al[r] = acs_l[h * 128 + 16 * wave + 4 * kq + r]; el[r] = __expf(al[r]); }
#pragma unroll
                for (int st = 0; st < 8; ++st) { const int sidx = 16 * st + qi; const float as = acs_l[h * 128 + sidx];
#pragma unroll
                    for (int r = 0; r < 4; ++r) { const int ll = 16 * wave + 4 * kq + r; const float mv = sidx <= ll ? cb[st][r] * __expf(al[r] - as) : 0.f;
                        *(LAS bf16_t*)(mw + (4 * kq + r) * SSD_RSB + sidx * 2) = f2bf(mv); } }
                LDS_WAIT(); asm volatile("" ::: "memory");
                bf16x8 mfr[4];
#pragma unroll
                for (int ks = 0; ks < 4; ++ks) mfr[ks] = *(const LAS bf16x8*)(mw + qi * SSD_RSB + (32 * ks + 8 * kq) * 2);
                LAS const unsigned char* pvb = lds + (hh < 2 ? SSD_OFF_C + hh * 64 * SSD_RSB : SSD_OFF_P2);
                f32x4 yy[4];
#pragma unroll
                for (int pt = 0; pt < 4; ++pt) {
                    f32x4 yd = (f32x4){0.f, 0.f, 0.f, 0.f}, yo = (f32x4){0.f, 0.f, 0.f, 0.f};
                    v4i16_t xlo[4], xhi[4]; bf16x8 pfr[4];
#pragma unroll
                    for (int ks = 0; ks < 4; ++ks) {
                        LAS const unsigned char* xp = lds + SSD_OFF_X + (32 * ks + 8 * kq + (qi >> 2)) * SSD_RSX + (hh * 64 + 16 * pt + 4 * (qi & 3)) * 2;
                        xlo[ks] = lds_tr16(xp); xhi[ks] = lds_tr16(xp + 4 * SSD_RSX);
                        pfr[ks] = *(const LAS bf16x8*)(pvb + (16 * pt + qi) * SSD_RSB + (32 * ks + 8 * kq) * 2);
                    }
#pragma unroll
                    for (int ks = 0; ks < 4; ++ks) {
                        yd = MFMA16(mfr[ks], ((bf16x8){xlo[ks][0], xlo[ks][1], xlo[ks][2], xlo[ks][3], xhi[ks][0], xhi[ks][1], xhi[ks][2], xhi[ks][3]}), yd);
                        yo = MFMA16(cfr[ks], pfr[ks], yo);
                    }
                    __builtin_amdgcn_sched_group_barrier(0x100, 12, 0); __builtin_amdgcn_sched_group_barrier(0x008, 8, 0);
#pragma unroll
                    for (int r = 0; r < 4; ++r) yy[pt][r] = yd[r] + yo[r] * el[r];
                }
                LDS_WAIT(); asm volatile("" ::: "memory");
#pragma unroll
                for (int pt = 0; pt < 4; ++pt)
#pragma unroll
                    for (int r = 0; r < 4; ++r) *(LAS float*)(mw + (4 * kq + r) * SSD_RSB + (16 * pt + qi) * 4) = yy[pt][r];
                LDS_WAIT(); asm volatile("" ::: "memory");
                {
                    f32x4 y4[4];
#pragma unroll
                    for (int q = 0; q < 4; ++q) y4[q] = *(const LAS f32x4*)(mw + erow * SSD_RSB + (16 * epq + 4 * q) * 4);
                    float v[16];
#define SSD_EPI(i, yv, xw, zw, hi_) { const float xs_ = hi_ ? bfhi(xw) : bflo(xw), zz_ = hi_ ? bfhi(zw) : bflo(zw); v[i] = ((yv) + Dh * xs_) * fsilu(zz_); ssq += v[i] * v[i]; }
                    SSD_EPI(0, y4[0].x, x0.x, z0.x, 0) SSD_EPI(1, y4[0].y, x0.x, z0.x, 1) SSD_EPI(2, y4[0].z, x0.y, z0.y, 0) SSD_EPI(3, y4[0].w, x0.y, z0.y, 1)
                    SSD_EPI(4, y4[1].x, x0.z, z0.z, 0) SSD_EPI(5, y4[1].y, x0.z, z0.z, 1) SSD_EPI(6, y4[1].z, x0.w, z0.w, 0) SSD_EPI(7, y4[1].w, x0.w, z0.w, 1)
                    SSD_EPI(8, y4[2].x, x1.x, z1.x, 0) SSD_EPI(9, y4[2].y, x1.x, z1.x, 1) SSD_EPI(10, y4[2].z, x1.y, z1.y, 0) SSD_EPI(11, y4[2].w, x1.y, z1.y, 1)
                    SSD_EPI(12, y4[3].x, x1.z, z1.z, 0) SSD_EPI(13, y4[3].y, x1.z, z1.z, 1) SSD_EPI(14, y4[3].z, x1.w, z1.w, 0) SSD_EPI(15, y4[3].w, x1.w, z1.w, 1)
#undef SSD_EPI
                    u32x4_t o0, o1; o0.x = pkbf(v[0], v[1]); o0.y = pkbf(v[2], v[3]); o0.z = pkbf(v[4], v[5]); o0.w = pkbf(v[6], v[7]); o1.x = pkbf(v[8], v[9]); o1.y = pkbf(v[10], v[11]); o1.z = pkbf(v[12], v[13]); o1.w = pkbf(v[14], v[15]);
                    *(u32x4_t*)(CAT + erow_g * 1536 + ch0) = o0; *(u32x4_t*)(CAT + erow_g * 1536 + ch0 + 8) = o1;
                }
                LDS_WAIT(); asm volatile("" ::: "memory");
            }
        }
        ssq += __shfl_xor(ssq, 1); ssq += __shfl_xor(ssq, 2);
        const float rsn = rsqrtf(ssq * (1.f / 384.f) + 1e-6f);
        asm volatile("s_waitcnt vmcnt(0)" ::: "memory");
        u32x4_t av[6][2]; f32x4 gv[6][4];
#pragma unroll
        for (int h = 0; h < 6; ++h) { const int ch0 = h * 64 + 16 * epq; const bf16_t* p = CAT + erow_g * 1536 + ch0; av[h][0] = *(const u32x4_t*)p; av[h][1] = *(const u32x4_t*)(p + 8);
#pragma unroll
            for (int q = 0; q < 4; ++q) gv[h][q] = *(const f32x4*)(gn + ch0 + 4 * q); }
#pragma unroll
        for (int h = 0; h < 6; ++h) {
            const int ch0 = h * 64 + 16 * epq; bf16_t* p = CAT + erow_g * 1536 + ch0;
            const u32x4_t a0 = av[h][0], a1 = av[h][1];
            const f32x4 g0 = gv[h][0], g1 = gv[h][1], g2 = gv[h][2], g3 = gv[h][3];
            u32x4_t o0, o1;
            o0.x = pkbf(bflo(a0.x) * rsn * g0.x, bfhi(a0.x) * rsn * g0.y); o0.y = pkbf(bflo(a0.y) * rsn * g0.z, bfhi(a0.y) * rsn * g0.w);
            o0.z = pkbf(bflo(a0.z) * rsn * g1.x, bfhi(a0.z) * rsn * g1.y); o0.w = pkbf(bflo(a0.w) * rsn * g1.z, bfhi(a0.w) * rsn * g1.w);
            o1.x = pkbf(bflo(a1.x) * rsn * g2.x, bfhi(a1.x) * rsn * g2.y); o1.y = pkbf(bflo(a1.y) * rsn * g2.z, bfhi(a1.y) * rsn * g2.w);
            o1.z = pkbf(bflo(a1.z) * rsn * g3.x, bfhi(a1.z) * rsn * g3.y); o1.w = pkbf(bflo(a1.w) * rsn * g3.z, bfhi(a1.w) * rsn * g3.w);
            *(u32x4_t*)p = o0; *(u32x4_t*)(p + 8) = o1;
        }
    }
    __syncthreads();
}

#if defined(PROBE_LO)
#define PROBE_BEGIN(lp) do { if ((lp) == PROBE_LO) t_probe = __builtin_amdgcn_s_memrealtime(); } while (0)
#define PROBE_END(lp) do { if ((lp) == PROBE_HI) { const unsigned long long t1_ = __builtin_amdgcn_s_memrealtime(), d_ = (t1_ - t_probe) * PROBE_K; while (__builtin_amdgcn_s_memrealtime() - t1_ < d_) __builtin_amdgcn_s_sleep(8); } } while (0)
#else
#define PROBE_BEGIN(lp) do { } while (0)
#define PROBE_END(lp) do { } while (0)
#endif
#define WSP(type, off) ((type*)(args.ws + (off)))
#define IN(k) (lo <= (k) && (k) < hi)
#define SEAM(k) do { if (IN(k) && IN((k) + 1)) xcd_barrier(bar); } while (0)
template <int l> __device__ __forceinline__ void layer_phases(const MkArgs& args, LAS unsigned char* lds, const XcdBarrier& bar, const int lo, const int hi) {
    const int P0 = PH_L0 + l * PH_PER_LAYER;
    const int tid = threadIdx.x, lane = tid & 63, wave = __builtin_amdgcn_readfirstlane(tid >> 6);
    const int gw = (int)blockIdx.x * NWAVES + wave, NGW = (int)gridDim.x * NWAVES;
    unsigned long long t_probe = 0; (void)t_probe;
    PROBE_BEGIN(LP_NORM1);
    if (IN(P0 + LP_NORM1)) {
        const LAS int* tb = nullptr;
        if (l == 0) {
        } else { tb = moe_tables(args, 0, lds, tid); ph_norm1<l>(args, tb, lds, tid, lane, gw, NGW); }
    }
    PROBE_END(LP_NORM1);
    if (l != 0) SEAM(P0 + LP_NORM1);
    PROBE_BEGIN(LP_GIN);
    if (IN(P0 + LP_GIN)) {
        if (l == 0) {
            const int kv0 = gridDim.x >= 160 ? 128 : 0, nkv = gridDim.x >= 160 ? 32 : (int)gridDim.x;
            if ((int)blockIdx.x >= kv0 && (int)blockIdx.x < kv0 + nkv) {
                pg8::Gemm g{WSP(bf16_t, WS_MEMN), WSP(bf16_t, WS_WKV), 512, 4096, DM}; pg8::StaticOrder S; S.init(512, 4096, nkv, (int)blockIdx.x - kv0);
                pg8::EpiBf16<0> E{WSP(bf16_t, WS_KV), 4096, nullptr, 0, 0, 1.f};
                pg8::gemm_phase<pg8::EpiBf16<0>, pg8::StaticOrder, true, true>(lds, g, S, E);
            }
        }
        pg8::Gemm g{(const bf16_t*)args.out, WSP(bf16_t, WS_WIN), T, NP, DM}; pg8::StaticOrder S; S.init(T, NP, gridDim.x, (int)blockIdx.x);
        pg8::EpiProj E{WSP(bf16_t, WS_PROJ), WSP(bf16_t, WS_HALO), WSP(const float, WS_GATEBUF) + 65536};
        pg8::gemm_phase<pg8::EpiProj, pg8::StaticOrder, true, true>(lds, g, S, E);
    }
    PROBE_END(LP_GIN);
    SEAM(P0 + LP_GIN);
    PROBE_BEGIN(LP_QKN);
    PROBE_END(LP_QKN);
    PROBE_BEGIN(LP_MIX1);
    if (IN(P0 + LP_MIX1)) {
        if (l == 0) ph_knorm(args, lane, gw, NGW);
        PROBE_BEGIN(22); if (args.mask & 4) ph_ssd1<l>(args, lds, tid, wave, lane); PROBE_END(22);
        PROBE_BEGIN(20); if (args.mask & 1) ph_cf<l>(args, lds, tid, wave, lane); PROBE_END(20);
    }
    PROBE_END(LP_MIX1);
    SEAM(P0 + LP_MIX1);
    PROBE_BEGIN(LP_SCAN);
    if (IN(P0 + LP_SCAN)) { ph_ssd_scan(args, tid); PROBE_BEGIN(21); ph_dattn<l>(args, lds, tid, wave, lane); PROBE_END(21); }
    PROBE_END(LP_SCAN);
    SEAM(P0 + LP_SCAN);
    PROBE_BEGIN(LP_MIX2);
    if (IN(P0 + LP_MIX2)) {
        PROBE_BEGIN(23); if (args.mask & 1) ph_attn_comb(args, lane, gw, NGW); PROBE_END(23);
        PROBE_BEGIN(24); if (args.mask & 4) ph_ssd2<l>(args, lds, tid, wave, lane); PROBE_END(24);
    }
    PROBE_END(LP_MIX2);
    SEAM(P0 + LP_MIX2);
    PROBE_BEGIN(LP_GOUT);
    if (IN(P0 + LP_GOUT)) {
        pg8::Gemm g{WSP(bf16_t, WS_CAT), WSP(bf16_t, WS_WOUT), T, DM, 1536}; pg8::StaticOrder S; S.init(T, DM, gridDim.x, (int)blockIdx.x);
        pg8::EpiResB<false, true> E{(const void*)args.out, WSP(bf16_t, WS_XB1), WSP(float, WS_SSQ)};
        pg8::gemm_phase<pg8::EpiResB<false, true>, pg8::StaticOrder, true, true>(lds, g, S, E);
    }
    PROBE_END(LP_GOUT);
    SEAM(P0 + LP_GOUT);
    PROBE_BEGIN(LP_NORM2);
    PROBE_END(LP_NORM2);
    PROBE_BEGIN(LP_GQ);
    if (IN(P0 + LP_GQ)) {
        pg8::Gemm g{WSP(bf16_t, WS_XB1), WSP(bf16_t, WS_WQ), T, DM, DM}; pg8::StaticOrder S; S.init(T, DM, gridDim.x, (int)blockIdx.x);
        pg8::EpiBf16RowScale E{WSP(bf16_t, WS_Q), WSP(const float, WS_SSQ)};
        pg8::gemm_phase<pg8::EpiBf16RowScale, pg8::StaticOrder, true, true>(lds, g, S, E);
    }
    PROBE_END(LP_GQ);
    SEAM(P0 + LP_GQ);
    PROBE_BEGIN(LP_CA);
    if (IN(P0 + LP_CA)) ph_ca<l>(args, lds, tid, wave, lane);
    PROBE_END(LP_CA);
    SEAM(P0 + LP_CA);
    PROBE_BEGIN(LP_GO);
    if (IN(P0 + LP_GO)) {
        pg8::Gemm g{WSP(bf16_t, WS_O), WSP(bf16_t, WS_WO), T, DM, DM}; pg8::StaticOrder S; S.init(T, DM, gridDim.x, (int)blockIdx.x);
        pg8::EpiResB<false, false> E{(const void*)WSP(bf16_t, WS_XB1), WSP(bf16_t, WS_XN), nullptr};
        pg8::gemm_phase<pg8::EpiResB<false, false>, pg8::StaticOrder, true, true>(lds, g, S, E);
    }
    PROBE_END(LP_GO);
    SEAM(P0 + LP_GO);
    PROBE_BEGIN(LP_ROUTER);
    if (IN(P0 + LP_ROUTER)) { ph_router<l>(args, lds, tid, lane, gw, NGW); __syncthreads(); cvt_layer_experts(args, l, lds, wave, lane, gw, NGW); }
    PROBE_END(LP_ROUTER);
    SEAM(P0 + LP_ROUTER);
    PROBE_BEGIN(LP_GATHER);
    PROBE_END(LP_GATHER);
    PROBE_BEGIN(LP_GGU);
    if (IN(P0 + LP_GGU)) {
        const LAS int* tb = moe_tables(args, l, lds, tid);
        pg8::Gemm g{WSP(bf16_t, WS_XN), WSP(bf16_t, WS_WGU), 0, 1024, DM}; pg8::MoeOrder<true> S; S.init(4, gridDim.x, (int)blockIdx.x, tb, (size_t)1024 * DM * 2, WSP(const int, WS_LIST), DM * 2);
        pg8::EpiGateUp E{WSP(bf16_t, WS_HID), WSP(const float, WS_GATEBUF), WSP(const int, WS_LIST), tb};
        pg8::gemm_phase<pg8::EpiGateUp, pg8::MoeOrder<true>, true, true>(lds, g, S, E);
        if (l == 0) {
            const int G_ = (int)gridDim.x, r = ((tb[32] / 256) * 4) % G_, c = (int)blockIdx.x;
            if (r == 0) cvt_layer_small(args, 1, lds, wave, lane, gw, NGW);
            else if (c >= r) cvt_layer_small(args, 1, lds, wave, lane, (c - r) * NWAVES + wave, (G_ - r) * NWAVES);
        }
    }
    PROBE_END(LP_GGU);
    SEAM(P0 + LP_GGU);
    PROBE_BEGIN(LP_GDOWN);
    if (IN(P0 + LP_GDOWN)) {
        const LAS int* tb = moe_tables(args, l, lds, tid);
        pg8::Gemm g{WSP(bf16_t, WS_HID), WSP(bf16_t, WS_WD), 0, 1024, 512}; pg8::MoeOrder<false> S; S.init(4, gridDim.x, (int)blockIdx.x, tb, (size_t)DM * 512 * 2, nullptr, 0u);
        pg8::EpiDown E{WSP(bf16_t, WS_YB), WSP(const float, WS_GATEL), tb};
        pg8::gemm_phase<pg8::EpiDown, pg8::MoeOrder<false>, true, true>(lds, g, S, E);
    }
    PROBE_END(LP_GDOWN);
    SEAM(P0 + LP_GDOWN);
}
__global__ void __launch_bounds__(NWAVES * 64, 2) mk_fwd(MkArgs args) {
    extern __shared__ __attribute__((aligned(16))) unsigned char lds_raw[];
    LAS unsigned char* lds = (LAS unsigned char*)lds_raw;
    for (int u = threadIdx.x; u < 64; u += NWAVES * 64) ((LAS unsigned*)(lds + MISC_OFF))[u] = 0u;
    __syncthreads();
    XcdBarrier bar = xcd_barrier_post(WSP(unsigned, WS_CTL) + CW_BAR + args.bar_region * XCD_BAR_WORDS, (volatile LAS unsigned*)(lds + MISC_OFF) + 8);
    const int lo = args.ph_lo, hi = args.ph_hi;
    unsigned long long t_probe = 0; (void)t_probe;
    PROBE_BEGIN(30);
    if (IN(0)) { const int tid = threadIdx.x, lane = tid & 63, wave = __builtin_amdgcn_readfirstlane(tid >> 6);
        ph_pro0(args, lds, wave, lane, (int)blockIdx.x * NWAVES + wave, (int)gridDim.x * NWAVES);
        ph_norm1<0>(args, nullptr, lds, tid, lane, (int)blockIdx.x * NWAVES + wave, (int)gridDim.x * NWAVES); }
    PROBE_END(30);
    SEAM(0);
    layer_phases<0>(args, lds, bar, lo, hi);
    layer_phases<1>(args, lds, bar, lo, hi);
    PROBE_BEGIN(32);
    if (IN(PH_FINAL)) { const int tid = threadIdx.x, lane = tid & 63, wave = __builtin_amdgcn_readfirstlane(tid >> 6);
        const LAS int* tb = moe_tables(args, 1, lds, tid);
        ph_final(args, tb, lane, (int)blockIdx.x * NWAVES + wave, (int)gridDim.x * NWAVES); }
    PROBE_END(32);
#undef IN
#undef SEAM
}

static int g_grid = 0, g_region = 0;
static void mk(hipStream_t stream, void* const* d_in, void* d_out, void* d_ws, int lo, int hi, int mask = 0) {
    MkArgs a{};
    for (int i = 0; i < 33; ++i) a.in[i] = (const float*)d_in[i];
    a.out = (float*)d_out; a.ws = (unsigned char*)d_ws; a.ph_lo = lo; a.ph_hi = hi; a.bar_region = g_region++; a.mask = mask;
    hipLaunchKernelGGL(mk_fwd, dim3(g_grid), dim3(NWAVES * 64), LDS_BYTES, stream, a);
}

extern "C" void kernel_launch(void* const* d_in, const int* in_sizes, int n_in, void* d_out, int out_size, void* d_ws, size_t ws_size, hipStream_t stream) {
    if (n_in != 33 || ws_size < WS_END) { fprintf(stderr, "kernel_launch: bad n_in %d or ws %zu < %zu\n", n_in, ws_size, (size_t)WS_END); return; }
    if (g_grid == 0) {
        int dev = 0, cus = 0;
        (void)hipGetDevice(&dev); (void)hipDeviceGetAttribute(&cus, hipDeviceAttributeMultiprocessorCount, dev);
        if (hipFuncSetAttribute((const void*)mk_fwd, hipFuncAttributeMaxDynamicSharedMemorySize, LDS_BYTES) != hipSuccess) fprintf(stderr, "hipFuncSetAttribute failed\n");
        g_grid = cus > 0 ? cus : 256;
    }
    int* CTL = (int*)((char*)d_ws + WS_CTL);
    (void)hipMemsetAsync(CTL, 0, CTL_ZERO_BYTES, stream);
    g_region = 0;
#define MK(lo, hi, mask) mk(stream, d_in, d_out, d_ws, (lo), (hi), (mask))
    MK(0, PH_COUNT, 7);
#undef MK
}
```

```cpp
#include <hip/hip_runtime.h>
#include <stdint.h>
#include <stdio.h>

typedef unsigned short bf16_t;
typedef short bf16x8 __attribute__((ext_vector_type(8)));
typedef float f32x4 __attribute__((ext_vector_type(4)));

constexpr int DM = 1024, BATCH = 2, SEQ = 16384, T = BATCH * SEQ, MEML = 256;
constexpr int NIN = 4358, NP = 4352;
constexpr int PC_Z = 0, PC_XBC = 384, PC_SCB = 1280, PC_SCC = 1664, PC_SCH = 2048, PC_Q = 2432, PC_K = 2816, PC_V = 3200, PC_CFA = 3584, PC_CFG = 3968;
constexpr int NEXP = 32, LISTCAP = 65536, PROWS = 65536 + 32 * 256;
constexpr size_t MiB = 1u << 20;
constexpr size_t WS_CTL = 0, WS_WIN = 1 * MiB, WS_WOUT = 10 * MiB, WS_WQ = 13 * MiB, WS_WO = 15 * MiB, WS_WKV = 17 * MiB, WS_MEMN = 25 * MiB, WS_KV = 26 * MiB;
constexpr size_t WS_PROJ = 33 * MiB, WS_Q = 33 * MiB, WS_O = 97 * MiB, WS_BUF = 33 * MiB, WS_YB = 33 * MiB, WS_HID = 177 * MiB;
constexpr size_t WS_CAT = 305 * MiB, WS_XN = 305 * MiB;
constexpr size_t WS_OBR = 401 * MiB, WS_LSE = 473 * MiB, WS_YS = 476 * MiB, WS_DT = 525 * MiB;
constexpr size_t WS_WGU = 401 * MiB, WS_WD = 465 * MiB;
constexpr size_t WS_LIST = 527 * MiB, WS_GATEL = 535 * MiB, WS_TOKDEST = 543 * MiB, WS_GATEBUF = 544 * MiB, WS_END = 545 * MiB;
constexpr int CW_CNT = 0, CW_CNT_STRIDE = 32, CW_NT = 1024, CW_TILEE = 1088, CW_LAYER = 2048;

__device__ __forceinline__ float bf2f(bf16_t v) { return __uint_as_float(((unsigned)v) << 16); }
__device__ __forceinline__ bf16_t f2bf(float f) { unsigned u = __float_as_uint(f); return (bf16_t)((u + 0x7fffu + ((u >> 16) & 1u)) >> 16); }

namespace pg8 {
#define PG8_LAS __attribute__((address_space(3)))
typedef unsigned short bf16_t;
typedef short bf16x8 __attribute__((ext_vector_type(8)));
typedef float f32x4 __attribute__((ext_vector_type(4)));
typedef unsigned u32x4 __attribute__((ext_vector_type(4)));
constexpr int BM = 256, BK = 64, HALF = 128, HTB = HALF * BK * 2  , STAGE_BYTES = 8 * HTB, NXCD = 8, WGM = 8;

__host__ __device__ __forceinline__ int lds_byte(int r, int c) { const int st = (r >> 4) * 2 + (c >> 5), rr = r & 15, cc = c & 31, ob = rr * 64 + cc * 2; return st * 1024 + (ob ^ (((ob >> 9) & 1) << 5)); }
__host__ __device__ __forceinline__ void stage_rc(int b, int& R, int& C) { const int st = b / 1024, sb = b % 1024, swz = sb ^ (((sb >> 9) & 1) << 5); R = (st >> 1) * 16 + swz / 64; C = (st & 1) * 32 + (swz % 64) / 2; }
__host__ __device__ __forceinline__ int perm32(int rho) { const int n = rho >> 4, i = rho & 15; return 8 * (i >> 2) + 4 * n + (i & 3); }

struct Unit { int pm, pn; };
struct Gemm { const bf16_t* A; const bf16_t* Bt; int M, N, K; };

struct StaticOrder {
    static constexpr bool GATHER = false;
    __device__ __forceinline__ unsigned a_rowoff(const Unit&, int) const { return 0u; }
    int nM, nN, nwg, G, c;
    __host__ __device__ void init(int M, int N, int G_, int c_) { nM = M / BM; nN = N / BM; nwg = nM * nN; G = G_; c = c_; }
    __host__ __device__ bool next(int i, Unit& u) const {
        const long L = (long)i * G + c; if (L >= nwg) return false;
        int wgid = (int)L; { const int q = nwg / NXCD, r = nwg % NXCD, xcd = wgid % NXCD, off = wgid / NXCD; wgid = (xcd < r ? xcd * (q + 1) : r * (q + 1) + (xcd - r) * q) + off; }
        const int nig = WGM * nN, gid = wgid / nig, fm = gid * WGM, gsz = (nM - fm) < WGM ? (nM - fm) : WGM;
        u.pm = fm + ((wgid % nig) % gsz); u.pn = (wgid % nig) / gsz; return true;
    }
    __device__ __forceinline__ void a_ready(const Unit&) const {}
    __device__ __forceinline__ const char* b_base(const Gemm& g, const Unit&) const { return (const char*)g.Bt; }
    __device__ __forceinline__ void done(const Unit&) const {}
};

__device__ __forceinline__ unsigned cvt_pk_bf16(float lo, float hi) { unsigned r; asm volatile("v_cvt_pk_bf16_f32 %0, %1, %2" : "=v"(r) : "v"(lo), "v"(hi)); return r; }
typedef float f32x2 __attribute__((ext_vector_type(2)));
__device__ __forceinline__ f32x2 gelu_pk(f32x2 v) {
    const f32x2 av = __builtin_elementwise_abs(v), d = av * 0.2316418882f + 1.0f;
    f32x2 t; t.x = __builtin_amdgcn_rcpf(d.x); t.y = __builtin_amdgcn_rcpf(d.y);
    f32x2 q = t * 0.5307027145f + (-0.7265760135f); q = q * t + 0.7107068705f; q = q * t + (-0.142248368f); q = q * t + 0.127414796f; q = q * t;
    const f32x2 s = (v * v) * (-0.72134752044f);
    f32x2 e; e.x = __builtin_amdgcn_exp2f(s.x); e.y = __builtin_amdgcn_exp2f(s.y);
    const f32x2 m = v * (q * e), r = v - m;
    f32x2 o; o.x = v.x < 0.f ? m.x : r.x; o.y = v.y < 0.f ? m.y : r.y; return o;
}

template <int ACT  > struct EpiBf16 {
    static constexpr bool PERM = true, AFTER_DRAIN = false; static_assert(ACT == 0 || ACT == 1, "EpiBf16: ACT is 0 (none) or 1 (gelu_pk)");
    bf16_t* O; int ldc; const float* bias; int split_cols; size_t split_stride; float scale0;
    __device__ __forceinline__ void operator()(const f32x4 (&acc)[2][2][4][2], const Unit& u, int wr, int wc, int fr, int fq) const {
        const int row0 = u.pm * BM + wr * 64 + fr; int colt = u.pn * BM; bf16_t* base = O;
        float sc = 1.f; if (split_cols) { const int t = colt / split_cols; base += (size_t)t * split_stride; colt -= t * split_cols; if (t == 0) sc = scale0; }
        const int col0 = colt + wc * 32 + 8 * fq, bcol0 = u.pn * BM + wc * 32 + 8 * fq;
        f32x4 bv[2][2];
#pragma unroll
        for (int bj = 0; bj < 2; ++bj)
#pragma unroll
            for (int n = 0; n < 2; ++n) bv[bj][n] = bias ? *(const f32x4*)(bias + bcol0 + bj * HALF + 4 * n) : (f32x4){0.f, 0.f, 0.f, 0.f};
#pragma unroll
        for (int ai = 0; ai < 2; ++ai)
#pragma unroll
            for (int m = 0; m < 4; ++m) { bf16_t* rowp = base + (size_t)(row0 + ai * HALF + m * 16) * ldc + col0;
#pragma unroll
                for (int bj = 0; bj < 2; ++bj) { f32x4 v0 = acc[ai][bj][m][0] + bv[bj][0], v1 = acc[ai][bj][m][1] + bv[bj][1];
                    if (ACT == 1) { f32x2 a = gelu_pk((f32x2){v0[0], v0[1]}), b = gelu_pk((f32x2){v0[2], v0[3]}), c = gelu_pk((f32x2){v1[0], v1[1]}), d = gelu_pk((f32x2){v1[2], v1[3]});
                        v0 = (f32x4){a.x, a.y, b.x, b.y}; v1 = (f32x4){c.x, c.y, d.x, d.y}; }
                    v0 = v0 * sc; v1 = v1 * sc; u32x4 w; w.x = cvt_pk_bf16(v0[0], v0[1]); w.y = cvt_pk_bf16(v0[2], v0[3]); w.z = cvt_pk_bf16(v1[0], v1[1]); w.w = cvt_pk_bf16(v1[2], v1[3]);
                    *(u32x4*)(rowp + bj * HALF) = w; } }
    }
};
template <class Epi, class Sched, bool ALIGN_EPI = false, bool SP2 = false>
__device__ __forceinline__ void gemm_phase(PG8_LAS unsigned char* lds, const Gemm g, const Sched& S, const Epi& E) {
    const int tid = threadIdx.x, wid = __builtin_amdgcn_readfirstlane(tid >> 6), lane = tid & 63, wr = wid >> 2, wc = wid & 3, fr = lane & 15, fq = lane >> 4;
    const int K = g.K, nt = K / BK;
    unsigned voffA[2], voffB[2]; int rowA[2], colA2[2];
#pragma unroll
    for (int i = 0; i < 2; ++i) { int R, C; stage_rc(tid * 16 + i * 8192, R, C); const int Rb = Epi::PERM ? ((R & ~31) + perm32(R & 31)) : R;
        voffA[i] = (unsigned)(R * K + C) * 2u; voffB[i] = (unsigned)(Rb * K + C) * 2u; rowA[i] = R; colA2[i] = C * 2; }
    unsigned voffAc[2][2], voffAn[2][2];
    const size_t kstep = (size_t)(BK * 2);
    const size_t hstep = (size_t)HALF * K * 2;
    const size_t tstep = 2 * hstep;
    const unsigned ldsw = (unsigned)wid * 1024u;
    const int aoff = lds_byte(wr * 64 + fr, fq * 8), boff = lds_byte(wc * 32 + fr, fq * 8);
#define PG8_SA(b, h) (((b) * 2 + (h)) * HTB)
#define PG8_SB(b, h) ((4 + (b) * 2 + (h)) * HTB)
#define PG8_STAGE(bufoff, gbase, voff) do { _Pragma("unroll") for (int _i = 0; _i < 2; ++_i) \
        __builtin_amdgcn_global_load_lds((const unsigned*)((const char*)(gbase) + (voff)[_i]), (PG8_LAS unsigned*)(lds + (bufoff) + ldsw + _i * 8192), 16, 0, 0); } while (0)
#define PG8_STAGE_A(bufoff, gbase, half, usen) do { if constexpr (Sched::GATHER) { _Pragma("unroll") for (int _i = 0; _i < 2; ++_i) { const unsigned _vo = (usen) ? voffAn[half][_i] : voffAc[half][_i]; \
        __builtin_amdgcn_global_load_lds((const unsigned*)((const char*)(gbase) + _vo), (PG8_LAS unsigned*)(lds + (bufoff) + ldsw + _i * 8192), 16, 0, 0); } } \
        else { PG8_STAGE(bufoff, (gbase) + ((half) ? hstep : 0), voffA); } } while (0)
#define PG8_LDA(dst, b, h) do { _Pragma("unroll") for (int m = 0; m < 4; ++m) _Pragma("unroll") for (int k = 0; k < 2; ++k) dst[m][k] = *(const PG8_LAS bf16x8*)(lds + PG8_SA(b, h) + aoff + m * 2048 + k * 1024); } while (0)
#define PG8_LDB(dst, b, h) do { _Pragma("unroll") for (int n = 0; n < 2; ++n) _Pragma("unroll") for (int k = 0; k < 2; ++k) dst[n][k] = *(const PG8_LAS bf16x8*)(lds + PG8_SB(b, h) + boff + n * 2048 + k * 1024); } while (0)
#define PG8_MMA(ai, bj, At, Bt) do { __builtin_amdgcn_s_setprio(1); _Pragma("unroll") for (int m = 0; m < 4; ++m) _Pragma("unroll") for (int n = 0; n < 2; ++n) _Pragma("unroll") for (int k = 0; k < 2; ++k) \
        acc[ai][bj][m][n] = __builtin_amdgcn_mfma_f32_16x16x32_bf16(Bt[n][k], At[m][k], acc[ai][bj][m][n], 0, 0, 0); __builtin_amdgcn_s_setprio(0); } while (0)
#define PG8_WAIT_V(n) asm volatile("s_waitcnt vmcnt(" #n ")" ::: "memory")
#define PG8_WAIT_L(n) asm volatile("s_waitcnt lgkmcnt(" #n ")" ::: "memory")
#define PG8_BAR __builtin_amdgcn_s_barrier()
#define PG8_SCHED __builtin_amdgcn_sched_barrier(0)
    Unit cur, nxt; int ui = 0;
    if (!S.next(0, cur)) return;
    f32x4 acc[2][2][4][2];
#pragma unroll
    for (int a = 0; a < 2; ++a)
#pragma unroll
        for (int b = 0; b < 2; ++b)
#pragma unroll
            for (int m = 0; m < 4; ++m)
#pragma unroll
                for (int n = 0; n < 2; ++n) acc[a][b][m][n] = (f32x4){0.f, 0.f, 0.f, 0.f};
    bf16x8 At[4][2], B0[2][2], B1[2][2];
    const char* cA = (const char*)g.A + (Sched::GATHER ? (size_t)0 : (size_t)cur.pm * tstep); const char* cB = S.b_base(g, cur) + (size_t)cur.pn * tstep;
    if constexpr (Sched::GATHER) { static_assert(!Sched::GATHER || SP2, "gather needs the SP2 loop");
#pragma unroll
        for (int h = 0; h < 2; ++h)
#pragma unroll
            for (int i = 0; i < 2; ++i) voffAc[h][i] = S.a_rowoff(cur, h * HALF + rowA[i]) + (unsigned)colA2[i]; }
    S.a_ready(cur);
    if constexpr (SP2) {
        PG8_STAGE(PG8_SB(0, 0), cB, voffB); PG8_STAGE(PG8_SB(0, 1), cB + hstep, voffB); PG8_STAGE_A(PG8_SA(0, 0), cA, 0, false); PG8_STAGE_A(PG8_SA(0, 1), cA, 1, false);
        if (wr == 1) PG8_BAR;
        PG8_WAIT_V(2); PG8_BAR;
        PG8_STAGE(PG8_SB(1, 0), cB + kstep, voffB); PG8_STAGE_A(PG8_SA(1, 0), cA + kstep, 0, false); PG8_STAGE(PG8_SB(1, 1), cB + hstep + kstep, voffB);
        PG8_WAIT_V(6); PG8_BAR;
    } else {
        PG8_STAGE(PG8_SB(0, 0), cB, voffB); PG8_STAGE(PG8_SA(0, 0), cA, voffA); PG8_STAGE(PG8_SB(0, 1), cB + hstep, voffB); PG8_STAGE(PG8_SA(0, 1), cA + hstep, voffA);
        if (wr == 1) PG8_BAR;
        PG8_WAIT_V(4); PG8_BAR;
        PG8_STAGE(PG8_SB(1, 0), cB + kstep, voffB); PG8_STAGE(PG8_SA(1, 0), cA + kstep, voffA); PG8_STAGE(PG8_SB(1, 1), cB + hstep + kstep, voffB);
        PG8_WAIT_V(6); PG8_BAR;
    }
    for (;;) {
        const bool has_next = S.next(ui + 1, nxt);
        if constexpr (Sched::GATHER) { if (has_next) {
#pragma unroll
            for (int h = 0; h < 2; ++h)
#pragma unroll
                for (int i = 0; i < 2; ++i) voffAn[h][i] = S.a_rowoff(nxt, h * HALF + rowA[i]) + (unsigned)colA2[i]; } }
        const char* nA = has_next ? (const char*)g.A + (Sched::GATHER ? (size_t)0 : (size_t)nxt.pm * tstep) : cA; const char* nB = has_next ? S.b_base(g, nxt) + (size_t)nxt.pn * tstep : cB;
        for (int t = 0; t < nt; t += 2) {
            const bool last = (t == nt - 2);
            const char* a1 = cA + (size_t)(t + 1) * kstep;
            const char* a2 = last ? nA : cA + (size_t)(t + 2) * kstep; const char* b2 = last ? nB : cB + (size_t)(t + 2) * kstep;
            const char* a3 = a2 + kstep; const char* b3 = b2 + kstep;
            if (last && has_next) S.a_ready(nxt);
            if constexpr (SP2) {
            const bool lastn = last && has_next; (void)lastn;
            PG8_LDB(B0, 0, 0); PG8_LDB(B1, 0, 1); PG8_SCHED; PG8_LDA(At, 0, 0); PG8_STAGE_A(PG8_SA(1, 1), a1, 1, false);
            PG8_WAIT_V(8); PG8_WAIT_L(0); PG8_BAR; PG8_MMA(0, 0, At, B0); PG8_MMA(0, 1, At, B1); PG8_BAR; PG8_SCHED;
            PG8_LDA(At, 0, 1); PG8_STAGE(PG8_SB(0, 0), b2, voffB); PG8_STAGE(PG8_SB(0, 1), b2 + hstep, voffB); PG8_STAGE_A(PG8_SA(0, 0), a2, 0, lastn);
            PG8_WAIT_V(8); PG8_WAIT_L(0); PG8_BAR; PG8_MMA(1, 0, At, B0); PG8_MMA(1, 1, At, B1); PG8_BAR; PG8_SCHED;
            PG8_LDB(B0, 1, 0); PG8_LDB(B1, 1, 1); PG8_SCHED; PG8_LDA(At, 1, 0); PG8_STAGE_A(PG8_SA(0, 1), a2, 1, lastn);
            PG8_WAIT_V(8); PG8_WAIT_L(0); PG8_BAR; PG8_MMA(0, 0, At, B0); PG8_MMA(0, 1, At, B1); PG8_BAR; PG8_SCHED;
            PG8_LDA(At, 1, 1); PG8_STAGE(PG8_SB(1, 0), b3, voffB); PG8_STAGE(PG8_SB(1, 1), b3 + hstep, voffB); PG8_STAGE_A(PG8_SA(1, 0), a3, 0, lastn);
            PG8_WAIT_V(8); PG8_WAIT_L(0); PG8_BAR; PG8_MMA(1, 0, At, B0); PG8_MMA(1, 1, At, B1); PG8_BAR; PG8_SCHED;
            } else {
            PG8_LDB(B0, 0, 0); PG8_SCHED; PG8_LDA(At, 0, 0); PG8_STAGE(PG8_SA(1, 1), a1 + hstep, voffA);
            PG8_WAIT_L(8); PG8_BAR; PG8_WAIT_L(0); PG8_MMA(0, 0, At, B0); PG8_BAR; PG8_SCHED;
            PG8_LDB(B1, 0, 1); PG8_STAGE(PG8_SB(0, 0), b2, voffB);
            PG8_BAR; PG8_WAIT_L(0); PG8_MMA(0, 1, At, B1); PG8_BAR;
            PG8_LDA(At, 0, 1); PG8_STAGE(PG8_SA(0, 0), a2, voffA);
            PG8_BAR; PG8_WAIT_L(0); PG8_MMA(1, 0, At, B0); PG8_BAR; PG8_SCHED;
            PG8_STAGE(PG8_SB(0, 1), b2 + hstep, voffB);
            PG8_WAIT_V(6); PG8_BAR; PG8_MMA(1, 1, At, B1); PG8_BAR;
            PG8_LDB(B0, 1, 0); PG8_SCHED; PG8_LDA(At, 1, 0); PG8_STAGE(PG8_SA(0, 1), a2 + hstep, voffA);
            PG8_WAIT_L(8); PG8_BAR; PG8_WAIT_L(0); PG8_MMA(0, 0, At, B0); PG8_BAR; PG8_SCHED;
            PG8_LDB(B1, 1, 1); PG8_STAGE(PG8_SB(1, 0), b3, voffB);
            PG8_BAR; PG8_WAIT_L(0); PG8_MMA(0, 1, At, B1); PG8_BAR;
            PG8_LDA(At, 1, 1); PG8_STAGE(PG8_SA(1, 0), a3, voffA);
            PG8_BAR; PG8_WAIT_L(0); PG8_MMA(1, 0, At, B0); PG8_BAR; PG8_SCHED;
            PG8_STAGE(PG8_SB(1, 1), b3 + hstep, voffB);
            PG8_WAIT_V(6); PG8_BAR; PG8_MMA(1, 1, At, B1); PG8_BAR;
            }
        }
        if constexpr (ALIGN_EPI) { if (wr == 0) PG8_BAR; }
        if constexpr (!Epi::AFTER_DRAIN) { E(acc, cur, wr, wc, fr, fq); S.done(cur); }
        if (!has_next) break;
#pragma unroll
        for (int a = 0; a < 2; ++a)
#pragma unroll
            for (int b = 0; b < 2; ++b)
#pragma unroll
                for (int m = 0; m < 4; ++m)
#pragma unroll
                    for (int n = 0; n < 2; ++n) acc[a][b][m][n] = (f32x4){0.f, 0.f, 0.f, 0.f};
        cur = nxt; cA = nA; cB = nB; ++ui;
        if constexpr (Sched::GATHER) {
#pragma unroll
            for (int h = 0; h < 2; ++h)
#pragma unroll
                for (int i = 0; i < 2; ++i) voffAc[h][i] = voffAn[h][i]; }
        if constexpr (ALIGN_EPI) { if (wr == 1) PG8_BAR; }
    }
    PG8_WAIT_V(0);
    if constexpr (!ALIGN_EPI) { if (wr == 0) PG8_BAR; }
    PG8_BAR;
    if constexpr (Epi::AFTER_DRAIN) { E.fused(acc, cur, wr, wc, fr, fq, lds, wid, lane); S.done(cur); }
#undef PG8_SA
#undef PG8_SB
#undef PG8_STAGE
#undef PG8_STAGE_A
#undef PG8_LDA
#undef PG8_LDB
#undef PG8_MMA
#undef PG8_WAIT_V
#undef PG8_WAIT_L
#undef PG8_BAR
#undef PG8_SCHED
}
}

namespace pg8 {
template <bool GA> struct MoeOrder {
    static constexpr bool GATHER = GA;
    int nM, nN, nwg, G, c; const PG8_LAS int* tb; size_t es_bytes; const int* LIST; unsigned rowbytes;
    __device__ void init(int nN_, int G_, int c_, const PG8_LAS int* tb_, size_t es, const int* list_, unsigned rowbytes_) { tb = tb_; nM = tb_[32] / 256; nN = nN_; nwg = nM * nN; G = G_; c = c_; es_bytes = es; LIST = list_; rowbytes = rowbytes_; }
    __device__ bool next(int i, Unit& u) const {
        const long L = (long)i * G + c; if (L >= nwg) return false;
        int wgid = (int)L; { const int q = nwg / NXCD, r = nwg % NXCD, xcd = wgid % NXCD, off = wgid / NXCD; wgid = (xcd < r ? xcd * (q + 1) : r * (q + 1) + (xcd - r) * q) + off; }
        const int nig = WGM * nN, gid = wgid / nig, fm = gid * WGM, gsz = (nM - fm) < WGM ? (nM - fm) : WGM;
        u.pm = fm + ((wgid % nig) % gsz); u.pn = (wgid % nig) / gsz; return true;
    }
    __device__ __forceinline__ void a_ready(const Unit&) const {}
    __device__ __forceinline__ void done(const Unit&) const {}
    __device__ __forceinline__ const char* b_base(const Gemm& g, const Unit& u) const { return (const char*)g.Bt + (size_t)tb[128 + u.pm] * es_bytes; }
    __device__ __forceinline__ unsigned a_rowoff(const Unit& u, int rloc) const {
        const int e = tb[128 + u.pm], pos = u.pm * 256 + rloc - tb[e];
        const bool ok = pos < tb[64 + e]; const int tok = LIST[(size_t)e * 65536 + (ok ? pos : 0)] >> 1;
        return (unsigned)(ok ? tok : 0) * rowbytes;
    }
};
struct EpiProj {
    static constexpr bool PERM = true, AFTER_DRAIN = false;
    bf16_t* PROJ; bf16_t* HALO; const float* RSN;
    __device__ __forceinline__ void operator()(const f32x4 (&acc)[2][2][4][2], const Unit& u, int wr, int wc, int fr, int fq) const {
        const int row0 = u.pm * BM + wr * 64 + fr, col0 = u.pn * BM + wc * 32 + 8 * fq;
        float rsv[2][4];
#pragma unroll
        for (int ai = 0; ai < 2; ++ai)
#pragma unroll
            for (int m = 0; m < 4; ++m) rsv[ai][m] = RSN[row0 + ai * HALF + m * 16];
        __builtin_amdgcn_sched_barrier(0);
#pragma unroll
        for (int ai = 0; ai < 2; ++ai)
#pragma unroll
            for (int m = 0; m < 4; ++m) { const int row = row0 + ai * HALF + m * 16; bf16_t* rowp = PROJ + (size_t)row * 4352 + col0; const float rs = rsv[ai][m];
#pragma unroll
                for (int bj = 0; bj < 2; ++bj) { const f32x4 v0 = acc[ai][bj][m][0] * rs, v1 = acc[ai][bj][m][1] * rs; const int col = col0 + bj * HALF;
                    u32x4 w; w.x = cvt_pk_bf16(v0[0], v0[1]); w.y = cvt_pk_bf16(v0[2], v0[3]); w.z = cvt_pk_bf16(v1[0], v1[1]); w.w = cvt_pk_bf16(v1[2], v1[3]);
                    *(u32x4*)(rowp + bj * HALF) = w;
                    if (col >= 384 && col < 1280 && (row & 127) >= 125 && ((row >> 7) & 127) != 127)
                        *(u32x4*)(HALO + ((size_t)((row >> 7) + 1) * 3 + ((row & 127) - 125)) * 896 + (col - 384)) = w; } }
    }
};
template <bool BASE_F32, bool WITH_SSQ> struct EpiResB {
    static constexpr bool PERM = true, AFTER_DRAIN = false;
    const void* base; bf16_t* XB; float* SSQ;
    __device__ __forceinline__ void operator()(const f32x4 (&acc)[2][2][4][2], const Unit& u, int wr, int wc, int fr, int fq) const {
        const int row0 = u.pm * BM + wr * 64 + fr, col0 = u.pn * BM + wc * 32 + 8 * fq;
        static_assert(!BASE_F32, "EpiResB: bf16 base only (the base pieces of a row half are preloaded)");
#pragma unroll
        for (int ai = 0; ai < 2; ++ai) {
            u32x4 bw[4][2];
#pragma unroll
            for (int m = 0; m < 4; ++m)
#pragma unroll
                for (int bj = 0; bj < 2; ++bj) bw[m][bj] = *(const u32x4*)((const bf16_t*)base + (size_t)(row0 + ai * HALF + m * 16) * 1024 + col0 + bj * HALF);
            __builtin_amdgcn_sched_barrier(0);
#pragma unroll
            for (int m = 0; m < 4; ++m) { const int row = row0 + ai * HALF + m * 16; const size_t off = (size_t)row * 1024 + col0; float ss = 0.f;
#pragma unroll
                for (int bj = 0; bj < 2; ++bj) {
                    f32x4 x0, x1;
                    { const u32x4 w = bw[m][bj];
                        x0 = (f32x4){__uint_as_float(w.x << 16), __uint_as_float(w.x & 0xffff0000u), __uint_as_float(w.y << 16), __uint_as_float(w.y & 0xffff0000u)};
                        x1 = (f32x4){__uint_as_float(w.z << 16), __uint_as_float(w.z & 0xffff0000u), __uint_as_float(w.w << 16), __uint_as_float(w.w & 0xffff0000u)}; }
                    x0 = x0 + acc[ai][bj][m][0]; x1 = x1 + acc[ai][bj][m][1];
                    u32x4 o; o.x = cvt_pk_bf16(x0[0], x0[1]); o.y = cvt_pk_bf16(x0[2], x0[3]); o.z = cvt_pk_bf16(x1[0], x1[1]); o.w = cvt_pk_bf16(x1[2], x1[3]);
                    *(u32x4*)(XB + off + bj * HALF) = o;
                    ss += ((x0[0] * x0[0] + x0[1] * x0[1]) + (x0[2] * x0[2] + x0[3] * x0[3])) + ((x1[0] * x1[0] + x1[1] * x1[1]) + (x1[2] * x1[2] + x1[3] * x1[3])); }
                if (WITH_SSQ) { ss += __shfl_xor(ss, 16); ss += __shfl_xor(ss, 32); if (fq == 0) SSQ[(size_t)row * 16 + u.pn * 4 + wc] = ss; } }
        }
    }
};
struct EpiBf16RowScale {
    static constexpr bool PERM = true, AFTER_DRAIN = false;
    bf16_t* O; const float* SSQ;
    __device__ __forceinline__ void operator()(const f32x4 (&acc)[2][2][4][2], const Unit& u, int wr, int wc, int fr, int fq) const {
        const int row0 = u.pm * BM + wr * 64 + fr, col0 = u.pn * BM + wc * 32 + 8 * fq;
        f32x4 sq[2][4];
#pragma unroll
        for (int ai = 0; ai < 2; ++ai)
#pragma unroll
            for (int m = 0; m < 4; ++m) sq[ai][m] = *(const f32x4*)(SSQ + (size_t)(row0 + ai * HALF + m * 16) * 16 + 4 * fq);
        __builtin_amdgcn_sched_barrier(0);
#pragma unroll
        for (int ai = 0; ai < 2; ++ai)
#pragma unroll
            for (int m = 0; m < 4; ++m) { const int row = row0 + ai * HALF + m * 16;
                float tot = (sq[ai][m][0] + sq[ai][m][1]) + (sq[ai][m][2] + sq[ai][m][3]); tot += __shfl_xor(tot, 16); tot += __shfl_xor(tot, 32);
                const float rs = rsqrtf(tot * (1.f / 1024.f) + 1e-6f);
                bf16_t* rowp = O + (size_t)row * 1024 + col0;
#pragma unroll
                for (int bj = 0; bj < 2; ++bj) { const f32x4 v0 = acc[ai][bj][m][0] * rs, v1 = acc[ai][bj][m][1] * rs;
                    u32x4 w; w.x = cvt_pk_bf16(v0[0], v0[1]); w.y = cvt_pk_bf16(v0[2], v0[3]); w.z = cvt_pk_bf16(v1[0], v1[1]); w.w = cvt_pk_bf16(v1[2], v1[3]);
                    *(u32x4*)(rowp + bj * HALF) = w; } }
    }
};
struct EpiGateUp {
    static constexpr bool PERM = true, AFTER_DRAIN = false;
    bf16_t* HID; const float* RS; const int* LIST; const PG8_LAS int* tb;
    __device__ __forceinline__ void operator()(const f32x4 (&acc)[2][2][4][2], const Unit& u, int wr, int wc, int fr, int fq) const {
        const int row0 = u.pm * BM + wr * 64 + fr, hc0 = u.pn * 128 + wc * 16 + 4 * fq;
        const int e = tb[128 + u.pm], sp = tb[e], cn = tb[64 + e];
        float rsv[2][4];
#pragma unroll
        for (int ai = 0; ai < 2; ++ai)
#pragma unroll
            for (int m = 0; m < 4; ++m) { const int pos = row0 + ai * HALF + m * 16 - sp; rsv[ai][m] = ((const float*)LIST)[(size_t)e * 65536 + 32768 + (pos < cn ? pos : 0)]; }
        __builtin_amdgcn_sched_barrier(0);
#pragma unroll
        for (int ai = 0; ai < 2; ++ai)
#pragma unroll
            for (int m = 0; m < 4; ++m) { bf16_t* rowp = HID + (size_t)(row0 + ai * HALF + m * 16) * 512 + hc0; const float rs = rsv[ai][m];
#pragma unroll
                for (int bj = 0; bj < 2; ++bj) { const f32x4 g = acc[ai][bj][m][0] * rs, up = acc[ai][bj][m][1] * rs; float h[4];
#pragma unroll
                    for (int i = 0; i < 4; ++i) h[i] = g[i] * __builtin_amdgcn_rcpf(1.f + __expf(-g[i])) * up[i];
                    typedef unsigned u32x2 __attribute__((ext_vector_type(2)));
                    u32x2 w; w.x = cvt_pk_bf16(h[0], h[1]); w.y = cvt_pk_bf16(h[2], h[3]);
                    *(u32x2*)(rowp + bj * 64) = w; } }
    }
};
struct EpiDown {
    static constexpr bool PERM = true, AFTER_DRAIN = false;
    bf16_t* YB; const float* GATEL; const PG8_LAS int* tb;
    __device__ __forceinline__ void operator()(const f32x4 (&acc)[2][2][4][2], const Unit& u, int wr, int wc, int fr, int fq) const {
        const int row0 = u.pm * BM + wr * 64 + fr, col0 = u.pn * BM + wc * 32 + 8 * fq;
        const int e = tb[128 + u.pm], sp = tb[e], cn = tb[64 + e];
        float gtv[2][4], gvm[2][4];
#pragma unroll
        for (int ai = 0; ai < 2; ++ai)
#pragma unroll
            for (int m = 0; m < 4; ++m) { const int pos = row0 + ai * HALF + m * 16 - sp; gtv[ai][m] = GATEL[(size_t)e * 65536 + (pos < cn ? pos : 0)]; gvm[ai][m] = pos < cn ? 1.f : 0.f; }
        __builtin_amdgcn_sched_barrier(0);
#pragma unroll
        for (int ai = 0; ai < 2; ++ai)
#pragma unroll
            for (int m = 0; m < 4; ++m) { const int row = row0 + ai * HALF + m * 16; const float gt = gtv[ai][m] * gvm[ai][m]; bf16_t* rowp = YB + (size_t)row * 1024 + col0;
#pragma unroll
                for (int bj = 0; bj < 2; ++bj) { const f32x4 v0 = acc[ai][bj][m][0] * gt, v1 = acc[ai][bj][m][1] * gt;
                    u32x4 w; w.x = cvt_pk_bf16(v0[0], v0[1]); w.y = cvt_pk_bf16(v0[2], v0[3]); w.z = cvt_pk_bf16(v1[0], v1[1]); w.w = cvt_pk_bf16(v1[2], v1[3]);
                    *(u32x4*)(rowp + bj * HALF) = w; } }
    }
};
}

#define GAS __attribute__((address_space(1)))
#define LAS __attribute__((address_space(3)))
constexpr int NWAVES = 8, LDS_BYTES = 163840, RING_BYTES = 131072, MISC_OFF = LDS_BYTES - 256;
constexpr int CW_BAR = 4096;
constexpr size_t CTL_ZERO_BYTES = 65536;

#define XB_TMO      128
#define XB_XCNT(j)  (256  + 64 * (j))
#define XB_XSUB(j)  (1280 + 64 * (j))
#define XB_XGEN(j)  (2304 + 64 * (j))
#define XB_TOP      3328
#define XB_TOPGEN   3392
#define XCD_BAR_WORDS 3456
#define XB_SPIN_CAP (1u << 20)
__device__ __forceinline__ unsigned xb_ld(unsigned* p)              { return __hip_atomic_load(p, __ATOMIC_RELAXED, __HIP_MEMORY_SCOPE_AGENT); }
__device__ __forceinline__ unsigned xb_add(unsigned* p, unsigned v) { return __hip_atomic_fetch_add(p, v, __ATOMIC_RELAXED, __HIP_MEMORY_SCOPE_AGENT); }
__device__ __forceinline__ unsigned xb_xcc_id() { return (unsigned)__builtin_amdgcn_s_getreg((3 << 11) | 20) & 0xFu; }
#define XB_SPIN(cond, bar) do { unsigned _sp = 0; while (cond) { __builtin_amdgcn_s_sleep(1); \
    if ((++_sp & 255u) == 0u) { if (xb_ld(&(bar)[XB_TMO])) break; if (_sp > XB_SPIN_CAP) { atomicAdd(&(bar)[XB_TMO], 1u); break; } } } } while (0)
struct XcdBarrier { unsigned* bar; unsigned x; volatile LAS unsigned* st; };
__device__ __forceinline__ XcdBarrier xcd_barrier_post(unsigned* bar, volatile LAS unsigned* st) {
    XcdBarrier b; b.bar = bar; b.x = xb_xcc_id(); b.st = st;
    if (threadIdx.x == 0) (void)xb_add(&bar[XB_XCNT(b.x)], 1u);
    return b;
}
__device__ __forceinline__ void xcd_barrier_complete(unsigned* bar, unsigned x, unsigned& nloc, unsigned& nx) {
    const unsigned G = gridDim.x * gridDim.y * gridDim.z;
    unsigned sum, cnt, mine, sp = 0u;
    for (;;) {
        sum = 0u; cnt = 0u; mine = 0u;
#pragma unroll
        for (unsigned j = 0; j < 16; ++j) { const unsigned c = xb_ld(&bar[XB_XCNT(j)]); sum += c; cnt += (c > 0u) ? 1u : 0u; mine = (j == x) ? c : mine; }
        if (sum == G) break;
        __builtin_amdgcn_s_sleep(1);
        if ((++sp & 255u) == 0u) { if (xb_ld(&bar[XB_TMO])) break; if (sp > XB_SPIN_CAP) { atomicAdd(&bar[XB_TMO], 1u); break; } }
    }
    nloc = mine > 0u ? mine : 1u; nx = cnt > 0u ? cnt : 1u;
}
__device__ __forceinline__ void xcd_barrier(const XcdBarrier& b) {
    asm volatile("s_waitcnt vmcnt(0)" ::: "memory");
    __syncthreads();
    if (threadIdx.x == 0) {
        unsigned* bar = b.bar;
        __builtin_amdgcn_s_waitcnt(0);
        unsigned nloc = b.st[0], nx = b.st[1];
        if (nloc == 0u) { xcd_barrier_complete(bar, b.x, nloc, nx); b.st[0] = nloc; b.st[1] = nx; }
        const unsigned old = xb_add(&bar[XB_XSUB(b.x)], 1u);
        const unsigned gen = old / nloc;
        if (old + 1u == (gen + 1u) * nloc) {
            __builtin_amdgcn_fence(__ATOMIC_RELEASE, "agent");
            asm volatile("s_waitcnt vmcnt(0)" ::: "memory");
            const unsigned og = xb_add(&bar[XB_TOP], 1u);
            const unsigned tg = og / nx;
            if (og + 1u == (tg + 1u) * nx) xb_add(&bar[XB_TOPGEN], 1u);
            else XB_SPIN(xb_ld(&bar[XB_TOPGEN]) == tg, bar);
            __builtin_amdgcn_fence(__ATOMIC_ACQUIRE, "agent");
            xb_add(&bar[XB_XGEN(b.x)], 1u);
            asm volatile("s_waitcnt vmcnt(0)" ::: "memory");
        } else {
            XB_SPIN(xb_ld(&bar[XB_XGEN(b.x)]) == gen, bar);
            __builtin_amdgcn_fence(__ATOMIC_ACQUIRE, "agent");
            asm volatile("s_waitcnt vmcnt(0)" ::: "memory");
        }
    }
    __syncthreads();
}

enum { PH_KVGEMM = 1, PH_L0 = 2, PH_PER_LAYER = 15, PH_FINAL = 32, PH_COUNT = 33 };
enum { LP_NORM1 = 0, LP_GIN = 1, LP_QKN = 2, LP_MIX1 = 3, LP_SCAN = 4, LP_MIX2 = 5, LP_GOUT = 6, LP_NORM2 = 7, LP_GQ = 8, LP_CA = 9, LP_GO = 10, LP_ROUTER = 11, LP_GATHER = 12, LP_GGU = 13, LP_GDOWN = 14 };

struct MkArgs { const float* in[33]; float* out; unsigned char* ws; int ph_lo, ph_hi, bar_region, mask; };
constexpr size_t WS_SSQ = WS_LIST, WS_XB1 = WS_OBR;
constexpr size_t WS_HALO = 30 * MiB;
constexpr size_t WS_ACS = 524 * MiB, WS_DTS = 526 * MiB;
typedef unsigned u32x2_t __attribute__((ext_vector_type(2)));
typedef float f32x2_t __attribute__((ext_vector_type(2)));
typedef unsigned u32x4_t __attribute__((ext_vector_type(4)));
#define LDS_WAIT() asm volatile("s_waitcnt lgkmcnt(0)" ::: "memory")
#define MFMA16(a, b, c) __builtin_amdgcn_mfma_f32_16x16x32_bf16((a), (b), (c), 0, 0, 0)
__device__ __forceinline__ float wave_sum(float v) {
#pragma unroll
    for (int o = 1; o < 64; o <<= 1) v += __shfl_xor(v, o);
    return v;
}
__device__ __forceinline__ unsigned pkbf(float lo, float hi) { unsigned r; asm("v_cvt_pk_bf16_f32 %0, %1, %2" : "=v"(r) : "v"(lo), "v"(hi)); return r; }
__device__ __forceinline__ unsigned pkbf_sw(float lo, float hi) { unsigned r; asm("v_cvt_pk_bf16_f32 %0, %1, %2\n\ts_nop 1" : "=v"(r) : "v"(lo), "v"(hi)); return r; }
__device__ __forceinline__ float bflo(unsigned w) { return __uint_as_float(w << 16); }
__device__ __forceinline__ float bfhi(unsigned w) { return __uint_as_float(w & 0xffff0000u); }
__device__ __forceinline__ float fsilu(float x) { return x * __builtin_amdgcn_rcpf(1.f + __expf(-x)); }
__device__ __forceinline__ float fsigm(float x) { return __builtin_amdgcn_rcpf(1.f + __expf(-x)); }

struct CJob { const float* src; const float* src2; const float* scale; bf16_t* dst; int K, N, ld, mode, nz; size_t src_es, dst_es; };
__device__ __forceinline__ void cvt_item(const CJob& j, LAS float* scr, int item, int lane) {
    const int nblk = j.N / 32, per_e = (j.K / 64) * nblk, e = item / per_e, it = item % per_e, kb = it / nblk, nb = it % nblk, k0 = 64 * kb, n0 = 32 * nb;
    if (j.mode == 1) {
        const int nl = lane & 31, col = n0 + nl + (n0 >= 1280 ? 6 : 0);
        const float* base = j.src;
        float vv[32], sv[32];
#pragma unroll
        for (int i = 0; i < 32; ++i) vv[i] = base[(size_t)(k0 + 2 * i + (lane >> 5)) * j.ld + col];
        if (j.scale) {
#pragma unroll
            for (int i = 0; i < 32; ++i) sv[i] = j.scale[k0 + 2 * i + (lane >> 5)];
        } else {
#pragma unroll
            for (int i = 0; i < 32; ++i) sv[i] = 1.f;
        }
#pragma unroll
        for (int i = 0; i < 32; ++i) scr[(2 * i + (lane >> 5)) * 33 + nl] = vv[i] * sv[i];
    } else {
        const int c4 = lane & 7, rsub = lane >> 3;
        const float* base; int col, nl;
        if (j.mode == 0) { base = j.src + (size_t)e * j.src_es; col = n0 + 4 * c4; nl = 4 * c4; }
        else { base = (c4 < 4 ? j.src : j.src2) + (size_t)e * j.src_es; col = (n0 >> 1) + 4 * (c4 & 3); nl = 8 * (c4 & 3) + (c4 >= 4 ? 4 : 0); }
        f32x4 v[8]; float scv[8];
#pragma unroll
        for (int i = 0; i < 8; ++i) v[i] = *(const f32x4*)(base + (size_t)(k0 + 8 * i + rsub) * j.ld + col);
        if (j.scale) {
#pragma unroll
            for (int i = 0; i < 8; ++i) scv[i] = j.scale[k0 + 8 * i + rsub];
        } else {
#pragma unroll
            for (int i = 0; i < 8; ++i) scv[i] = 1.f;
        }
#pragma unroll
        for (int i = 0; i < 8; ++i) { const int kk = 8 * i + rsub; const float sc = scv[i]; LAS float* d = scr + kk * 33 + nl;
            d[0] = v[i].x * sc; d[1] = v[i].y * sc; d[2] = v[i].z * sc; d[3] = v[i].w * sc; }
    }
    LDS_WAIT(); asm volatile("" ::: "memory");
    const int c = lane & 7;
    bf16_t* d = j.dst + (size_t)e * j.dst_es;
#pragma unroll
    for (int q = 0; q < 4; ++q) { const int n = (lane >> 3) + 8 * q; const LAS float* sp = scr + (8 * c) * 33 + n;
        u32x4_t o; o.x = pkbf(sp[0 * 33], sp[1 * 33]); o.y = pkbf(sp[2 * 33], sp[3 * 33]); o.z = pkbf(sp[4 * 33], sp[5 * 33]); o.w = pkbf(sp[6 * 33], sp[7 * 33]);
        *(u32x4_t*)(d + (size_t)(n0 + n) * j.K + k0 + 8 * c) = o; }
    LDS_WAIT(); asm volatile("" ::: "memory");
}
__device__ __forceinline__ void cvt_job(const CJob& j, LAS unsigned char* lds, int wave, int lane, int gw, int NGW, int& rot) {
    LAS float* scr = (LAS float*)(lds + wave * 16384);
    const int nitems = (j.K / 64) * (j.N / 32) * j.nz;
    int first = gw - (rot % NGW); if (first < 0) first += NGW;
    for (int it = first; it < nitems; it += NGW) cvt_item(j, scr, it, lane);
    rot += nitems;
}
__device__ __forceinline__ void cvt_layer_small(const MkArgs& args, int l, LAS unsigned char* lds, int wave, int lane, int gw, int NGW, int rot = 0) {
    { CJob j{args.in[3] + (size_t)l * DM * NIN, nullptr, args.in[2] + l * DM, (bf16_t*)(args.ws + WS_WIN), DM, NP, NIN, 1, 1, 0, 0}; cvt_job(j, lds, wave, lane, gw, NGW, rot); }
    { CJob j{args.in[17] + (size_t)l * 1536 * DM, nullptr, nullptr, (bf16_t*)(args.ws + WS_WOUT), 1536, DM, DM, 0, 1, 0, 0}; cvt_job(j, lds, wave, lane, gw, NGW, rot); }
    { CJob j{args.in[20] + (size_t)l * DM * DM, nullptr, args.in[18] + l * DM, (bf16_t*)(args.ws + WS_WQ), DM, DM, DM, 0, 1, 0, 0}; cvt_job(j, lds, wave, lane, gw, NGW, rot); }
    { CJob j{args.in[24] + (size_t)l * DM * DM, nullptr, nullptr, (bf16_t*)(args.ws + WS_WO), DM, DM, DM, 0, 1, 0, 0}; cvt_job(j, lds, wave, lane, gw, NGW, rot); }
}
__device__ __forceinline__ void cvt_layer_experts(const MkArgs& args, int l, LAS unsigned char* lds, int wave, int lane, int gw, int NGW) {
    int rot = 0;
    { CJob j{args.in[30] + (size_t)l * 32 * DM * 512, args.in[31] + (size_t)l * 32 * DM * 512, args.in[25] + l * DM, (bf16_t*)(args.ws + WS_WGU), DM, 1024, 512, 2, 32, (size_t)DM * 512, (size_t)1024 * DM}; cvt_job(j, lds, wave, lane, gw, NGW, rot); }
    { CJob j{args.in[32] + (size_t)l * 32 * 512 * DM, nullptr, nullptr, (bf16_t*)(args.ws + WS_WD), 512, DM, DM, 0, 32, (size_t)512 * DM, (size_t)DM * 512}; cvt_job(j, lds, wave, lane, gw, NGW, rot); }
}
__device__ __forceinline__ void ph_pro0(const MkArgs& args, LAS unsigned char* lds, int wave, int lane, int gw, int NGW) {
    int rot = 0;
    for (int l = 0; l < 2; ++l) { CJob j{args.in[21] + (size_t)l * DM * 2048, nullptr, args.in[19] + l * DM, (bf16_t*)(args.ws + WS_WKV) + (size_t)l * 2048 * DM, DM, 2048, 2048, 0, 1, 0, 0}; cvt_job(j, lds, wave, lane, gw, NGW, rot); }
    cvt_layer_small(args, 0, lds, wave, lane, gw, NGW, rot);
    const float* mem = args.in[1]; bf16_t* MEMN = (bf16_t*)(args.ws + WS_MEMN);
    for (int m = gw; m < BATCH * MEML; m += NGW) {
        f32x4 v[4]; float ss = 0.f;
#pragma unroll
        for (int j = 0; j < 4; ++j) { v[j] = *(const f32x4*)(mem + (size_t)m * DM + 4 * lane + 256 * j); ss += v[j].x * v[j].x + v[j].y * v[j].y + v[j].z * v[j].z + v[j].w * v[j].w; }
        const float rs = rsqrtf(wave_sum(ss) * (1.f / DM) + 1e-6f);
#pragma unroll
        for (int j = 0; j < 4; ++j) { u32x2_t o; o.x = pkbf(v[j].x * rs, v[j].y * rs); o.y = pkbf(v[j].z * rs, v[j].w * rs); *(u32x2_t*)(MEMN + (size_t)m * DM + 4 * lane + 256 * j) = o; }
    }
}
__device__ __forceinline__ void ph_knorm(const MkArgs& args, int lane, int gw, int NGW) {
    bf16_t* KV = (bf16_t*)(args.ws + WS_KV); const float* kn = args.in[23];
    for (int s = gw; s < 512 * 8; s += NGW) {
        const int h = s & 3, l = (s >> 2) & 1, m = s >> 3;
        u32x2_t* p = (u32x2_t*)(KV + (size_t)m * 4096 + l * 2048 + h * 256 + 4 * lane);
        const u32x2_t w = *p; const float a = bflo(w.x), b = bfhi(w.x), c = bflo(w.y), d = bfhi(w.y);
        const float rs = rsqrtf(wave_sum(a * a + b * b + c * c + d * d) * (1.f / 256.f) + 1e-6f);
        const f32x4 g = *(const f32x4*)(kn + l * 256 + 4 * lane);
        u32x2_t o; o.x = pkbf(a * rs * g.x, b * rs * g.y); o.y = pkbf(c * rs * g.z, d * rs * g.w); *p = o;
    }
}
template <int l> __device__ __forceinline__ void ph_norm1(const MkArgs& args, const LAS int* tb, LAS unsigned char* lds, int tid, int lane, int gw, int NGW) {
    constexpr int R = (l == 0) ? 4 : 2;
    const float* g = args.in[2] + l * DM; const float* w_in = args.in[3] + (size_t)l * DM * NIN;
    LAS float* wdt = (LAS float*)(lds + 135168);
    for (int k = tid; k < DM; k += NWAVES * 64) { const float gk = g[k];
#pragma unroll
        for (int q = 0; q < 6; ++q) wdt[q * DM + k] = gk * w_in[(size_t)k * NIN + 1280 + q]; }
    __syncthreads();
    bf16_t* Xres = (bf16_t*)args.out; bf16_t* XN = (bf16_t*)(args.ws + WS_XN); const bf16_t* YB = (const bf16_t*)(args.ws + WS_YB);
    const int* TOKDEST = (const int*)(args.ws + WS_TOKDEST); float* DT = (float*)(args.ws + WS_DT);
    float* RSN = (float*)(args.ws + WS_GATEBUF) + 65536;
    int qn[R][2];
#pragma unroll
    for (int r = 0; r < R; ++r) { qn[r][0] = 0; qn[r][1] = 0; if (l != 0 && gw * R < T) { qn[r][0] = TOKDEST[2 * (gw * R + r)]; qn[r][1] = TOKDEST[2 * (gw * R + r) + 1]; } }
    for (int t0 = gw * R; t0 < T; t0 += NGW * R) {
        f32x4 v[R][4];
        if (l == 0) {
#pragma unroll
            for (int r = 0; r < R; ++r)
#pragma unroll
                for (int j = 0; j < 4; ++j) v[r][j] = *(const f32x4*)(args.in[0] + (size_t)(t0 + r) * DM + 4 * lane + 256 * j);
        } else {
            int d0[R], d1[R];
#pragma unroll
            for (int r = 0; r < R; ++r) { const int q0 = qn[r][0], q1 = qn[r][1]; d0[r] = tb[q0 >> 16] + (q0 & 0xffff); d1[r] = tb[q1 >> 16] + (q1 & 0xffff); }
            if (t0 + NGW * R < T) {
#pragma unroll
                for (int r = 0; r < R; ++r) { qn[r][0] = TOKDEST[2 * (t0 + NGW * R + r)]; qn[r][1] = TOKDEST[2 * (t0 + NGW * R + r) + 1]; } }
            u32x2_t y0[R][4], y1[R][4], xb[R][4];
#pragma unroll
            for (int r = 0; r < R; ++r)
#pragma unroll
                for (int j = 0; j < 4; ++j) { xb[r][j] = *(const u32x2_t*)(XN + (size_t)(t0 + r) * DM + 4 * lane + 256 * j);
                    y0[r][j] = *(const u32x2_t*)(YB + (size_t)d0[r] * DM + 4 * lane + 256 * j); y1[r][j] = *(const u32x2_t*)(YB + (size_t)d1[r] * DM + 4 * lane + 256 * j); }
#pragma unroll
            for (int r = 0; r < R; ++r)
#pragma unroll
                for (int j = 0; j < 4; ++j) {
                    v[r][j].x = bflo(xb[r][j].x) + bflo(y0[r][j].x) + bflo(y1[r][j].x); v[r][j].y = bfhi(xb[r][j].x) + bfhi(y0[r][j].x) + bfhi(y1[r][j].x);
                    v[r][j].z = bflo(xb[r][j].y) + bflo(y0[r][j].y) + bflo(y1[r][j].y); v[r][j].w = bfhi(xb[r][j].y) + bfhi(y0[r][j].y) + bfhi(y1[r][j].y);
                }
        }
#pragma unroll
        for (int r = 0; r < R; ++r) {
            float ss = 0.f; float p[6] = {0.f, 0.f, 0.f, 0.f, 0.f, 0.f};
#pragma unroll
            for (int j = 0; j < 4; ++j) {
                u32x2_t o; o.x = pkbf(v[r][j].x, v[r][j].y); o.y = pkbf(v[r][j].z, v[r][j].w);
                *(u32x2_t*)(Xres + (size_t)(t0 + r) * DM + 4 * lane + 256 * j) = o;
                const float a0 = bflo(o.x), a1 = bfhi(o.x), a2 = bflo(o.y), a3 = bfhi(o.y);
                ss += a0 * a0 + a1 * a1 + a2 * a2 + a3 * a3;
#pragma unroll
                for (int q = 0; q < 6; ++q) { const f32x4 w = *(const LAS f32x4*)(wdt + q * DM + 4 * lane + 256 * j); p[q] += a0 * w.x + a1 * w.y + a2 * w.z + a3 * w.w; }
            }
            const float rs = rsqrtf(wave_sum(ss) * (1.f / DM) + 1e-6f);
#pragma unroll
            for (int q = 0; q < 6; ++q) p[q] = wave_sum(p[q]) * rs;
            if (lane == 0) { *(f32x4*)(DT + (size_t)(t0 + r) * 8) = (f32x4){p[0], p[1], p[2], p[3]}; *(float2*)(DT + (size_t)(t0 + r) * 8 + 4) = make_float2(p[4], p[5]); RSN[t0 + r] = rs; }
        }
    }
}
template <int l> __device__ __forceinline__ void ph_router(const MkArgs& args, LAS unsigned char* lds, int tid, int lane, int gw, int NGW) {
    constexpr int RSW = 2064;
    LAS unsigned char* Wh = lds; LAS unsigned char* Wl = lds + 36 * RSW;
    const float* g = args.in[25] + l * DM; const float* wg = args.in[26] + (size_t)l * DM * 4; const float* we = args.in[28] + (size_t)l * DM * 32;
    for (int k = tid; k < DM; k += NWAVES * 64) {
        const float gk = g[k];
        float wv[36];
        { const f32x4 a = *(const f32x4*)(wg + (size_t)k * 4); wv[0] = a.x; wv[1] = a.y; wv[2] = a.z; wv[3] = a.w; }
#pragma unroll
        for (int q = 0; q < 8; ++q) { const f32x4 e4 = *(const f32x4*)(we + (size_t)k * 32 + 4 * q); wv[4 + 4 * q] = e4.x; wv[5 + 4 * q] = e4.y; wv[6 + 4 * q] = e4.z; wv[7 + 4 * q] = e4.w; }
#pragma unroll
        for (int c = 0; c < 36; ++c) { const float v = gk * wv[c]; const bf16_t hi = f2bf(v); *(LAS bf16_t*)(Wh + c * RSW + 2 * k) = hi; *(LAS bf16_t*)(Wl + c * RSW + 2 * k) = f2bf(v - bf2f(hi)); }
    }
    __syncthreads();
    const float* bg = args.in[27] + l * 4; const float* be = args.in[29] + l * 32;
    const bf16_t* X = (const bf16_t*)(args.ws + WS_XN); float* RSb = (float*)(args.ws + WS_GATEBUF);
    int* CNT = (int*)(args.ws + WS_CTL) + l * CW_LAYER + CW_CNT; int* LIST = (int*)(args.ws + WS_LIST); float* GATEL = (float*)(args.ws + WS_GATEL); int* TOKPOS = (int*)(args.ws + WS_TOKDEST);
    const int qi = lane & 15, kq = lane >> 4;
    float biasv[3][4];
#pragma unroll
    for (int nt = 0; nt < 3; ++nt)
#pragma unroll
        for (int r = 0; r < 4; ++r) { const int n = 16 * nt + 4 * kq + r; biasv[nt][r] = n < 4 ? bg[n] : (n < 36 ? be[n - 4] : 0.f); }
    int wrow[3];
#pragma unroll
    for (int nt = 0; nt < 3; ++nt) { const int n = 16 * nt + qi; wrow[nt] = (n < 36 ? n : 35) * RSW + 16 * kq; }
    LAS int* lcnt = (LAS int*)(lds + 2 * 36 * RSW); LAS int* lbase = lcnt + 32;
    if (tid < 32) lcnt[tid] = 0;
    __syncthreads();
    for (int tile0 = 0; tile0 < T / 16; tile0 += NGW) {
        const int tile = tile0 + gw; const bool valid = tile < T / 16;
        const size_t t0 = (size_t)(valid ? tile : 0) * 16;
        const bf16_t* xr = X + (t0 + qi) * DM + 8 * kq;
        f32x4 acc[3]; acc[0] = (f32x4){0.f, 0.f, 0.f, 0.f}; acc[1] = acc[0]; acc[2] = acc[0];
        float ss = 0.f;
        u32x4_t xwv[32];
#pragma unroll
        for (int ks = 0; ks < 32; ++ks) xwv[ks] = *(const u32x4_t*)(xr + 32 * ks);
#pragma unroll
        for (int ks = 0; ks < 32; ++ks) {
            const u32x4_t xw = xwv[ks];
            { const float a0 = bflo(xw.x), a1 = bfhi(xw.x), a2 = bflo(xw.y), a3 = bfhi(xw.y), a4 = bflo(xw.z), a5 = bfhi(xw.z), a6 = bflo(xw.w), a7 = bfhi(xw.w);
              ss += a0 * a0 + a1 * a1 + a2 * a2 + a3 * a3 + a4 * a4 + a5 * a5 + a6 * a6 + a7 * a7; }
            const bf16x8 bh = __builtin_bit_cast(bf16x8, xw);
#pragma unroll
            for (int nt = 0; nt < 3; ++nt) {
                const bf16x8 wh = *(const LAS bf16x8*)(Wh + wrow[nt] + 64 * ks), wl = *(const LAS bf16x8*)(Wl + wrow[nt] + 64 * ks);
                acc[nt] = MFMA16(wh, bh, acc[nt]); acc[nt] = MFMA16(wl, bh, acc[nt]);
            }
        }
        ss += __shfl_xor(ss, 16); ss += __shfl_xor(ss, 32);
        const float rs = rsqrtf(ss * (1.f / DM) + 1e-6f);
#pragma unroll
        for (int nt = 0; nt < 3; ++nt)
#pragma unroll
            for (int r = 0; r < 4; ++r) acc[nt][r] = acc[nt][r] * rs + biasv[nt][r];
        float lgp[4];
#pragma unroll
        for (int r = 0; r < 4; ++r) lgp[r] = __shfl(acc[0][r], qi);
        int gi = 0; float gmx = lgp[0];
#pragma unroll
        for (int i = 1; i < 4; ++i) if (lgp[i] > gmx) { gmx = lgp[i]; gi = i; }
        float den = 0.f;
#pragma unroll
        for (int i = 0; i < 4; ++i) den += __expf(lgp[i] - gmx);
        const float gp = 1.f / den;
        const int cA = 1 + 2 * gi, cB = 2 + 2 * gi, srcA = qi + 16 * (cA & 3), srcB = qi + 16 * (cB & 3), tA = cA >> 2, tB = cB >> 2;
        float le[8];
#pragma unroll
        for (int r = 0; r < 4; ++r) {
            const float a0 = __shfl(acc[0][r], srcA), a1 = __shfl(acc[1][r], srcA);
            le[r] = tA == 0 ? a0 : a1;
            const float b0 = __shfl(acc[0][r], srcB), b1 = __shfl(acc[1][r], srcB), b2 = __shfl(acc[2][r], srcB);
            le[4 + r] = tB == 0 ? b0 : (tB == 1 ? b1 : b2);
        }
        int i1 = 0; float m1 = le[0];
#pragma unroll
        for (int i = 1; i < 8; ++i) if (le[i] > m1) { m1 = le[i]; i1 = i; }
        int i2 = -1; float m2 = -INFINITY;
#pragma unroll
        for (int i = 0; i < 8; ++i) if (i != i1 && le[i] > m2) { m2 = le[i]; i2 = i; }
        if (i2 < 0) i2 = i1 == 0 ? 1 : 0;
        const float rr = __expf(m2 - m1);
        const int e1 = gi * 8 + i1, e2 = gi * 8 + i2, tk = (int)(t0 + qi);
        int r1 = 0, r2 = 0;
        if (kq == 0 && valid) { r1 = atomicAdd((int*)&lcnt[e1], 1); r2 = atomicAdd((int*)&lcnt[e2], 1); }
        __syncthreads();
        if (tid < 32) { const int c = lcnt[tid]; lbase[tid] = c ? atomicAdd(&CNT[tid * CW_CNT_STRIDE], c) : 0; lcnt[tid] = 0; }
        __syncthreads();
        if (kq == 0 && valid) {
            const int p1 = lbase[e1] + r1, p2 = lbase[e2] + r2;
            LIST[(size_t)e1 * LISTCAP + p1] = tk * 2; GATEL[(size_t)e1 * LISTCAP + p1] = gp / (1.f + rr);
            LIST[(size_t)e2 * LISTCAP + p2] = tk * 2 + 1; GATEL[(size_t)e2 * LISTCAP + p2] = gp * rr / (1.f + rr);
            TOKPOS[tk * 2] = (e1 << 16) | p1; TOKPOS[tk * 2 + 1] = (e2 << 16) | p2;
            ((float*)LIST)[(size_t)e1 * LISTCAP + 32768 + p1] = rs; ((float*)LIST)[(size_t)e2 * LISTCAP + 32768 + p2] = rs;
        }
        if (!valid) continue;
        if (kq == 0) RSb[t0 + qi] = rs;
    }
}
constexpr int MOE_TB_OFF = RING_BYTES;
__device__ __forceinline__ LAS int* moe_tables(const MkArgs& args, int l, LAS unsigned char* lds, int tid) {
    LAS int* tb = (LAS int*)(lds + MOE_TB_OFF);
    const int* CTLl = (const int*)(args.ws + WS_CTL) + l * CW_LAYER;
    __syncthreads();
    if (tid < 64) {
        const int cnt = tid < 32 ? CTLl[CW_CNT + tid * CW_CNT_STRIDE] : 0, nt = (cnt + 255) / 256;
        int incl = nt;
#pragma unroll
        for (int d = 1; d < 32; d <<= 1) { const int v = __shfl_up(incl, d); if (tid >= d) incl += v; }
        const int first = incl - nt;
        if (tid < 32) { tb[64 + tid] = cnt; tb[tid] = first * 256; for (int t = 0; t < nt; ++t) tb[128 + first + t] = tid; }
        if (tid == 31) tb[32] = incl * 256;
    }
    __syncthreads();
    return tb;
}
__device__ __forceinline__ void ph_final(const MkArgs& args, const LAS int* tb, int lane, int gw, int NGW) {
    float* OUT = args.out; const bf16_t* X2 = (const bf16_t*)(args.ws + WS_XN); const bf16_t* YB = (const bf16_t*)(args.ws + WS_YB); const int* TOKDEST = (const int*)(args.ws + WS_TOKDEST);
    int qn[2][2] = {{0, 0}, {0, 0}};
    if (gw * 2 < T) {
#pragma unroll
        for (int r = 0; r < 2; ++r) { qn[r][0] = TOKDEST[2 * (gw * 2 + r)]; qn[r][1] = TOKDEST[2 * (gw * 2 + r) + 1]; } }
    for (int t0 = gw * 2; t0 < T; t0 += NGW * 2) {
        int d0[2], d1[2];
#pragma unroll
        for (int r = 0; r < 2; ++r) { const int q0 = qn[r][0], q1 = qn[r][1]; d0[r] = tb[q0 >> 16] + (q0 & 0xffff); d1[r] = tb[q1 >> 16] + (q1 & 0xffff); }
        if (t0 + NGW * 2 < T) {
#pragma unroll
            for (int r = 0; r < 2; ++r) { qn[r][0] = TOKDEST[2 * (t0 + NGW * 2 + r)]; qn[r][1] = TOKDEST[2 * (t0 + NGW * 2 + r) + 1]; } }
        u32x2_t xb[2][4], y0[2][4], y1[2][4];
#pragma unroll
        for (int r = 0; r < 2; ++r)
#pragma unroll
            for (int j = 0; j < 4; ++j) { xb[r][j] = *(const u32x2_t*)(X2 + (size_t)(t0 + r) * DM + 4 * lane + 256 * j);
                y0[r][j] = *(const u32x2_t*)(YB + (size_t)d0[r] * DM + 4 * lane + 256 * j); y1[r][j] = *(const u32x2_t*)(YB + (size_t)d1[r] * DM + 4 * lane + 256 * j); }
#pragma unroll
        for (int r = 0; r < 2; ++r)
#pragma unroll
            for (int j = 0; j < 4; ++j) { f32x4 x;
                x.x = bflo(xb[r][j].x) + bflo(y0[r][j].x) + bflo(y1[r][j].x); x.y = bfhi(xb[r][j].x) + bfhi(y0[r][j].x) + bfhi(y1[r][j].x);
                x.z = bflo(xb[r][j].y) + bflo(y0[r][j].y) + bflo(y1[r][j].y); x.w = bfhi(xb[r][j].y) + bfhi(y0[r][j].y) + bfhi(y1[r][j].y);
                *(f32x4*)(OUT + (size_t)(t0 + r) * DM + 4 * lane + 256 * j) = x; }
    }
}
__device__ __forceinline__ void ph_attn_comb(const MkArgs& args, int lane, int gw, int NGW) {
    const bf16_t* OBR = (const bf16_t*)(args.ws + WS_OBR); const float* LSE = (const float*)(args.ws + WS_LSE); bf16_t* CAT = (bf16_t*)(args.ws + WS_CAT);
    constexpr int R = 4;
    for (int t0 = gw * R; t0 < T; t0 += NGW * R) {
        if (lane < 48) {
            const int h = lane >> 3;
            float lv[R][3]; u32x4_t av[R][3];
#pragma unroll
            for (int r = 0; r < R; ++r)
#pragma unroll
                for (int br = 0; br < 3; ++br) { lv[r][br] = LSE[((size_t)br * T + t0 + r) * 6 + h]; av[r][br] = *(const u32x4_t*)(OBR + ((size_t)br * T + t0 + r) * 384 + 8 * lane); }
#pragma unroll
            for (int r = 0; r < R; ++r) {
                const float l0 = lv[r][0], l1 = lv[r][1], l2 = lv[r][2];
                const float mx = fmaxf(l0, fmaxf(l1, l2));
                float w0 = __expf(l0 - mx), w1 = __expf(l1 - mx), w2 = __expf(l2 - mx); const float inv = __builtin_amdgcn_rcpf(w0 + w1 + w2); w0 *= inv; w1 *= inv; w2 *= inv;
                const u32x4_t a = av[r][0], b = av[r][1], c = av[r][2];
                u32x4_t o;
                o.x = pkbf(w0 * bflo(a.x) + w1 * bflo(b.x) + w2 * bflo(c.x), w0 * bfhi(a.x) + w1 * bfhi(b.x) + w2 * bfhi(c.x));
                o.y = pkbf(w0 * bflo(a.y) + w1 * bflo(b.y) + w2 * bflo(c.y), w0 * bfhi(a.y) + w1 * bfhi(b.y) + w2 * bfhi(c.y));
                o.z = pkbf(w0 * bflo(a.z) + w1 * bflo(b.z) + w2 * bflo(c.z), w0 * bfhi(a.z) + w1 * bfhi(b.z) + w2 * bfhi(c.z));
                o.w = pkbf(w0 * bflo(a.w) + w1 * bflo(b.w) + w2 * bflo(c.w), w0 * bfhi(a.w) + w1 * bfhi(b.w) + w2 * bfhi(c.w));
                *(u32x4_t*)(CAT + (size_t)(t0 + r) * 1536 + 768 + 8 * lane) = o;
            }
        }
    }
}
template <int l> __device__ __forceinline__ void ph_cf(const MkArgs& args, LAS unsigned char* lds, int tid, int wave, int lane) {
    const bf16_t* PROJ = (const bf16_t*)(args.ws + WS_PROJ); bf16_t* CAT = (bf16_t*)(args.ws + WS_CAT);
    const float* cw = args.in[13] + l * 31 * 384; const float* cb = args.in[14] + l * 384; const float* lng = args.in[15] + l * 384; const float* lnb = args.in[16] + l * 384;
    const float* scw = args.in[10] + l * 3 * 384;
    LAS float* cwl = (LAS float*)lds;
    LAS bf16_t* gt = (LAS bf16_t*)(lds + 31 * 384 * 4);
    {
        f32x4 cwv[6];
#pragma unroll
        for (int k = 0; k < 6; ++k) { const int i = tid + NWAVES * 64 * k; cwv[k] = (f32x4){0.f, 0.f, 0.f, 0.f}; if (i < 31 * 384 / 4) cwv[k] = ((const f32x4*)cw)[i]; }
#pragma unroll
        for (int k = 0; k < 6; ++k) { const int i = tid + NWAVES * 64 * k; if (i < 31 * 384 / 4) ((LAS f32x4*)cwl)[i] = cwv[k]; }
    }
    LAS float* prm = (LAS float*)(lds + 31 * 384 * 4 + 94 * 384 * 2);
    for (int i = tid; i < 384; i += NWAVES * 64) { prm[i] = cb[i]; prm[384 + i] = lng[i]; prm[768 + i] = lnb[i]; }
    for (int u = blockIdx.x; u < T / 64; u += gridDim.x) {
        const int b = u / (SEQ / 64), t0 = (u % (SEQ / 64)) * 64;
        __syncthreads();
        {
            constexpr int hb = 0;
            u32x4_t av[9], gv[9];
#pragma unroll
            for (int i = 0; i < 9; ++i) { const int idx = tid + NWAVES * 64 * i, idc = idx < 94 * 48 ? idx : 94 * 48 - 1, rr = idc / 48, cg = idc - 48 * rr, tq = t0 - 30 + rr;
                const bf16_t* pr = PROJ + (size_t)(b * SEQ + (tq >= 0 ? tq : 0)) * NP; av[i] = *(const u32x4_t*)(pr + PC_CFA + 8 * cg); gv[i] = *(const u32x4_t*)(pr + PC_CFG + 8 * cg);
                if (tq < 0) { av[i] = (u32x4_t){0u, 0u, 0u, 0u}; gv[i] = av[i]; } }
#pragma unroll
            for (int i = 0; i < 9; ++i) { const int idx = tid + NWAVES * 64 * (hb + i), rr = idx / 48, cg = idx % 48;
                if (idx < 94 * 48) { const u32x4_t a = av[i], gg = gv[i]; u32x4_t o;
                    o.x = pkbf(bflo(a.x) * fsigm(bflo(gg.x)), bfhi(a.x) * fsigm(bfhi(gg.x))); o.y = pkbf(bflo(a.y) * fsigm(bflo(gg.y)), bfhi(a.y) * fsigm(bfhi(gg.y)));
                    o.z = pkbf(bflo(a.z) * fsigm(bflo(gg.z)), bfhi(a.z) * fsigm(bfhi(gg.z))); o.w = pkbf(bflo(a.w) * fsigm(bflo(gg.w)), bfhi(a.w) * fsigm(bfhi(gg.w)));
                    *(LAS u32x4_t*)(gt + rr * 384 + 8 * cg) = o; } }
        }
        __syncthreads();
        float uo[8][6];
#pragma unroll
        for (int tt = 0; tt < 8; ++tt)
#pragma unroll
            for (int j = 0; j < 6; ++j) uo[tt][j] = 0.f;
#pragma unroll 1
        for (int i = 0; i < 6; ++i) {
            const int c = lane + 64 * i; const float cbi = prm[c];
            float gwv[38], u8[8];
#pragma unroll
            for (int r = 0; r < 38; ++r) gwv[r] = bf2f(gt[(wave * 8 + r) * 384 + c]);
#pragma unroll
            for (int tt = 0; tt < 8; ++tt) u8[tt] = 0.f;
#pragma unroll
            for (int k = 0; k < 31; ++k) { const float wk = cwl[k * 384 + c];
#pragma unroll
                for (int tt = 0; tt < 8; ++tt) u8[tt] += wk * gwv[tt + k]; }
#pragma unroll
            for (int tt = 0; tt < 8; ++tt)
#pragma unroll
                for (int j = 0; j < 6; ++j) uo[tt][j] = (i == j) ? u8[tt] + cbi : uo[tt][j];
        }
#pragma unroll
        for (int tt = 0; tt < 8; ++tt) {
            float s1 = 0.f;
#pragma unroll
            for (int i = 0; i < 6; ++i) s1 += uo[tt][i];
            const float mean = wave_sum(s1) * (1.f / 384.f);
            float q = 0.f;
#pragma unroll
            for (int i = 0; i < 6; ++i) { const float d = uo[tt][i] - mean; q += d * d; }
            const float rstd = rsqrtf(wave_sum(q) * (1.f / 384.f) + 1e-5f);
            bf16_t* orow = CAT + (size_t)(b * SEQ + t0 + wave * 8 + tt) * 1536 + 1152;
#pragma unroll
            for (int i = 0; i < 6; ++i) orow[lane + 64 * i] = f2bf(fsilu((uo[tt][i] - mean) * rstd * prm[384 + lane + 64 * i] + prm[768 + lane + 64 * i]));
        }
        if (lane < 48) {
            float wk[3][8];
#pragma unroll
            for (int i = 0; i < 8; ++i) { wk[0][i] = scw[0 * 384 + 8 * lane + i]; wk[1][i] = scw[1 * 384 + 8 * lane + i]; wk[2][i] = scw[2 * 384 + 8 * lane + i]; }
            const int tp0 = t0 + wave * 8; const size_t rowb = (size_t)b * SEQ + tp0;
#pragma unroll 1
            for (int hf = 0; hf < 2; ++hf) {
                const size_t rb = rowb + 4 * hf; const int tp = tp0 + 4 * hf;
                u32x4_t c4[6], h4[6], b4[4];
#pragma unroll
                for (int r = 0; r < 6; ++r) { c4[r] = (u32x4_t){0u, 0u, 0u, 0u}; h4[r] = c4[r];
                    if (tp - 2 + r >= 0) { const bf16_t* pr = PROJ + (rb - 2 + r) * NP; c4[r] = *(const u32x4_t*)(pr + PC_SCC + 8 * lane); h4[r] = *(const u32x4_t*)(pr + PC_SCH + 8 * lane); } }
#pragma unroll
                for (int tt = 0; tt < 4; ++tt) b4[tt] = *(const u32x4_t*)(PROJ + (rb + tt) * NP + PC_SCB + 8 * lane);
                float pr_[6][8];
#pragma unroll
                for (int r = 0; r < 6; ++r) { pr_[r][0] = bflo(c4[r].x) * bflo(h4[r].x); pr_[r][1] = bfhi(c4[r].x) * bfhi(h4[r].x); pr_[r][2] = bflo(c4[r].y) * bflo(h4[r].y); pr_[r][3] = bfhi(c4[r].y) * bfhi(h4[r].y);
                    pr_[r][4] = bflo(c4[r].z) * bflo(h4[r].z); pr_[r][5] = bfhi(c4[r].z) * bfhi(h4[r].z); pr_[r][6] = bflo(c4[r].w) * bflo(h4[r].w); pr_[r][7] = bfhi(c4[r].w) * bfhi(h4[r].w); }
#pragma unroll
                for (int tt = 0; tt < 4; ++tt) {
                    float acc[8];
#pragma unroll
                    for (int i = 0; i < 8; ++i) acc[i] = wk[0][i] * pr_[tt][i] + wk[1][i] * pr_[tt + 1][i] + wk[2][i] * pr_[tt + 2][i];
                    u32x4_t o; o.x = pkbf(bflo(b4[tt].x) * acc[0], bfhi(b4[tt].x) * acc[1]); o.y = pkbf(bflo(b4[tt].y) * acc[2], bfhi(b4[tt].y) * acc[3]);
                    o.z = pkbf(bflo(b4[tt].z) * acc[4], bfhi(b4[tt].z) * acc[5]); o.w = pkbf(bflo(b4[tt].w) * acc[6], bfhi(b4[tt].w) * acc[7]);
                    *(u32x4_t*)(CAT + (rb + tt) * 1536 + 384 + 8 * lane) = o;
                }
            }
        }
    }
    __syncthreads();
}


typedef short v4i16_t __attribute__((ext_vector_type(4)));
__device__ __forceinline__ v4i16_t lds_tr16(LAS const unsigned char* p) { return __builtin_amdgcn_ds_read_tr16_b64_v4i16((LAS v4i16_t*)p); }
template <int l> __device__ __forceinline__ void ph_ca(const MkArgs& args, LAS unsigned char* lds, int tid, int wave, int lane) {
    constexpr int RS = 544;
    const bf16_t* Qb = (const bf16_t*)(args.ws + WS_Q); const bf16_t* KV = (const bf16_t*)(args.ws + WS_KV); bf16_t* Ob = (bf16_t*)(args.ws + WS_O);
    const float* qn = args.in[22] + l * 256;
    const int qi = lane & 15, kq = lane >> 4;
    for (int du = blockIdx.x; du < 512; du += gridDim.x) {
        const int bh = du >> 6, b = bh >> 2, h = bh & 3, qt2 = du & 63;
        u32x4_t rawq[2][8];
#pragma unroll
        for (int qt = 0; qt < 2; ++qt)
#pragma unroll
            for (int ks = 0; ks < 8; ++ks) rawq[qt][ks] = *(const u32x4_t*)(Qb + ((size_t)b * SEQ + (size_t)(qt2 * 2 + qt) * 128 + wave * 16 + qi) * DM + h * 256 + 32 * ks + 8 * kq);
        f32x4 gq[8][2];
#pragma unroll
        for (int ks = 0; ks < 8; ++ks) { gq[ks][0] = *(const f32x4*)(qn + 32 * ks + 8 * kq); gq[ks][1] = *(const f32x4*)(qn + 32 * ks + 8 * kq + 4); }
        __syncthreads();
        if (lane < 32) {
#pragma unroll
            for (int i = 0; i < 32; ++i) { const int key = wave * 32 + i;
                __builtin_amdgcn_global_load_lds((const unsigned*)(KV + (size_t)(b * MEML + key) * 4096 + l * 2048 + h * 256 + 8 * lane), (LAS unsigned*)(lds + key * RS), 16, 0, 0); }
        }
        unsigned pP[2][32]; float linv[2];
        {
            bf16x8 qf[2][8];
#pragma unroll
            for (int qt = 0; qt < 2; ++qt) {
                const size_t t0 = (size_t)b * SEQ + (size_t)(qt2 * 2 + qt) * 128 + wave * 16;
                u32x4_t raw[8]; float ss = 0.f;
#pragma unroll
                for (int ks = 0; ks < 8; ++ks) { raw[ks] = rawq[qt][ks];
                    const float a0 = bflo(raw[ks].x), a1 = bfhi(raw[ks].x), a2 = bflo(raw[ks].y), a3 = bfhi(raw[ks].y), a4 = bflo(raw[ks].z), a5 = bfhi(raw[ks].z), a6 = bflo(raw[ks].w), a7 = bfhi(raw[ks].w);
                    ss += a0 * a0 + a1 * a1 + a2 * a2 + a3 * a3 + a4 * a4 + a5 * a5 + a6 * a6 + a7 * a7; }
                ss += __shfl_xor(ss, 16); ss += __shfl_xor(ss, 32);
                const float rs = rsqrtf(ss * (1.f / 256.f) + 1e-6f) * 0.0625f;
#pragma unroll
                for (int ks = 0; ks < 8; ++ks) { const f32x4 g0 = gq[ks][0], g1 = gq[ks][1];
                    u32x4_t o; o.x = pkbf(bflo(raw[ks].x) * rs * g0.x, bfhi(raw[ks].x) * rs * g0.y); o.y = pkbf(bflo(raw[ks].y) * rs * g0.z, bfhi(raw[ks].y) * rs * g0.w);
                    o.z = pkbf(bflo(raw[ks].z) * rs * g1.x, bfhi(raw[ks].z) * rs * g1.y); o.w = pkbf(bflo(raw[ks].w) * rs * g1.z, bfhi(raw[ks].w) * rs * g1.w);
                    qf[qt][ks] = __builtin_bit_cast(bf16x8, o); }
            }
            asm volatile("s_waitcnt vmcnt(0)" ::: "memory");
            __syncthreads();
            f32x4 s0[16], s1[16];
#pragma unroll
            for (int kt = 0; kt < 16; ++kt) { s0[kt] = (f32x4){0.f, 0.f, 0.f, 0.f}; s1[kt] = s0[kt];
                bf16x8 ka[8];
#pragma unroll
                for (int ks = 0; ks < 8; ++ks) ka[ks] = *(const LAS bf16x8*)(lds + (16 * kt + qi) * RS + (32 * ks + 8 * kq) * 2);
#pragma unroll
                for (int ks = 0; ks < 8; ++ks) { s0[kt] = MFMA16(ka[ks], qf[0][ks], s0[kt]); s1[kt] = MFMA16(ka[ks], qf[1][ks], s1[kt]); }
                __builtin_amdgcn_sched_group_barrier(0x100, 8, 0); __builtin_amdgcn_sched_group_barrier(0x008, 16, 0); }
#define CA_SOFTMAX(sacc, qt) { f32x2_t t2[16][2];   \
            _Pragma("unroll") for (int kt = 0; kt < 16; ++kt) { t2[kt][0] = (f32x2_t){sacc[kt][0], sacc[kt][1]} * (f32x2_t){1.44269504f, 1.44269504f}; t2[kt][1] = (f32x2_t){sacc[kt][2], sacc[kt][3]} * (f32x2_t){1.44269504f, 1.44269504f}; } \
            float m = t2[0][0].x; \
            _Pragma("unroll") for (int kt = 0; kt < 16; ++kt) m = fmaxf(fmaxf(m, fmaxf(t2[kt][0].x, t2[kt][0].y)), fmaxf(t2[kt][1].x, t2[kt][1].y)); \
            m = fmaxf(m, __shfl_xor(m, 16)); m = fmaxf(m, __shfl_xor(m, 32)); float sum = 0.f; const f32x2_t m2 = (f32x2_t){m, m}; \
            _Pragma("unroll") for (int kt = 0; kt < 16; ++kt) { const f32x2_t e0 = t2[kt][0] - m2, e1 = t2[kt][1] - m2; \
                const float p0 = __builtin_amdgcn_exp2f(e0.x), p1 = __builtin_amdgcn_exp2f(e0.y), p2 = __builtin_amdgcn_exp2f(e1.x), p3 = __builtin_amdgcn_exp2f(e1.y); \
                sum += (p0 + p1) + (p2 + p3); pP[qt][2 * kt] = pkbf(p0, p1); pP[qt][2 * kt + 1] = pkbf(p2, p3); } \
            sum += __shfl_xor(sum, 16); sum += __shfl_xor(sum, 32); linv[qt] = __builtin_amdgcn_rcpf(sum); }
            CA_SOFTMAX(s0, 0)
            CA_SOFTMAX(s1, 1)
#undef CA_SOFTMAX
        }
        __syncthreads();
        if (lane < 32) {
#pragma unroll
            for (int i = 0; i < 32; ++i) { const int key = wave * 32 + i;
                __builtin_amdgcn_global_load_lds((const unsigned*)(KV + (size_t)(b * MEML + key) * 4096 + l * 2048 + 1024 + h * 256 + 8 * lane), (LAS unsigned*)(lds + key * RS), 16, 0, 0); }
        }
        asm volatile("s_waitcnt vmcnt(0)" ::: "memory");
        __syncthreads();
        {
            const size_t t0 = (size_t)b * SEQ + (size_t)(qt2 * 2) * 128 + wave * 16;
            LAS const unsigned char* vb = lds + (4 * kq + (qi >> 2)) * RS + 8 * (qi & 3);
#pragma unroll 2
            for (int dtp = 0; dtp < 8; ++dtp) {
                u32x2_t wq[2][2];
#pragma unroll
                for (int e = 0; e < 2; ++e) { const int dt = 2 * dtp + e;
                    f32x4 o0 = (f32x4){0.f, 0.f, 0.f, 0.f}, o1 = o0;
                    v4i16_t vlo[8], vhi[8];
#pragma unroll
                    for (int kk = 0; kk < 8; ++kk) { vlo[kk] = lds_tr16(vb + (32 * kk) * RS + 32 * dt); vhi[kk] = lds_tr16(vb + (32 * kk + 16) * RS + 32 * dt); }
#pragma unroll
                    for (int kk = 0; kk < 8; ++kk) {
                        const v4i16_t lo = vlo[kk], hi = vhi[kk];
                        const bf16x8 a = (bf16x8){lo[0], lo[1], lo[2], lo[3], hi[0], hi[1], hi[2], hi[3]};
                        const u32x4_t pb0 = (u32x4_t){pP[0][4 * kk], pP[0][4 * kk + 1], pP[0][4 * kk + 2], pP[0][4 * kk + 3]};
                        const u32x4_t pb1 = (u32x4_t){pP[1][4 * kk], pP[1][4 * kk + 1], pP[1][4 * kk + 2], pP[1][4 * kk + 3]};
                        o0 = MFMA16(a, __builtin_bit_cast(bf16x8, pb0), o0); o1 = MFMA16(a, __builtin_bit_cast(bf16x8, pb1), o1);
                    }
                    __builtin_amdgcn_sched_group_barrier(0x100, 16, 0); __builtin_amdgcn_sched_group_barrier(0x008, 16, 0);
                    wq[e][0].x = pkbf_sw(o0[0] * linv[0], o0[1] * linv[0]); wq[e][0].y = pkbf_sw(o0[2] * linv[0], o0[3] * linv[0]);
                    wq[e][1].x = pkbf_sw(o1[0] * linv[1], o1[1] * linv[1]); wq[e][1].y = pkbf_sw(o1[2] * linv[1], o1[3] * linv[1]);
                }
#pragma unroll
                for (int qt = 0; qt < 2; ++qt) {
                    const u32x2_t sx = __builtin_amdgcn_permlane16_swap(wq[0][qt].x, wq[1][qt].x, false, false), sy = __builtin_amdgcn_permlane16_swap(wq[0][qt].y, wq[1][qt].y, false, false);
                    const u32x4_t o = (u32x4_t){sx.x, sy.x, sx.y, sy.y};
                    *(u32x4_t*)(Ob + (t0 + 128 * qt + qi) * DM + h * 256 + 16 * (2 * dtp + (kq & 1)) + 8 * (kq >> 1)) = o;
                }
            }
        }
    }
    __syncthreads();
}
template <int l> __device__ __forceinline__ void ph_dattn(const MkArgs& args, LAS unsigned char* lds, int tid, int wave, int lane) {
    constexpr int RS = 144, RSV = 160, KH = 128 * RS, VS = 144 * RSV;
    constexpr int VB0 = 20480, KB0 = VB0 + 3 * VS, DEND = KB0 + 3 * KH;
    static_assert(DEND <= MISC_OFF, "dattn LDS");
    constexpr int NU = 3 * 2 * 6 * 128;
    const bf16_t* PROJ = (const bf16_t*)(args.ws + WS_PROJ); bf16_t* OBR = (bf16_t*)(args.ws + WS_OBR); float* LSE = (float*)(args.ws + WS_LSE);
    const int qi = lane & 15, kq = lane >> 4;
    for (int idx = tid; idx < (DEND - VB0) / 16; idx += NWAVES * 64) ((LAS u32x4_t*)(lds + VB0))[idx] = (u32x4_t){0u, 0u, 0u, 0u};
    __syncthreads();
    const float* qn = args.in[11] + l * 64; const float* kn = args.in[12] + l * 64;
    const f32x4 qg0 = *(const f32x4*)(qn + 8 * kq) * *(const f32x4*)(kn + 8 * kq), qg1 = *(const f32x4*)(qn + 8 * kq + 4) * *(const f32x4*)(kn + 8 * kq + 4),
                qg2 = *(const f32x4*)(qn + 32 + 8 * kq) * *(const f32x4*)(kn + 32 + 8 * kq), qg3 = *(const f32x4*)(qn + 32 + 8 * kq + 4) * *(const f32x4*)(kn + 32 + 8 * kq + 4);
    f32x2_t mb0[2], mb8[2];
#pragma unroll
    for (int r = 0; r < 4; ++r) { mb0[r >> 1][r & 1] = (128 + qi - 4 * kq - r <= 128) ? 0.f : -INFINITY; mb8[r >> 1][r & 1] = (qi - 4 * kq - r >= 0) ? 0.f : -INFINITY; }
    struct DSet { u32x4_t pre[4]; bf16x8 q0, q1; size_t tq; int br, h, i0; };
    DSet sA, sB; sA.tq = 0; sA.br = sA.h = sA.i0 = 0; sB.tq = 0; sB.br = sB.h = sB.i0 = 0;
#define DATTN_DECODE(u_, br_, bb_, h_, dil_, res_, i0_) const int qt_ = (u_) & 127, h_ = ((u_) >> 7) % 6, bb_ = (((u_) >> 7) / 6) & 1, br_ = ((u_) >> 7) / 12; \
        const int dil_ = br_ == 0 ? 1 : (br_ == 1 ? 4 : 16), per_ = SEQ / dil_ / 128, res_ = qt_ / per_, i0_ = (qt_ % per_) * 128;
#define DATTN_LOADH(S_, bb_, h_, dil_, res_, ibase_) do { \
        _Pragma("unroll") for (int j = 0; j < 4; ++j) { const int idx = tid + NWAVES * 64 * (j & 1), jk = idx >> 3, cc = idx & 7, isv = j >> 1; \
            (S_).pre[j] = *(const u32x4_t*)(PROJ + (size_t)((bb_) * SEQ + ((ibase_) + jk) * (dil_) + (res_)) * NP + (isv ? PC_V : PC_K) + (h_) * 64 + 8 * cc); } } while (0)
#define DATTN_LOAD(S_, u_) do { DATTN_DECODE(u_, br, bb, h, dil, res, i0) DATTN_LOADH(S_, bb, h, dil, res, i0); \
        const size_t tq_ = (size_t)bb * SEQ + (size_t)(i0 + wave * 16 + qi) * dil + res; (S_).tq = tq_; (S_).br = br; (S_).h = h; (S_).i0 = i0; \
        (S_).q0 = *(const bf16x8*)(PROJ + tq_ * NP + PC_Q + h * 64 + 8 * kq); (S_).q1 = *(const bf16x8*)(PROJ + tq_ * NP + PC_Q + h * 64 + 32 + 8 * kq); } while (0)
#define DATTN_STAGE(S_, slot_) do { \
        _Pragma("unroll") for (int j = 0; j < 4; ++j) { const int idx = tid + NWAVES * 64 * (j & 1), jk = idx >> 3, cc = idx & 7, isv = j >> 1; \
            u32x4_t v = (S_).pre[j]; \
            if (!isv) { \
                const float a0 = bflo(v.x), a1 = bfhi(v.x), a2 = bflo(v.y), a3 = bfhi(v.y), a4 = bflo(v.z), a5 = bfhi(v.z), a6 = bflo(v.w), a7 = bfhi(v.w); \
                float ss = a0 * a0 + a1 * a1 + a2 * a2 + a3 * a3 + a4 * a4 + a5 * a5 + a6 * a6 + a7 * a7; \
                ss += __shfl_xor(ss, 1); ss += __shfl_xor(ss, 2); ss += __shfl_xor(ss, 4); \
                const float rs = rsqrtf(ss * (1.f / 64.f) + 1e-6f); const f32x2_t r2 = (f32x2_t){rs, rs}; \
                const f32x2_t x0 = (f32x2_t){a0, a1} * r2, x1 = (f32x2_t){a2, a3} * r2, x2 = (f32x2_t){a4, a5} * r2, x3 = (f32x2_t){a6, a7} * r2; \
                v.x = pkbf(x0.x, x0.y); v.y = pkbf(x1.x, x1.y); v.z = pkbf(x2.x, x2.y); v.w = pkbf(x3.x, x3.y); \
            } \
            *(LAS u32x4_t*)(lds + (isv ? VB0 + (slot_) * VS + jk * RSV : KB0 + (slot_) * KH + jk * RS) + 16 * cc) = v; } } while (0)
    const int G_ = (int)gridDim.x;
    const int u_lo = (int)(((long long)blockIdx.x * NU) / G_), u_hi = (int)(((long long)(blockIdx.x + 1) * NU) / G_);
    int slo = 0, shi = 1;
    if (u_lo < u_hi) {
        { DATTN_DECODE(u_lo, br, bb, h, dil, res, i0) (void)br;
          if (i0 > 0) { DATTN_LOADH(sA, bb, h, dil, res, i0 - 128); DATTN_STAGE(sA, 0); } }
        DATTN_LOAD(sA, u_lo); if (u_lo + 1 < u_hi) DATTN_LOAD(sB, u_lo + 1);
    }
    struct Cur { bf16x8 cq0, cq1; size_t tq; int br, h, i0; };
    Cur cur; cur.tq = 0; cur.br = cur.h = cur.i0 = 0;
    auto top = [&](DSet& S) __attribute__((always_inline)) {
        DATTN_STAGE(S, shi);
        bf16x8 cq0, cq1;
        {
            const u32x4_t u0 = __builtin_bit_cast(u32x4_t, S.q0), u1 = __builtin_bit_cast(u32x4_t, S.q1);
            float ss = bflo(u0.x) * bflo(u0.x) + bfhi(u0.x) * bfhi(u0.x) + bflo(u0.y) * bflo(u0.y) + bfhi(u0.y) * bfhi(u0.y) + bflo(u0.z) * bflo(u0.z) + bfhi(u0.z) * bfhi(u0.z) + bflo(u0.w) * bflo(u0.w) + bfhi(u0.w) * bfhi(u0.w)
                     + bflo(u1.x) * bflo(u1.x) + bfhi(u1.x) * bfhi(u1.x) + bflo(u1.y) * bflo(u1.y) + bfhi(u1.y) * bfhi(u1.y) + bflo(u1.z) * bflo(u1.z) + bfhi(u1.z) * bfhi(u1.z) + bflo(u1.w) * bflo(u1.w) + bfhi(u1.w) * bfhi(u1.w);
            ss += __shfl_xor(ss, 16); ss += __shfl_xor(ss, 32);
            const float rs = rsqrtf(ss * (1.f / 64.f) + 1e-6f) * 0.125f;
            u32x4_t o0, o1; const f32x2_t r2 = (f32x2_t){rs, rs};
#define DATTN_QP(w_, g_, hi_) ({ const f32x2_t x_ = (f32x2_t){bflo(w_), bfhi(w_)} * r2 * ((hi_) ? (f32x2_t){(g_).z, (g_).w} : (f32x2_t){(g_).x, (g_).y}); pkbf(x_.x, x_.y); })
            o0.x = DATTN_QP(u0.x, qg0, 0); o0.y = DATTN_QP(u0.y, qg0, 1); o0.z = DATTN_QP(u0.z, qg1, 0); o0.w = DATTN_QP(u0.w, qg1, 1);
            o1.x = DATTN_QP(u1.x, qg2, 0); o1.y = DATTN_QP(u1.y, qg2, 1); o1.z = DATTN_QP(u1.z, qg3, 0); o1.w = DATTN_QP(u1.w, qg3, 1);
#undef DATTN_QP
            cq0 = __builtin_bit_cast(bf16x8, o0); cq1 = __builtin_bit_cast(bf16x8, o1);
        }
        cur.cq0 = cq0; cur.cq1 = cq1; cur.tq = S.tq; cur.br = S.br; cur.h = S.h; cur.i0 = S.i0;
    };
    auto body = [&](DSet& S, const int uload, const bool doload) __attribute__((always_inline)) {
        const bf16x8 cq0 = cur.cq0, cq1 = cur.cq1;
        const size_t ctq = cur.tq; const int cbr = cur.br, ch = cur.h, i0 = cur.i0;
        __syncthreads();
        if (doload) DATTN_LOAD(S, uload);
        const int kA = KB0 + slo * KH + (16 * wave + qi) * RS + 16 * kq, kB = KB0 + shi * KH - KH + (16 * wave + qi) * RS + 16 * kq;
        f32x4 s[9];
        {
            bf16x8 ka[9], kb[9];
#pragma unroll
            for (int kt = 0; kt < 9; ++kt) { LAS const unsigned char* kp = lds + (wave + kt < 8 ? kA : kB) + 16 * kt * RS; ka[kt] = *(const LAS bf16x8*)kp; kb[kt] = *(const LAS bf16x8*)(kp + 64); }
#pragma unroll
            for (int kt = 0; kt < 9; ++kt) { s[kt] = MFMA16(ka[kt], cq0, ((f32x4){0.f, 0.f, 0.f, 0.f})); s[kt] = MFMA16(kb[kt], cq1, s[kt]); }
            __builtin_amdgcn_sched_group_barrier(0x100, 18, 0); __builtin_amdgcn_sched_group_barrier(0x008, 18, 0);
        }
        f32x2_t t2[9][2];
#pragma unroll
        for (int kt = 0; kt < 9; ++kt) {
            f32x2_t b0, b1;
            if (kt == 0) { b0 = i0 == 0 ? (f32x2_t){-INFINITY, -INFINITY} : mb0[0]; b1 = i0 == 0 ? (f32x2_t){-INFINITY, -INFINITY} : mb0[1]; }
            else if (kt == 8) { b0 = mb8[0]; b1 = mb8[1]; }
            else { const float tb = (i0 == 0 && wave + kt < 8) ? -INFINITY : 0.f; b0 = (f32x2_t){tb, tb}; b1 = b0; }
            t2[kt][0] = __builtin_elementwise_fma((f32x2_t){s[kt][0], s[kt][1]}, (f32x2_t){1.44269504f, 1.44269504f}, b0);
            t2[kt][1] = __builtin_elementwise_fma((f32x2_t){s[kt][2], s[kt][3]}, (f32x2_t){1.44269504f, 1.44269504f}, b1);
        }
        float m = -INFINITY;
#pragma unroll
        for (int kt = 0; kt < 9; ++kt) m = fmaxf(fmaxf(m, fmaxf(t2[kt][0].x, t2[kt][0].y)), fmaxf(t2[kt][1].x, t2[kt][1].y));
        m = fmaxf(m, __shfl_xor(m, 16)); m = fmaxf(m, __shfl_xor(m, 32));
        float sum = 0.f; unsigned pp[20]; const f32x2_t m2 = (f32x2_t){m, m};
#pragma unroll
        for (int kt = 0; kt < 9; ++kt) { const f32x2_t e0 = t2[kt][0] - m2, e1 = t2[kt][1] - m2;
            const float p0 = __builtin_amdgcn_exp2f(e0.x), p1 = __builtin_amdgcn_exp2f(e0.y), p2 = __builtin_amdgcn_exp2f(e1.x), p3 = __builtin_amdgcn_exp2f(e1.y);
            sum += (p0 + p1) + (p2 + p3); pp[2 * kt] = pkbf(p0, p1); pp[2 * kt + 1] = pkbf(p2, p3); }
        pp[18] = 0u; pp[19] = 0u;
        sum += __shfl_xor(sum, 16); sum += __shfl_xor(sum, 32);
        const float linv = __builtin_amdgcn_rcpf(sum);
        const int vrow = (16 * wave + 4 * kq + (qi >> 2)) * RSV + 8 * (qi & 3);
        const int vA = VB0 + slo * VS + vrow, vB = VB0 + shi * VS - 128 * RSV + vrow;
        bf16_t* orow = OBR + ((size_t)cbr * T + ctq) * 384 + ch * 64;
#pragma unroll
        for (int dp = 0; dp < 2; ++dp) {
            v4i16_t lo[2][5], hi[2][5];
#pragma unroll
            for (int d2 = 0; d2 < 2; ++d2)
#pragma unroll
                for (int kk = 0; kk < 5; ++kk) {
                    lo[d2][kk] = lds_tr16(lds + (wave + 2 * kk < 8 ? vA : vB) + (32 * kk) * RSV + 32 * (2 * dp + d2));
                    hi[d2][kk] = lds_tr16(lds + (wave + 2 * kk + 1 < 8 ? vA : vB) + (32 * kk + 16) * RSV + 32 * (2 * dp + d2)); }
            f32x4 o[2]; o[0] = (f32x4){0.f, 0.f, 0.f, 0.f}; o[1] = o[0];
#pragma unroll
            for (int kk = 0; kk < 5; ++kk) {
                const u32x4_t pb = (u32x4_t){pp[4 * kk], pp[4 * kk + 1], pp[4 * kk + 2], pp[4 * kk + 3]};
#pragma unroll
                for (int d2 = 0; d2 < 2; ++d2) o[d2] = MFMA16(((bf16x8){lo[d2][kk][0], lo[d2][kk][1], lo[d2][kk][2], lo[d2][kk][3], hi[d2][kk][0], hi[d2][kk][1], hi[d2][kk][2], hi[d2][kk][3]}), __builtin_bit_cast(bf16x8, pb), o[d2]);
            }
            __builtin_amdgcn_sched_group_barrier(0x100, 20, 0); __builtin_amdgcn_sched_group_barrier(0x008, 10, 0);
            {
                u32x2_t w0, w1; w0.x = pkbf_sw(o[0][0] * linv, o[0][1] * linv); w0.y = pkbf_sw(o[0][2] * linv, o[0][3] * linv); w1.x = pkbf_sw(o[1][0] * linv, o[1][1] * linv); w1.y = pkbf_sw(o[1][2] * linv, o[1][3] * linv);
                const u32x2_t sx = __builtin_amdgcn_permlane16_swap(w0.x, w1.x, false, false), sy = __builtin_amdgcn_permlane16_swap(w0.y, w1.y, false, false);
                *(u32x4_t*)(orow + 16 * (2 * dp + (kq & 1)) + 8 * (kq >> 1)) = (u32x4_t){sx.x, sy.x, sx.y, sy.y};
            }
        }
        if (kq == 0) LSE[((size_t)cbr * T + ctq) * 6 + ch] = (m + __builtin_amdgcn_logf(sum)) * 0.69314718f;
        slo = shi; shi = shi == 2 ? 0 : shi + 1;
    };
    if (u_lo < u_hi) {
        int u = u_lo;
        top(sA);
        for (; u + 3 < u_hi; u += 2) {
            body(sA, u + 2, true); top(sB); body(sB, u + 3, true); top(sA);
        }
        const bool has1 = u + 1 < u_hi, has2 = u + 2 < u_hi;
        body(sA, u + 2, has2);
        if (has1) { top(sB); body(sB, 0, false); }
        if (has2) { top(sA); body(sA, 0, false); }
    }
#undef DATTN_DECODE
#undef DATTN_LOADH
#undef DATTN_LOAD
#undef DATTN_STAGE
    __syncthreads();
}
constexpr int SSD_RSX = 400, SSD_RSB = 288;
constexpr int SSD_OFF_ARR = 0;
constexpr int SSD_OFF_X = 9216, SSD_OFF_B = SSD_OFF_X + 128 * SSD_RSX, SSD_OFF_C = SSD_OFF_B + 128 * SSD_RSB;
__device__ __forceinline__ float fsoftplus(float x) { return fmaxf(x, 0.f) + log1pf(__expf(-fabsf(x))); }

template <int l> __device__ __forceinline__ void ph_ssd1(const MkArgs& args, LAS unsigned char* lds, int tid, int wave, int lane) {
    bf16_t* PROJ = (bf16_t*)(args.ws + WS_PROJ); const bf16_t* HALO = (const bf16_t*)(args.ws + WS_HALO);
    const float* DT = (const float*)(args.ws + WS_DT); float* ACS = (float*)(args.ws + WS_ACS); float* DTS = (float*)(args.ws + WS_DTS); bf16_t* STATES = (bf16_t*)(args.ws + WS_YS);
    const float* conv_w = args.in[4] + l * 4 * 896; const float* conv_b = args.in[5] + l * 896;
    const float* dt_bias = args.in[6] + l * 6; const float* a_log = args.in[7] + l * 6;
    LAS float* acs_l = (LAS float*)(lds + SSD_OFF_ARR); LAS float* dt_l = acs_l + 768; LAS float* fac_l = acs_l + 1536;
    const int qi = lane & 15, kq = lane >> 4;
    const float ah_w = wave < 6 ? -__expf(a_log[wave]) : 0.f, bias_w = wave < 6 ? dt_bias[wave] : 0.f;
    for (int u = blockIdx.x; u < 256; u += gridDim.x) {
        const int b = u >> 7, c = u & 127; const size_t row0 = (size_t)b * SEQ + (size_t)c * 128;
        __syncthreads();
#pragma unroll 1
        for (int g = 0; g < 2; ++g) {
            const int cg = tid % 56, seg = tid / 56, l0 = seg * 16;
            const int ci = cg < 24 ? g * 192 + 8 * cg : (cg < 40 ? 384 + g * 128 + 8 * (cg - 24) : 640 + g * 128 + 8 * (cg - 40));
            u32x4_t hr[3];
            if (tid < 448) {
#pragma unroll
                for (int r = 0; r < 3; ++r) { const int ll = l0 - 3 + r;
                    hr[r] = ll >= 0 ? *(const u32x4_t*)(PROJ + (row0 + ll) * NP + PC_XBC + ci) : (c > 0 ? *(const u32x4_t*)(HALO + ((size_t)u * 3 + (ll + 3)) * 896 + ci) : (u32x4_t){0u, 0u, 0u, 0u}); }
            }
        if (g == 0 && wave < 6) {
            const int h = wave; const float ah = ah_w, bias = bias_w;
            const float d0 = fsoftplus(DT[(row0 + 2 * lane) * 8 + h] + bias), d1 = fsoftplus(DT[(row0 + 2 * lane + 1) * 8 + h] + bias);
            const float v0 = d0 * ah, v1 = v0 + d1 * ah;
            float sc = v1;
#pragma unroll
            for (int o = 1; o < 64; o <<= 1) { const float t = __shfl_up(sc, o); if (lane >= o) sc += t; }
            const float ex = sc - v1, a0 = ex + v0, a1 = ex + v1, tot = __shfl(sc, 63);
            acs_l[h * 128 + 2 * lane] = a0; acs_l[h * 128 + 2 * lane + 1] = a1; dt_l[h * 128 + 2 * lane] = d0; dt_l[h * 128 + 2 * lane + 1] = d1;
            fac_l[h * 128 + 2 * lane] = d0 * __expf(tot - a0); fac_l[h * 128 + 2 * lane + 1] = d1 * __expf(tot - a1);
            ACS[(row0 + 2 * lane) * 8 + h] = a0; ACS[(row0 + 2 * lane + 1) * 8 + h] = a1; DTS[(row0 + 2 * lane) * 8 + h] = d0; DTS[(row0 + 2 * lane + 1) * 8 + h] = d1;
        }
            asm volatile("s_waitcnt vmcnt(0)" ::: "memory");
            __syncthreads();
            if (tid < 448) {
                float w[4][8], bs[8];
#pragma unroll
                for (int i = 0; i < 8; ++i) { bs[i] = conv_b[ci + i];
#pragma unroll
                    for (int k = 0; k < 4; ++k) w[k][i] = conv_w[k * 896 + ci + i]; }
                const int hx = g * 3 + (cg >> 3);
                float win[4][8];
#define UNPK(dst, rr) do { dst[0] = bflo(rr.x); dst[1] = bfhi(rr.x); dst[2] = bflo(rr.y); dst[3] = bfhi(rr.y); dst[4] = bflo(rr.z); dst[5] = bfhi(rr.z); dst[6] = bflo(rr.w); dst[7] = bfhi(rr.w); } while (0)
                UNPK(win[0], hr[0]); UNPK(win[1], hr[1]); UNPK(win[2], hr[2]);
                bf16_t* prow = PROJ + (row0 + l0) * NP + PC_XBC + ci;
#pragma unroll 1
                for (int jb = 0; jb < 16; jb += 8) {
                    u32x4_t raw[8];
#pragma unroll
                    for (int j = 0; j < 8; ++j) raw[j] = *(const u32x4_t*)(prow + (size_t)(jb + j) * NP);
#pragma unroll
                    for (int j = 0; j < 8; ++j) {
                        UNPK(win[(j + 3) & 3], raw[j]);
                        float o[8];
#pragma unroll
                        for (int i = 0; i < 8; ++i) o[i] = fsilu(bs[i] + w[0][i] * win[j & 3][i] + w[1][i] * win[(j + 1) & 3][i] + w[2][i] * win[(j + 2) & 3][i] + w[3][i] * win[(j + 3) & 3][i]);
                        u32x4_t pk; pk.x = pkbf(o[0], o[1]); pk.y = pkbf(o[2], o[3]); pk.z = pkbf(o[4], o[5]); pk.w = pkbf(o[6], o[7]);
                        *(u32x4_t*)(prow + (size_t)(jb + j) * NP) = pk;
                        if (cg < 24) { const float f = fac_l[hx * 128 + l0 + jb + j];
                            u32x4_t ps; ps.x = pkbf(o[0] * f, o[1] * f); ps.y = pkbf(o[2] * f, o[3] * f); ps.z = pkbf(o[4] * f, o[5] * f); ps.w = pkbf(o[6] * f, o[7] * f);
                            *(LAS u32x4_t*)(lds + SSD_OFF_X + (l0 + jb + j) * SSD_RSX + 16 * cg) = ps; }
                        else if (cg < 40) *(LAS u32x4_t*)(lds + SSD_OFF_B + (l0 + jb + j) * SSD_RSB + 16 * (cg - 24)) = pk;
                    }
                }
            }
            __syncthreads();
            bf16x8 bfr[4];
#pragma unroll
            for (int ks = 0; ks < 4; ++ks) {
                LAS const unsigned char* bp = lds + SSD_OFF_B + (32 * ks + 4 * kq + (qi >> 2)) * SSD_RSB + (16 * wave + 4 * (qi & 3)) * 2;
                const v4i16_t lo = lds_tr16(bp), hi = lds_tr16(bp + 16 * SSD_RSB);
                bfr[ks] = (bf16x8){lo[0], lo[1], lo[2], lo[3], hi[0], hi[1], hi[2], hi[3]};
            }
#pragma unroll 1
            for (int hh = 0; hh < 3; ++hh) {
                bf16_t* sp = STATES + ((((size_t)u * 6 + g * 3 + hh) * 64) * 128);
#pragma unroll
                for (int pt = 0; pt < 4; ++pt) {
                    f32x4 acc = (f32x4){0.f, 0.f, 0.f, 0.f};
                    v4i16_t xlo[4], xhi[4];
#pragma unroll
                    for (int ks = 0; ks < 4; ++ks) {
                        LAS const unsigned char* xp = lds + SSD_OFF_X + (32 * ks + 4 * kq + (qi >> 2)) * SSD_RSX + (hh * 64 + 16 * pt + 4 * (qi & 3)) * 2;
                        xlo[ks] = lds_tr16(xp); xhi[ks] = lds_tr16(xp + 16 * SSD_RSX);
                    }
#pragma unroll
                    for (int ks = 0; ks < 4; ++ks) acc = MFMA16(bfr[ks], ((bf16x8){xlo[ks][0], xlo[ks][1], xlo[ks][2], xlo[ks][3], xhi[ks][0], xhi[ks][1], xhi[ks][2], xhi[ks][3]}), acc);
                    __builtin_amdgcn_sched_group_barrier(0x100, 8, 0); __builtin_amdgcn_sched_group_barrier(0x008, 4, 0);
#pragma unroll
                    for (int r = 0; r < 4; r += 4) { u32x2_t w; w.x = (unsigned)(unsigned short)f2bf(acc[0]) | ((unsigned)(unsigned short)f2bf(acc[1]) << 16); w.y = (unsigned)(unsigned short)f2bf(acc[2]) | ((unsigned)(unsigned short)f2bf(acc[3]) << 16);
                        *(u32x2_t*)(sp + (size_t)(16 * pt + qi) * 128 + 16 * wave + 4 * kq) = w; }
                }
            }
        }
    }
    __syncthreads();
}
__device__ __forceinline__ void ph_ssd_scan(const MkArgs& args, int tid) {
    unsigned* STATES = (unsigned*)(args.ws + WS_YS); const float* ACS = (const float*)(args.ws + WS_ACS);
    constexpr int NE = 2 * 6 * 64 * 64;
    const int G_ = (int)gridDim.x, per = (((NE + G_ - 1) / G_) + 63) & ~63, lane = tid & 63;
    for (int i0 = 0; i0 < per; i0 += NWAVES * 64) {
        const int e = (int)blockIdx.x * per + i0 + tid;
        if (i0 + tid < per && e < NE) {
            const int pn2 = e & 4095, h = (e >> 12) % 6, b = e / (6 * 4096);
            unsigned* sp = STATES + ((size_t)(b * 128) * 6 + h) * 4096 + pn2;
            const float ed0 = __expf(ACS[((size_t)b * SEQ + (size_t)lane * 128 + 127) * 8 + h]), ed1 = __expf(ACS[((size_t)b * SEQ + (size_t)(64 + lane) * 128 + 127) * 8 + h]);
            float H0 = 0.f, H1 = 0.f;
#pragma unroll 1
            for (int hf = 0; hf < 2; ++hf) {
                unsigned* sq = sp + (size_t)hf * 64 * 6 * 4096; const float edv = hf ? ed1 : ed0;
                unsigned sv[64];
#pragma unroll
                for (int c = 0; c < 64; ++c) sv[c] = sq[(size_t)c * 6 * 4096];
#pragma unroll
                for (int c = 0; c < 64; ++c) {
                    sq[(size_t)c * 6 * 4096] = pkbf(H0, H1);
                    const float ed = __builtin_bit_cast(float, __builtin_amdgcn_readlane(__builtin_bit_cast(int, edv), c));
                    H0 = H0 * ed + bflo(sv[c]); H1 = H1 * ed + bfhi(sv[c]);
                }
            }
        }
    }
}
template <int l> __device__ __forceinline__ void ph_ssd2(const MkArgs& args, LAS unsigned char* lds, int tid, int wave, int lane) {
    const bf16_t* PROJ = (const bf16_t*)(args.ws + WS_PROJ); bf16_t* CAT = (bf16_t*)(args.ws + WS_CAT);
    const float* ACS = (const float*)(args.ws + WS_ACS); const float* DTS = (const float*)(args.ws + WS_DTS); const bf16_t* STATES = (const bf16_t*)(args.ws + WS_YS);
    const float* dvec = args.in[8] + l * 6; const float* gn = args.in[9] + l * 384;
    LAS float* acs_l = (LAS float*)(lds + SSD_OFF_ARR); LAS float* dt_l = acs_l + 768;
    constexpr int SSD_OFF_P2 = SSD_OFF_C + 128 * SSD_RSB;
    const int qi = lane & 15, kq = lane >> 4, erow = lane >> 2, epq = lane & 3;
    for (int u = blockIdx.x; u < 256; u += gridDim.x) {
        const int b = u >> 7, c = u & 127; const size_t row0 = (size_t)b * SEQ + (size_t)c * 128;
        float ssq = 0.f;
        const size_t erow_g = row0 + 16 * wave + erow;
#pragma unroll 1
        for (int g = 0; g < 2; ++g) {
            __syncthreads();
            {
                const int ll = tid >> 2, c4 = tid & 3; const bf16_t* prow = PROJ + (row0 + ll) * NP + PC_XBC;
                u32x4_t sv[14];
#pragma unroll
                for (int i = 0; i < 14; ++i) { const int cg = c4 + 4 * i; sv[i] = *(const u32x4_t*)(prow + (i < 6 ? g * 192 + 8 * cg : (i < 10 ? 384 + g * 128 + 8 * (cg - 24) : 640 + g * 128 + 8 * (cg - 40)))); }
                if (g == 0) {
                    const int i0 = tid, i1 = tid + NWAVES * 64;
                    const float a0 = ACS[(row0 + (i0 & 127)) * 8 + (i0 >> 7)], d0 = DTS[(row0 + (i0 & 127)) * 8 + (i0 >> 7)];
                    float a1 = 0.f, d1 = 0.f; if (i1 < 768) { a1 = ACS[(row0 + (i1 & 127)) * 8 + (i1 >> 7)]; d1 = DTS[(row0 + (i1 & 127)) * 8 + (i1 >> 7)]; }
                    acs_l[i0] = a0; dt_l[i0] = d0; if (i1 < 768) { acs_l[i1] = a1; dt_l[i1] = d1; }
                    __syncthreads();
                }
#pragma unroll
                for (int i = 0; i < 14; ++i) { const int cg = c4 + 4 * i; const u32x4_t v = sv[i];
                    if (i < 6) { const float f = dt_l[(g * 3 + (cg >> 3)) * 128 + ll];
                        u32x4_t ps; ps.x = pkbf(bflo(v.x) * f, bfhi(v.x) * f); ps.y = pkbf(bflo(v.y) * f, bfhi(v.y) * f); ps.z = pkbf(bflo(v.z) * f, bfhi(v.z) * f); ps.w = pkbf(bflo(v.w) * f, bfhi(v.w) * f);
                        *(LAS u32x4_t*)(lds + SSD_OFF_X + ll * SSD_RSX + 16 * cg) = ps; }
                    else if (i < 10) *(LAS u32x4_t*)(lds + SSD_OFF_B + ll * SSD_RSB + 16 * (cg - 24)) = v;
                    else *(LAS u32x4_t*)(lds + SSD_OFF_C + ll * SSD_RSB + 16 * (cg - 40)) = v; }
            }
            u32x4_t pv[6];
#pragma unroll
            for (int i = 0; i < 6; ++i) pv[i] = *(const u32x4_t*)(STATES + (((size_t)u * 6 + g * 3) * 64) * 128 + (size_t)(tid + NWAVES * 64 * i) * 8);
            __syncthreads();
            bf16x8 cfr[4];
#pragma unroll
            for (int ks = 0; ks < 4; ++ks) cfr[ks] = *(const LAS bf16x8*)(lds + SSD_OFF_C + (16 * wave + qi) * SSD_RSB + (32 * ks + 8 * kq) * 2);
            f32x4 cb[8];
#pragma unroll
            for (int st = 0; st < 8; ++st) { cb[st] = (f32x4){0.f, 0.f, 0.f, 0.f};
                if (st <= wave) {
#pragma unroll
                    for (int ks = 0; ks < 4; ++ks) cb[st] = MFMA16(cfr[ks], *(const LAS bf16x8*)(lds + SSD_OFF_B + (16 * st + qi) * SSD_RSB + (32 * ks + 8 * kq) * 2), cb[st]); } }
            __syncthreads();
#pragma unroll
            for (int i = 0; i < 6; ++i) { const int e8 = tid + NWAVES * 64 * i, hh = e8 >> 10, p = (e8 >> 4) & 63, n8 = e8 & 15;
                *(LAS u32x4_t*)(lds + (hh < 2 ? SSD_OFF_C + hh * 64 * SSD_RSB : SSD_OFF_P2) + p * SSD_RSB + 16 * n8) = pv[i]; }
            __syncthreads();
            LAS unsigned char* mw = lds + SSD_OFF_B + wave * (16 * SSD_RSB);
#pragma unroll 1
            for (int hh = 0; hh < 3; ++hh) {
                const int h = g * 3 + hh;
                const int ch0 = h * 64 + 16 * epq; const bf16_t* prow = PROJ + erow_g * NP;
                const u32x4_t x0 = *(const u32x4_t*)(prow + PC_XBC + ch0), x1 = *(const u32x4_t*)(prow + PC_XBC + ch0 + 8), z0 = *(const u32x4_t*)(prow + PC_Z + ch0), z1 = *(const u32x4_t*)(prow + PC_Z + ch0 + 8);
                const float Dh = dvec[h];
                float al[4], el[4];
#pragma unroll
                for (int r = 0; r < 4; ++r) { al[r] = acs_l[h * 128 + 16 * wave + 4 * kq + r]; el[r] = __expf(al[r]); }
#pragma unroll
                for (int st = 0; st < 8; ++st) { const int sidx = 16 * st + qi; const float as = acs_l[h * 128 + sidx];
#pragma unroll
                    for (int r = 0; r < 4; ++r) { const int ll = 16 * wave + 4 * kq + r; const float mv = sidx <= ll ? cb[st][r] * __expf(al[r] - as) : 0.f;
                        *(LAS bf16_t*)(mw + (4 * kq + r) * SSD_RSB + sidx * 2) = f2bf(mv); } }
                LDS_WAIT(); asm volatile("" ::: "memory");
                bf16x8 mfr[4];
#pragma unroll
                for (int ks = 0; ks < 4; ++ks) mfr[ks] = *(const LAS bf16x8*)(mw + qi * SSD_RSB + (32 * ks + 8 * kq) * 2);
                LAS const unsigned char* pvb = lds + (hh < 2 ? SSD_OFF_C + hh * 64 * SSD_RSB : SSD_OFF_P2);
                f32x4 yy[4];
#pragma unroll
                for (int pt = 0; pt < 4; ++pt) {
                    f32x4 yd = (f32x4){0.f, 0.f, 0.f, 0.f}, yo = (f32x4){0.f, 0.f, 0.f, 0.f};
                    v4i16_t xlo[4], xhi[4]; bf16x8 pfr[4];
#pragma unroll
                    for (int ks = 0; ks < 4; ++ks) {
                        LAS const unsigned char* xp = lds + SSD_OFF_X + (32 * ks + 8 * kq + (qi >> 2)) * SSD_RSX + (hh * 64 + 16 * pt + 4 * (qi & 3)) * 2;
                        xlo[ks] = lds_tr16(xp); xhi[ks] = lds_tr16(xp + 4 * SSD_RSX);
                        pfr[ks] = *(const LAS bf16x8*)(pvb + (16 * pt + qi) * SSD_RSB + (32 * ks + 8 * kq) * 2);
                    }
#pragma unroll
                    for (int ks = 0; ks < 4; ++ks) {
                        yd = MFMA16(mfr[ks], ((bf16x8){xlo[ks][0], xlo[ks][1], xlo[ks][2], xlo[ks][3], xhi[ks][0], xhi[ks][1], xhi[ks][2], xhi[ks][3]}), yd);
                        yo = MFMA16(cfr[ks], pfr[ks], yo);
                    }
                    __builtin_amdgcn_sched_group_barrier(0x100, 12, 0); __builtin_amdgcn_sched_group_barrier(0x008, 8, 0);
#pragma unroll
                    for (int r = 0; r < 4; ++r) yy[pt][r] = yd[r] + yo[r] * el[r];
                }
                LDS_WAIT(); asm volatile("" ::: "memory");
#pragma unroll
                for (int pt = 0; pt < 4; ++pt)
#pragma unroll
                    for (int r = 0; r < 4; ++r) *(LAS float*)(mw + (4 * kq + r) * SSD_RSB + (16 * pt + qi) * 4) = yy[pt][r];
                LDS_WAIT(); asm volatile("" ::: "memory");
                {
                    f32x4 y4[4];
#pragma unroll
                    for (int q = 0; q < 4; ++q) y4[q] = *(const LAS f32x4*)(mw + erow * SSD_RSB + (16 * epq + 4 * q) * 4);
                    float v[16];
#define SSD_EPI(i, yv, xw, zw, hi_) { const float xs_ = hi_ ? bfhi(xw) : bflo(xw), zz_ = hi_ ? bfhi(zw) : bflo(zw); v[i] = ((yv) + Dh * xs_) * fsilu(zz_); ssq += v[i] * v[i]; }
                    SSD_EPI(0, y4[0].x, x0.x, z0.x, 0) SSD_EPI(1, y4[0].y, x0.x, z0.x, 1) SSD_EPI(2, y4[0].z, x0.y, z0.y, 0) SSD_EPI(3, y4[0].w, x0.y, z0.y, 1)
                    SSD_EPI(4, y4[1].x, x0.z, z0.z, 0) SSD_EPI(5, y4[1].y, x0.z, z0.z, 1) SSD_EPI(6, y4[1].z, x0.w, z0.w, 0) SSD_EPI(7, y4[1].w, x0.w, z0.w, 1)
                    SSD_EPI(8, y4[2].x, x1.x, z1.x, 0) SSD_EPI(9, y4[2].y, x1.x, z1.x, 1) SSD_EPI(10, y4[2].z, x1.y, z1.y, 0) SSD_EPI(11, y4[2].w, x1.y, z1.y, 1)
                    SSD_EPI(12, y4[3].x, x1.z, z1.z, 0) SSD_EPI(13, y4[3].y, x1.z, z1.z, 1) SSD_EPI(14, y4[3].z, x1.w, z1.w, 0) SSD_EPI(15, y4[3].w, x1.w, z1.w, 1)
#undef SSD_EPI
                    u32x4_t o0, o1; o0.x = pkbf(v[0], v[1]); o0.y = pkbf(v[2], v[3]); o0.z = pkbf(v[4], v[5]); o0.w = pkbf(v[6], v[7]); o1.x = pkbf(v[8], v[9]); o1.y = pkbf(v[10], v[11]); o1.z = pkbf(v[12], v[13]); o1.w = pkbf(v[14], v[15]);
                    *(u32x4_t*)(CAT + erow_g * 1536 + ch0) = o0; *(u32x4_t*)(CAT + erow_g * 1536 + ch0 + 8) = o1;
                }
                LDS_WAIT(); asm volatile("" ::: "memory");
            }
        }
        ssq += __shfl_xor(ssq, 1); ssq += __shfl_xor(ssq, 2);
        const float rsn = rsqrtf(ssq * (1.f / 384.f) + 1e-6f);
        asm volatile("s_waitcnt vmcnt(0)" ::: "memory");
        u32x4_t av[6][2]; f32x4 gv[6][4];
#pragma unroll
        for (int h = 0; h < 6; ++h) { const int ch0 = h * 64 + 16 * epq; const bf16_t* p = CAT + erow_g * 1536 + ch0; av[h][0] = *(const u32x4_t*)p; av[h][1] = *(const u32x4_t*)(p + 8);
#pragma unroll
            for (int q = 0; q < 4; ++q) gv[h][q] = *(const f32x4*)(gn + ch0 + 4 * q); }
#pragma unroll
        for (int h = 0; h < 6; ++h) {
            const int ch0 = h * 64 + 16 * epq; bf16_t* p = CAT + erow_g * 1536 + ch0;
            const u32x4_t a0 = av[h][0], a1 = av[h][1];
            const f32x4 g0 = gv[h][0], g1 = gv[h][1], g2 = gv[h][2], g3 = gv[h][3];
            u32x4_t o0, o1;
            o0.x = pkbf(bflo(a0.x) * rsn * g0.x, bfhi(a0.x) * rsn * g0.y); o0.y = pkbf(bflo(a0.y) * rsn * g0.z, bfhi(a0.y) * rsn * g0.w);
            o0.z = pkbf(bflo(a0.z) * rsn * g1.x, bfhi(a0.z) * rsn * g1.y); o0.w = pkbf(bflo(a0.w) * rsn * g1.z, bfhi(a0.w) * rsn * g1.w);
            o1.x = pkbf(bflo(a1.x) * rsn * g2.x, bfhi(a1.x) * rsn * g2.y); o1.y = pkbf(bflo(a1.y) * rsn * g2.z, bfhi(a1.y) * rsn * g2.w);
            o1.z = pkbf(bflo(a1.z) * rsn * g3.x, bfhi(a1.z) * rsn * g3.y); o1.w = pkbf(bflo(a1.w) * rsn * g3.z, bfhi(a1.w) * rsn * g3.w);
            *(u32x4_t*)p = o0; *(u32x4_t*)(p + 8) = o1;
        }
    }
    __syncthreads();
}

#if defined(PROBE_LO)
#define PROBE_BEGIN(lp) do { if ((lp) == PROBE_LO) t_probe = __builtin_amdgcn_s_memrealtime(); } while (0)
#define PROBE_END(lp) do { if ((lp) == PROBE_HI) { const unsigned long long t1_ = __builtin_amdgcn_s_memrealtime(), d_ = (t1_ - t_probe) * PROBE_K; while (__builtin_amdgcn_s_memrealtime() - t1_ < d_) __builtin_amdgcn_s_sleep(8); } } while (0)
#else
#define PROBE_BEGIN(lp) do { } while (0)
#define PROBE_END(lp) do { } while (0)
#endif
#define WSP(type, off) ((type*)(args.ws + (off)))
#define IN(k) (lo <= (k) && (k) < hi)
#define SEAM(k) do { if (IN(k) && IN((k) + 1)) xcd_barrier(bar); } while (0)
template <int l> __device__ __forceinline__ void layer_phases(const MkArgs& args, LAS unsigned char* lds, const XcdBarrier& bar, const int lo, const int hi) {
    const int P0 = PH_L0 + l * PH_PER_LAYER;
    const int tid = threadIdx.x, lane = tid & 63, wave = __builtin_amdgcn_readfirstlane(tid >> 6);
    const int gw = (int)blockIdx.x * NWAVES + wave, NGW = (int)gridDim.x * NWAVES;
    unsigned long long t_probe = 0; (void)t_probe;
    PROBE_BEGIN(LP_NORM1);
    if (IN(P0 + LP_NORM1)) {
        const LAS int* tb = nullptr;
        if (l == 0) {
        } else { tb = moe_tables(args, 0, lds, tid); ph_norm1<l>(args, tb, lds, tid, lane, gw, NGW); }
    }
    PROBE_END(LP_NORM1);
    if (l != 0) SEAM(P0 + LP_NORM1);
    PROBE_BEGIN(LP_GIN);
    if (IN(P0 + LP_GIN)) {
        if (l == 0) {
            const int kv0 = gridDim.x >= 160 ? 128 : 0, nkv = gridDim.x >= 160 ? 32 : (int)gridDim.x;
            if ((int)blockIdx.x >= kv0 && (int)blockIdx.x < kv0 + nkv) {
                pg8::Gemm g{WSP(bf16_t, WS_MEMN), WSP(bf16_t, WS_WKV), 512, 4096, DM}; pg8::StaticOrder S; S.init(512, 4096, nkv, (int)blockIdx.x - kv0);
                pg8::EpiBf16<0> E{WSP(bf16_t, WS_KV), 4096, nullptr, 0, 0, 1.f};
                pg8::gemm_phase<pg8::EpiBf16<0>, pg8::StaticOrder, true, true>(lds, g, S, E);
            }
        }
        pg8::Gemm g{(const bf16_t*)args.out, WSP(bf16_t, WS_WIN), T, NP, DM}; pg8::StaticOrder S; S.init(T, NP, gridDim.x, (int)blockIdx.x);
        pg8::EpiProj E{WSP(bf16_t, WS_PROJ), WSP(bf16_t, WS_HALO), WSP(const float, WS_GATEBUF) + 65536};
        pg8::gemm_phase<pg8::EpiProj, pg8::StaticOrder, true, true>(lds, g, S, E);
    }
    PROBE_END(LP_GIN);
    SEAM(P0 + LP_GIN);
    PROBE_BEGIN(LP_QKN);
    PROBE_END(LP_QKN);
    PROBE_BEGIN(LP_MIX1);
    if (IN(P0 + LP_MIX1)) {
        if (l == 0) ph_knorm(args, lane, gw, NGW);
        PROBE_BEGIN(22); if (args.mask & 4) ph_ssd1<l>(args, lds, tid, wave, lane); PROBE_END(22);
        PROBE_BEGIN(20); if (args.mask & 1) ph_cf<l>(args, lds, tid, wave, lane); PROBE_END(20);
    }
    PROBE_END(LP_MIX1);
    SEAM(P0 + LP_MIX1);
    PROBE_BEGIN(LP_SCAN);
    if (IN(P0 + LP_SCAN)) { ph_ssd_scan(args, tid); PROBE_BEGIN(21); ph_dattn<l>(args, lds, tid, wave, lane); PROBE_END(21); }
    PROBE_END(LP_SCAN);
    SEAM(P0 + LP_SCAN);
    PROBE_BEGIN(LP_MIX2);
    if (IN(P0 + LP_MIX2)) {
        PROBE_BEGIN(23); if (args.mask & 1) ph_attn_comb(args, lane, gw, NGW); PROBE_END(23);
        PROBE_BEGIN(24); if (args.mask & 4) ph_ssd2<l>(args, lds, tid, wave, lane); PROBE_END(24);
    }
    PROBE_END(LP_MIX2);
    SEAM(P0 + LP_MIX2);
    PROBE_BEGIN(LP_GOUT);
    if (IN(P0 + LP_GOUT)) {
        pg8::Gemm g{WSP(bf16_t, WS_CAT), WSP(bf16_t, WS_WOUT), T, DM, 1536}; pg8::StaticOrder S; S.init(T, DM, gridDim.x, (int)blockIdx.x);
        pg8::EpiResB<false, true> E{(const void*)args.out, WSP(bf16_t, WS_XB1), WSP(float, WS_SSQ)};
        pg8::gemm_phase<pg8::EpiResB<false, true>, pg8::StaticOrder, true, true>(lds, g, S, E);
    }
    PROBE_END(LP_GOUT);
    SEAM(P0 + LP_GOUT);
    PROBE_BEGIN(LP_NORM2);
    PROBE_END(LP_NORM2);
    PROBE_BEGIN(LP_GQ);
    if (IN(P0 + LP_GQ)) {
        pg8::Gemm g{WSP(bf16_t, WS_XB1), WSP(bf16_t, WS_WQ), T, DM, DM}; pg8::StaticOrder S; S.init(T, DM, gridDim.x, (int)blockIdx.x);
        pg8::EpiBf16RowScale E{WSP(bf16_t, WS_Q), WSP(const float, WS_SSQ)};
        pg8::gemm_phase<pg8::EpiBf16RowScale, pg8::StaticOrder, true, true>(lds, g, S, E);
    }
    PROBE_END(LP_GQ);
    SEAM(P0 + LP_GQ);
    PROBE_BEGIN(LP_CA);
    if (IN(P0 + LP_CA)) ph_ca<l>(args, lds, tid, wave, lane);
    PROBE_END(LP_CA);
    SEAM(P0 + LP_CA);
    PROBE_BEGIN(LP_GO);
    if (IN(P0 + LP_GO)) {
        pg8::Gemm g{WSP(bf16_t, WS_O), WSP(bf16_t, WS_WO), T, DM, DM}; pg8::StaticOrder S; S.init(T, DM, gridDim.x, (int)blockIdx.x);
        pg8::EpiResB<false, false> E{(const void*)WSP(bf16_t, WS_XB1), WSP(bf16_t, WS_XN), nullptr};
        pg8::gemm_phase<pg8::EpiResB<false, false>, pg8::StaticOrder, true, true>(lds, g, S, E);
    }
    PROBE_END(LP_GO);
    SEAM(P0 + LP_GO);
    PROBE_BEGIN(LP_ROUTER);
    if (IN(P0 + LP_ROUTER)) { ph_router<l>(args, lds, tid, lane, gw, NGW); __syncthreads(); cvt_layer_experts(args, l, lds, wave, lane, gw, NGW); }
    PROBE_END(LP_ROUTER);
    SEAM(P0 + LP_ROUTER);
    PROBE_BEGIN(LP_GATHER);
    PROBE_END(LP_GATHER);
    PROBE_BEGIN(LP_GGU);
    if (IN(P0 + LP_GGU)) {
        const LAS int* tb = moe_tables(args, l, lds, tid);
        pg8::Gemm g{WSP(bf16_t, WS_XN), WSP(bf16_t, WS_WGU), 0, 1024, DM}; pg8::MoeOrder<true> S; S.init(4, gridDim.x, (int)blockIdx.x, tb, (size_t)1024 * DM * 2, WSP(const int, WS_LIST), DM * 2);
        pg8::EpiGateUp E{WSP(bf16_t, WS_HID), WSP(const float, WS_GATEBUF), WSP(const int, WS_LIST), tb};
        pg8::gemm_phase<pg8::EpiGateUp, pg8::MoeOrder<true>, true, true>(lds, g, S, E);
        if (l == 0) {
            const int G_ = (int)gridDim.x, r = ((tb[32] / 256) * 4) % G_, c = (int)blockIdx.x;
            if (r == 0) cvt_layer_small(args, 1, lds, wave, lane, gw, NGW);
            else if (c >= r) cvt_layer_small(args, 1, lds, wave, lane, (c - r) * NWAVES + wave, (G_ - r) * NWAVES);
        }
    }
    PROBE_END(LP_GGU);
    SEAM(P0 + LP_GGU);
    PROBE_BEGIN(LP_GDOWN);
    if (IN(P0 + LP_GDOWN)) {
        const LAS int* tb = moe_tables(args, l, lds, tid);
        pg8::Gemm g{WSP(bf16_t, WS_HID), WSP(bf16_t, WS_WD), 0, 1024, 512}; pg8::MoeOrder<false> S; S.init(4, gridDim.x, (int)blockIdx.x, tb, (size_t)DM * 512 * 2, nullptr, 0u);
        pg8::EpiDown E{WSP(bf16_t, WS_YB), WSP(const float, WS_GATEL), tb};
        pg8::gemm_phase<pg8::EpiDown, pg8::MoeOrder<false>, true, true>(lds, g, S, E);
    }
    PROBE_END(LP_GDOWN);
    SEAM(P0 + LP_GDOWN);
}
__global__ void __launch_bounds__(NWAVES * 64, 2) mk_fwd(MkArgs args) {
    extern __shared__ __attribute__((aligned(16))) unsigned char lds_raw[];
    LAS unsigned char* lds = (LAS unsigned char*)lds_raw;
    for (int u = threadIdx.x; u < 64; u += NWAVES * 64) ((LAS unsigned*)(lds + MISC_OFF))[u] = 0u;
    __syncthreads();
    XcdBarrier bar = xcd_barrier_post(WSP(unsigned, WS_CTL) + CW_BAR + args.bar_region * XCD_BAR_WORDS, (volatile LAS unsigned*)(lds + MISC_OFF) + 8);
    const int lo = args.ph_lo, hi = args.ph_hi;
    unsigned long long t_probe = 0; (void)t_probe;
    PROBE_BEGIN(30);
    if (IN(0)) { const int tid = threadIdx.x, lane = tid & 63, wave = __builtin_amdgcn_readfirstlane(tid >> 6);
        ph_pro0(args, lds, wave, lane, (int)blockIdx.x * NWAVES + wave, (int)gridDim.x * NWAVES);
        ph_norm1<0>(args, nullptr, lds, tid, lane, (int)blockIdx.x * NWAVES + wave, (int)gridDim.x * NWAVES); }
    PROBE_END(30);
    SEAM(0);
    layer_phases<0>(args, lds, bar, lo, hi);
    layer_phases<1>(args, lds, bar, lo, hi);
    PROBE_BEGIN(32);
    if (IN(PH_FINAL)) { const int tid = threadIdx.x, lane = tid & 63, wave = __builtin_amdgcn_readfirstlane(tid >> 6);
        const LAS int* tb = moe_tables(args, 1, lds, tid);
        ph_final(args, tb, lane, (int)blockIdx.x * NWAVES + wave, (int)gridDim.x * NWAVES); }
    PROBE_END(32);
#undef IN
#undef SEAM
}

static int g_grid = 0, g_region = 0;
static void mk(hipStream_t stream, void* const* d_in, void* d_out, void* d_ws, int lo, int hi, int mask = 0) {
    MkArgs a{};
    for (int i = 0; i < 33; ++i) a.in[i] = (const float*)d_in[i];
    a.out = (float*)d_out; a.ws = (unsigned char*)d_ws; a.ph_lo = lo; a.ph_hi = hi; a.bar_region = g_region++; a.mask = mask;
    hipLaunchKernelGGL(mk_fwd, dim3(g_grid), dim3(NWAVES * 64), LDS_BYTES, stream, a);
}

extern "C" void kernel_launch(void* const* d_in, const int* in_sizes, int n_in, void* d_out, int out_size, void* d_ws, size_t ws_size, hipStream_t stream) {
    if (n_in != 33 || ws_size < WS_END) { fprintf(stderr, "kernel_launch: bad n_in %d or ws %zu < %zu\n", n_in, ws_size, (size_t)WS_END); return; }
    if (g_grid == 0) {
        int dev = 0, cus = 0;
        (void)hipGetDevice(&dev); (void)hipDeviceGetAttribute(&cus, hipDeviceAttributeMultiprocessorCount, dev);
        if (hipFuncSetAttribute((const void*)mk_fwd, hipFuncAttributeMaxDynamicSharedMemorySize, LDS_BYTES) != hipSuccess) fprintf(stderr, "hipFuncSetAttribute failed\n");
        g_grid = cus > 0 ? cus : 256;
    }
    int* CTL = (int*)((char*)d_ws + WS_CTL);
    (void)hipMemsetAsync(CTL, 0, CTL_ZERO_BYTES, stream);
    g_region = 0;
#define MK(lo, hi, mask) mk(stream, d_in, d_out, d_ws, (lo), (hi), (mask))
    MK(0, PH_COUNT, 7);
#undef MK
}
```
